# Optimizing an MI355X kernel written in HIP

```python
import jax
import jax.numpy as jnp
from jax import lax
import numpy as np

D_MODEL = 1024
BATCH = 4
SEQ = 8192
DEPTH = 2

CHUNK = 64
Q_BLOCK = 128
HEAD_DIM = 64
H_SPARSE = 8
H_FOX = 8
H_IDX = 8
D_IDX = 64
TOPK_MAX = 256
ROPE_THETA = 500000.0
ROT_DIM = HEAD_DIM // 4
ROT_DIM_IDX = D_IDX // 4
D_FF = 2816
CONV_W = 3
N_BRANCH = 2
EPS = 1e-6
NEG_INF = -1e30

W_SPARSE = H_SPARSE * HEAD_DIM
W_FOX = H_FOX * HEAD_DIM
IN_SPLITS = (W_SPARSE, HEAD_DIM, HEAD_DIM, H_IDX * D_IDX, D_IDX, H_IDX,
             W_FOX, W_FOX, W_FOX, H_FOX, N_BRANCH * D_MODEL)
N_IN = W_SPARSE + 2 * HEAD_DIM + H_IDX * D_IDX + D_IDX + H_IDX + 3 * W_FOX + H_FOX + N_BRANCH * D_MODEL

kernel_name = "hybrid_dsa_fox_convffn_adaln"


def _rmsnorm(x, g):
    xf = x.astype(jnp.float32)
    y = xf * lax.rsqrt(jnp.mean(xf * xf, axis=-1, keepdims=True) + EPS)
    return (y * g.astype(jnp.float32)).astype(x.dtype)


def _partial_rope(x, positions, rot_dim):
    half = rot_dim // 2
    inv_freq = ROPE_THETA ** (-jnp.arange(0, rot_dim, 2, dtype=jnp.float32) / rot_dim)
    ang = positions.astype(jnp.float32)[..., None] * inv_freq
    cos = jnp.cos(ang)[:, :, None, :]
    sin = jnp.sin(ang)[:, :, None, :]
    xf = x.astype(jnp.float32)
    x1, x2, rest = xf[..., :half], xf[..., half:rot_dim], xf[..., rot_dim:]
    out = jnp.concatenate([x1 * cos - x2 * sin, x2 * cos + x1 * sin, rest], axis=-1)
    return out.astype(x.dtype)


def _to_blocks(a, nb):
    b = a.shape[0]
    return jnp.moveaxis(a.reshape((b, nb, Q_BLOCK) + a.shape[2:]), 1, 0)


def _from_blocks(a):
    a = jnp.moveaxis(a, 0, 1)
    return a.reshape((a.shape[0], a.shape[1] * a.shape[2]) + a.shape[3:])


def _sparse_attention(q, k, v, q_idx, k_idx, w_idx):
    S = q.shape[1]
    nb = S // Q_BLOCK
    topk = min(TOPK_MAX, S // 4)
    key_chunk = jnp.arange(S) // CHUNK
    idx_scale = D_IDX ** -0.5
    att_scale = HEAD_DIM ** -0.5

    def block(args):
        qb, qib, wb, q_start = args
        q_chunk = (q_start + jnp.arange(Q_BLOCK)) // CHUNK
        admissible = key_chunk[None, :] <= q_chunk[:, None]
        s = jnp.einsum("bqhd,bsd->bqhs", qib, k_idx).astype(jnp.float32) * idx_scale
        score = jnp.einsum("bqh,bqhs->bqs", wb.astype(jnp.float32), jax.nn.relu(s))
        score = jnp.where(admissible[None], score, NEG_INF)
        top_val, top_idx = lax.top_k(score, topk)
        valid = top_val > 0.5 * NEG_INF
        k_sel = jax.vmap(lambda kk, ii: kk[ii])(k, top_idx)
        v_sel = jax.vmap(lambda vv, ii: vv[ii])(v, top_idx)
        logits = jnp.einsum("bqhd,bqkd->bqhk", qb, k_sel).astype(jnp.float32) * att_scale
        logits = jnp.where(valid[:, :, None, :], logits, NEG_INF)
        p = jax.nn.softmax(logits, axis=-1).astype(v.dtype)
        return jnp.einsum("bqhk,bqkd->bqhd", p, v_sel)

    starts = jnp.arange(nb) * Q_BLOCK
    out = lax.map(block, (_to_blocks(q, nb), _to_blocks(q_idx, nb), _to_blocks(w_idx, nb), starts))
    return _from_blocks(out)


def _forgetting_attention(q, k, v, log_f):
    S = q.shape[1]
    nb = S // Q_BLOCK
    cum = jnp.cumsum(log_f, axis=1)
    cum_k = jnp.moveaxis(cum, 1, 2)
    key_pos = jnp.arange(S)
    scale = HEAD_DIM ** -0.5

    def block(args):
        qb, cq, q_start = args
        causal = key_pos[None, :] <= (q_start + jnp.arange(Q_BLOCK))[:, None]
        logits = jnp.einsum("bqhd,bshd->bhqs", qb, k).astype(jnp.float32) * scale
        logits = logits + jnp.moveaxis(cq, 1, 2)[..., None] - cum_k[:, :, None, :]
        logits = jnp.where(causal[None, None], logits, NEG_INF)
        p = jax.nn.softmax(logits, axis=-1).astype(v.dtype)
        return jnp.einsum("bhqs,bshd->bqhd", p, v)

    starts = jnp.arange(nb) * Q_BLOCK
    out = lax.map(block, (_to_blocks(q, nb), _to_blocks(cum, nb), starts))
    return _from_blocks(out)


def _mixer(h, positions, w_in, forget_bias, w_branch_a, w_branch_b, w_out):
    B, S, _ = h.shape
    proj = h @ w_in
    offs = np.cumsum(IN_SPLITS)[:-1].tolist()
    q_a, k_a, v_a, q_i, k_i, w_i, q_f, k_f, v_f, f_f, gates = jnp.split(proj, offs, axis=-1)
    q_a = _partial_rope(q_a.reshape(B, S, H_SPARSE, HEAD_DIM), positions, ROT_DIM)
    k_a = _partial_rope(k_a[:, :, None, :], positions, ROT_DIM)[:, :, 0]
    q_i = _partial_rope(q_i.reshape(B, S, H_IDX, D_IDX), positions, ROT_DIM_IDX)
    k_i = _partial_rope(k_i[:, :, None, :], positions, ROT_DIM_IDX)[:, :, 0]
    w_i = w_i * (H_IDX ** -0.5)
    o_a = _sparse_attention(q_a, k_a, v_a, q_i, k_i, w_i)
    y_a = o_a.reshape(B, S, W_SPARSE) @ w_branch_a
    log_f = jax.nn.log_sigmoid(f_f.astype(jnp.float32) + forget_bias.astype(jnp.float32))
    o_b = _forgetting_attention(q_f.reshape(B, S, H_FOX, HEAD_DIM),
                                k_f.reshape(B, S, H_FOX, HEAD_DIM),
                                v_f.reshape(B, S, H_FOX, HEAD_DIM), log_f)
    y_b = o_b.reshape(B, S, W_FOX) @ w_branch_b
    g_a, g_b = jnp.split(jax.nn.sigmoid(gates.astype(jnp.float32)).astype(h.dtype), N_BRANCH, axis=-1)
    return (g_a * y_a + g_b * y_b) @ w_out


def _conv_ffn(h, w_up, conv_w, conv_b, w_down):
    S = h.shape[1]
    u = h @ w_up
    up = jnp.pad(u, ((0, 0), (CONV_W - 1, 0), (0, 0)))
    u = conv_b + sum(conv_w[i] * up[:, i:i + S] for i in range(CONV_W))
    a, b = jnp.split(u, 2, axis=-1)
    return (jax.nn.silu(a) * b) @ w_down


def setup_inputs(seed: int = 0) -> dict:
    key = jax.random.key(seed)
    ks = jax.random.split(key, 17)
    f32 = jnp.float32

    def nrm(k, shape, fan_in, mult=1.0):
        return jax.random.normal(k, shape, f32) * (mult * fan_in ** -0.5)

    x = jax.random.normal(ks[0], (BATCH, SEQ, D_MODEL), f32)
    c = jax.random.normal(ks[1], (BATCH, D_MODEL), f32)
    offset = jax.random.randint(ks[2], (BATCH, 1), 0, 4096, dtype=jnp.int32)
    positions = offset + jnp.arange(SEQ, dtype=jnp.int32)[None, :]
    mod_w = nrm(ks[3], (DEPTH, D_MODEL, 6 * D_MODEL), D_MODEL, 0.5)
    mod_b = 0.01 * jax.random.normal(ks[4], (DEPTH, 6 * D_MODEL), f32)
    norm1_g = 1.0 + 0.02 * jax.random.normal(ks[5], (DEPTH, D_MODEL), f32)
    norm2_g = 1.0 + 0.02 * jax.random.normal(ks[6], (DEPTH, D_MODEL), f32)
    w_in = nrm(ks[7], (DEPTH, D_MODEL, N_IN), D_MODEL)
    forget_bias = 4.0 + 0.5 * jax.random.normal(ks[8], (DEPTH, H_FOX), f32)
    w_branch_a = nrm(ks[9], (DEPTH, W_SPARSE, D_MODEL), W_SPARSE)
    w_branch_b = nrm(ks[10], (DEPTH, W_FOX, D_MODEL), W_FOX)
    w_out = nrm(ks[11], (DEPTH, D_MODEL, D_MODEL), D_MODEL)
    w_up = nrm(ks[12], (DEPTH, D_MODEL, 2 * D_FF), D_MODEL)
    conv_w = nrm(ks[13], (DEPTH, CONV_W, 2 * D_FF), CONV_W)
    conv_b = 0.01 * jax.random.normal(ks[14], (DEPTH, 2 * D_FF), f32)
    w_down = nrm(ks[15], (DEPTH, D_FF, D_MODEL), D_FF)
    final_g = 1.0 + 0.02 * jax.random.normal(ks[16], (D_MODEL,), f32)
    return {"x": x, "c": c, "positions": positions, "mod_w": mod_w, "mod_b": mod_b,
            "norm1_g": norm1_g, "norm2_g": norm2_g, "w_in": w_in, "forget_bias": forget_bias,
            "w_branch_a": w_branch_a, "w_branch_b": w_branch_b, "w_out": w_out,
            "w_up": w_up, "conv_w": conv_w, "conv_b": conv_b, "w_down": w_down,
            "final_g": final_g}


def reference(x, c, positions, mod_w, mod_b, norm1_g, norm2_g, w_in, forget_bias,
              w_branch_a, w_branch_b, w_out, w_up, conv_w, conv_b, w_down, final_g):
    for l in range(DEPTH):
        mod = c @ mod_w[l] + mod_b[l]
        sh1, sc1, g1, sh2, sc2, g2 = [m[:, None, :] for m in jnp.split(mod, 6, axis=-1)]
        h = _rmsnorm(x, norm1_g[l]) * (1.0 + sc1) + sh1
        x = x + g1 * _mixer(h, positions, w_in[l], forget_bias[l], w_branch_a[l], w_branch_b[l], w_out[l])
        h = _rmsnorm(x, norm2_g[l]) * (1.0 + sc2) + sh2
        x = x + g2 * _conv_ffn(h, w_up[l], conv_w[l], conv_b[l], w_down[l])
    return _rmsnorm(x, final_g)
```

```cpp
#include <hip/hip_runtime.h>
#include <cstdio>
#include <cstdint>

constexpr int DM = 1024, NB = 4, SEQ = 8192, MTOK = NB * SEQ, DEPTH = 2;
constexpr int NIN_SRC = 4816, NIN = 4864;
constexpr int DFF = 2816, NUP = 2 * DFF;
constexpr int WSP = 512;
constexpr float EPS = 1e-6f;
constexpr float LOG2E = 1.4426950408889634f;
constexpr float C2 = 0.125f * LOG2E;


__device__ __forceinline__ float lane_read(float v, int src_lane) { return __builtin_bit_cast(float, __builtin_amdgcn_ds_bpermute(src_lane << 2, __builtin_bit_cast(int, v))); }
__device__ __forceinline__ unsigned lane_read_u(unsigned v, int src_lane) { return (unsigned)__builtin_amdgcn_ds_bpermute(src_lane << 2, (int)v); }

constexpr size_t MiB = 1u << 20;
constexpr size_t WS_CTL = 0, CTL_ZERO_BYTES = 1 * MiB;
constexpr size_t WS_MOD = 1 * MiB;
constexpr size_t WS_CS = 2 * MiB;
constexpr size_t WS_WIN = 4 * MiB, WIN_L = (size_t)NIN * DM * 2;
constexpr size_t WS_WA = 23 * MiB, WA_L = (size_t)DM * WSP * 2;
constexpr size_t WS_WB = 25 * MiB;
constexpr size_t WS_WO = 27 * MiB, WO_L = (size_t)DM * DM * 2;
constexpr size_t WS_WUP = 31 * MiB, WUP_L = (size_t)NUP * DM * 2;
constexpr size_t WS_WD = 53 * MiB, WD_L = (size_t)DM * DFF * 2;
constexpr size_t WS_H = 64 * MiB;
constexpr size_t WS_QA = 128 * MiB, WS_QF = 160 * MiB, WS_QI = 192 * MiB, WS_KF = 224 * MiB, WS_VF = 256 * MiB;
constexpr int GLD = 2080;
constexpr size_t WS_GATES = 288 * MiB;
constexpr size_t WS_KA = 419 * MiB, WS_VA = 423 * MiB, WS_KI = 427 * MiB, WS_WI = 431 * MiB, WS_LOGF = 432 * MiB, WS_CUM = 433 * MiB;
constexpr size_t WS_OB = 436 * MiB, WS_OA = 468 * MiB;
constexpr size_t WS_ACT = 128 * MiB;
constexpr size_t WS_UH = 304 * MiB, WS_UT = 326 * MiB;
constexpr size_t WS_END = 500 * MiB;
static_assert(WS_GATES + (size_t)MTOK * GLD * 2 <= WS_KA && WS_CUM + 2 * MiB <= WS_OB, "projection map");
static_assert(WS_WIN + 2 * WIN_L <= WS_WA && WS_WUP + 2 * WUP_L <= WS_WD && WS_WD + 2 * WD_L <= WS_H, "weight map");
static_assert(WS_ACT + (size_t)MTOK * DFF * 2 <= WS_UH && WS_UH + (size_t)512 * 2 * NUP * 4 <= WS_UT && WS_UT + (size_t)512 * 2 * NUP * 4 <= WS_GATES + 128 * MiB, "ffn map");
constexpr int CW_TMO = 0, CW_CODE = 1, CW_BAR = 4096;


namespace pg8 {
#define PG8_LAS __attribute__((address_space(3)))
typedef unsigned short bf16_t;
typedef short bf16x8 __attribute__((ext_vector_type(8)));
typedef float f32x4 __attribute__((ext_vector_type(4)));
typedef unsigned u32x4 __attribute__((ext_vector_type(4)));
constexpr int BM = 256, BK = 64, HALF = 128, HTB = HALF * BK * 2  , STAGE_BYTES = 8 * HTB, NXCD = 8, WGM = 8;

__host__ __device__ __forceinline__ int lds_byte(int r, int c) { const int st = (r >> 4) * 2 + (c >> 5), rr = r & 15, cc = c & 31, ob = rr * 64 + cc * 2; return st * 1024 + (ob ^ (((ob >> 9) & 1) << 5)); }
__host__ __device__ __forceinline__ void stage_rc(int b, int& R, int& C) { const int st = b / 1024, sb = b % 1024, swz = sb ^ (((sb >> 9) & 1) << 5); R = (st >> 1) * 16 + swz / 64; C = (st & 1) * 32 + (swz % 64) / 2; }
__host__ __device__ __forceinline__ int perm32(int rho) { const int n = rho >> 4, i = rho & 15; return 8 * (i >> 2) + 4 * n + (i & 3); }

struct Unit { int pm, pn; };
struct Gemm { const bf16_t* A; const bf16_t* Bt; int M, N, K; };

struct StaticOrder {
    int nM, nN, nwg, G, c;
    __host__ __device__ void init(int M, int N, int G_, int c_) { nM = M / BM; nN = N / BM; nwg = nM * nN; G = G_; c = c_; }
    __host__ __device__ __forceinline__ bool next(int i, Unit& u) const {
        const long L = (long)i * G + c; if (L >= nwg) return false;
        int wgid = (int)L; { const int q = nwg / NXCD, r = nwg % NXCD, xcd = wgid % NXCD, off = wgid / NXCD; wgid = (xcd < r ? xcd * (q + 1) : r * (q + 1) + (xcd - r) * q) + off; }
        const int nig = WGM * nN, gid = wgid / nig, fm = gid * WGM, gsz = (nM - fm) < WGM ? (nM - fm) : WGM;
        u.pm = fm + ((wgid % nig) % gsz); u.pn = (wgid % nig) / gsz; return true;
    }
    __device__ __forceinline__ void a_ready(const Unit&) const {}
    __device__ __forceinline__ void done(const Unit&) const {}
};

typedef float f32x2_cv __attribute__((ext_vector_type(2))); typedef __bf16 bf16x2_cv __attribute__((ext_vector_type(2)));
__device__ __forceinline__ unsigned cvt_pk_bf16(float lo, float hi) { const f32x2_cv v = {lo, hi}; const bf16x2_cv b = __builtin_convertvector(v, bf16x2_cv); return __builtin_bit_cast(unsigned, b); }

typedef float f32x2 __attribute__((ext_vector_type(2)));
typedef unsigned u32x2 __attribute__((ext_vector_type(2)));
#define PG8_GAS __attribute__((address_space(1)))
__device__ __forceinline__ float fast_sigmoid(float z) { return __builtin_amdgcn_rcpf(1.f + __builtin_amdgcn_exp2f(-z * 1.4426950408889634f)); }
__device__ __forceinline__ u32x4 pack8(const f32x4& v0, const f32x4& v1) { u32x4 w; w.x = cvt_pk_bf16(v0[0], v0[1]); w.y = cvt_pk_bf16(v0[2], v0[3]); w.z = cvt_pk_bf16(v1[0], v1[1]); w.w = cvt_pk_bf16(v1[2], v1[3]); return w; }

struct EpiInProj {
    static constexpr bool PERM = true, AFTER_DRAIN = false, MIDK = false;
    unsigned char* ws; const float* CS; const float* fbias;
    enum { K_PLAIN = 0, K_ROPE = 1, K_SIG = 2, K_SMALL = 3, K_NONE = 4 };
    __device__ __forceinline__ void operator()(const f32x4 (&acc)[2][2][4][2], const Unit& u, int wr, int wc, int fr_, int fq_) const {
        int fr = fr_, fq = fq_; asm volatile("" : "+v"(fr), "+v"(fq));
        const int row0 = u.pm * BM + wr * 64 + fr, pn = u.pn;
#pragma unroll
        for (int bj = 0; bj < 2; ++bj) {
            const int cg = 128 * bj + 32 * wc;
            int kind = K_PLAIN; size_t off = 0; int ld = 512, dcol = 0; float sc = 1.f;
            if (pn < 2)       { off = WS_QA; dcol = 256 * pn + cg; kind = (cg & 32) ? K_PLAIN : K_ROPE; sc = C2; }
            else if (pn == 2) {
                ld = 64;
                if (cg < 64)       { off = WS_KA; dcol = cg; kind = (cg == 0) ? K_ROPE : K_PLAIN; }
                else if (cg < 128) { off = WS_VA; dcol = cg - 64; }
                else if (cg < 192) { off = WS_KI; dcol = cg - 128; kind = (cg == 128) ? K_ROPE : K_PLAIN; }
                else kind = (cg == 192) ? K_SMALL : K_NONE;
            }
            else if (pn < 5)  { off = WS_QI; dcol = 256 * (pn - 3) + cg; kind = (cg & 32) ? K_PLAIN : K_ROPE; }
            else if (pn < 7)  { off = WS_QF; dcol = 256 * (pn - 5) + cg; sc = C2; }
            else if (pn < 9)  { off = WS_KF; dcol = 256 * (pn - 7) + cg; }
            else if (pn < 11) { off = WS_VF; dcol = 256 * (pn - 9) + cg; }
            else              { off = WS_GATES; ld = GLD; dcol = 256 * (pn - 11) + cg; kind = K_SIG; }
            kind = __builtin_amdgcn_readfirstlane(kind);
            if (kind == K_NONE) continue;
            if (kind == K_SMALL) {
                PG8_GAS float* p = (PG8_GAS float*)(ws + (fq == 0 ? WS_WI : WS_LOGF)) + (size_t)row0 * 8;
                const f32x4 fb0 = *(const PG8_GAS f32x4*)(fbias), fb1 = *(const PG8_GAS f32x4*)(fbias + 4);
#pragma unroll
                for (int ai = 0; ai < 2; ++ai)
#pragma unroll
                    for (int m = 0; m < 4; ++m) {
                        const f32x4 v0 = acc[ai][bj][m][0], v1 = acc[ai][bj][m][1];
                        const f32x4 z0 = v0 + fb0, z1 = v1 + fb1; f32x4 l0, l1;
#pragma unroll
                        for (int i = 0; i < 4; ++i) { l0[i] = fminf(z0[i], 0.f) - log1pf(__expf(-fabsf(z0[i]))); l1[i] = fminf(z1[i], 0.f) - log1pf(__expf(-fabsf(z1[i]))); }
                        const float s8 = 0.35355339059327373f;
                        const f32x4 o0 = (fq == 0) ? v0 * s8 : l0, o1 = (fq == 0) ? v1 * s8 : l1;
                        if (fq < 2) { *(PG8_GAS f32x4*)p = o0; *(PG8_GAS f32x4*)(p + 4) = o1; }
                        p += ((m < 3) ? 16 : (HALF - 48)) * 8; asm volatile("" : "+v"(p));
                    }
                continue;
            }
            PG8_GAS bf16_t* p = (PG8_GAS bf16_t*)(ws + off) + (size_t)row0 * ld + dcol + 8 * fq;
            if (kind == K_ROPE) {
                const int f4 = 4 * (fq & 1);
                const PG8_GAS float* cp = (const PG8_GAS float*)CS + (size_t)row0 * 16 + 2 * f4;
                PG8_GAS bf16_t* ph = p - 8 * fq;
                f32x4 cs0 = *(const PG8_GAS f32x4*)cp, cs1 = *(const PG8_GAS f32x4*)(cp + 4);
#pragma unroll
                for (int ai = 0; ai < 2; ++ai)
#pragma unroll
                    for (int m = 0; m < 4; ++m) {
                        const int adv = (m < 3) ? 16 : (HALF - 48);
                        const bool lastrow = (ai == 1 && m == 3);
                        const PG8_GAS float* cpn = cp + (lastrow ? 0 : adv * 16);
                        const f32x4 ns0 = *(const PG8_GAS f32x4*)cpn, ns1 = *(const PG8_GAS f32x4*)(cpn + 4);
                        const f32x4 v0 = acc[ai][bj][m][0] * sc, v1 = acc[ai][bj][m][1] * sc;
                        f32x4 o1, o2;
                        o1[0] = v0[0] * cs0[0] - v1[0] * cs0[1]; o2[0] = v1[0] * cs0[0] + v0[0] * cs0[1];
                        o1[1] = v0[1] * cs0[2] - v1[1] * cs0[3]; o2[1] = v1[1] * cs0[2] + v0[1] * cs0[3];
                        o1[2] = v0[2] * cs1[0] - v1[2] * cs1[1]; o2[2] = v1[2] * cs1[0] + v0[2] * cs1[1];
                        o1[3] = v0[3] * cs1[2] - v1[3] * cs1[3]; o2[3] = v1[3] * cs1[2] + v0[3] * cs1[3];
                        u32x2 w1, w2; w1.x = cvt_pk_bf16(o1[0], o1[1]); w1.y = cvt_pk_bf16(o1[2], o1[3]); w2.x = cvt_pk_bf16(o2[0], o2[1]); w2.y = cvt_pk_bf16(o2[2], o2[3]);
                        if (fq < 2) { *(PG8_GAS u32x2*)(ph + f4) = w1; *(PG8_GAS u32x2*)(ph + 8 + f4) = w2; }
                        else *(PG8_GAS u32x4*)p = pack8(v0, v1);
                        p += (size_t)adv * ld; ph += (size_t)adv * ld; cp = cpn; cs0 = ns0; cs1 = ns1; asm volatile("" : "+v"(p), "+v"(ph), "+v"(cp));
                    }
            } else if (kind == K_SIG) {
#pragma unroll
                for (int ai = 0; ai < 2; ++ai)
#pragma unroll
                    for (int m = 0; m < 4; ++m) {
                        f32x4 v0 = acc[ai][bj][m][0], v1 = acc[ai][bj][m][1];
#pragma unroll
                        for (int i = 0; i < 4; ++i) { v0[i] = fast_sigmoid(v0[i]); v1[i] = fast_sigmoid(v1[i]); }
                        *(PG8_GAS u32x4*)p = pack8(v0, v1);
                        p += (size_t)((m < 3) ? 16 : (HALF - 48)) * ld; asm volatile("" : "+v"(p));
                    }
            } else {
#pragma unroll
                for (int ai = 0; ai < 2; ++ai)
#pragma unroll
                    for (int m = 0; m < 4; ++m) {
                        *(PG8_GAS u32x4*)p = pack8(acc[ai][bj][m][0] * sc, acc[ai][bj][m][1] * sc);
                        p += (size_t)((m < 3) ? 16 : (HALF - 48)) * ld; asm volatile("" : "+v"(p));
                    }
            }
        }
    }
};

template <int MODE> struct EpiGate {
    static constexpr bool PERM = true, AFTER_DRAIN = false, MIDK = false;
    bf16_t* O; const bf16_t* T; const bf16_t* G; int ldg;
    __device__ __forceinline__ void operator()(const f32x4 (&acc)[2][2][4][2], const Unit& u, int wr, int wc, int fr_, int fq_) const {
        int fr = fr_, fq = fq_; asm volatile("" : "+v"(fr), "+v"(fq));
        const int row0 = u.pm * BM + wr * 64 + fr, col0 = u.pn * BM + wc * 32 + 8 * fq;
        const PG8_GAS bf16_t* gp = (const PG8_GAS bf16_t*)G + (size_t)row0 * ldg + col0; const PG8_GAS bf16_t* tp = (const PG8_GAS bf16_t*)T + (size_t)row0 * DM + col0;
        PG8_GAS bf16_t* op = (PG8_GAS bf16_t*)O + (size_t)row0 * DM + col0;
        u32x4 gw[2], tw[2];
#pragma unroll
        for (int bj = 0; bj < 2; ++bj) { gw[bj] = *(const PG8_GAS u32x4*)(gp + bj * HALF); if (MODE == 1) tw[bj] = *(const PG8_GAS u32x4*)(tp + bj * HALF); }
#pragma unroll
        for (int ai = 0; ai < 2; ++ai)
#pragma unroll
            for (int m = 0; m < 4; ++m) {
                const int adv = (m < 3) ? 16 : (HALF - 48); const bool lastrow = (ai == 1 && m == 3);
                const PG8_GAS bf16_t* gpn = gp + (lastrow ? 0 : (size_t)adv * ldg); const PG8_GAS bf16_t* tpn = tp + (lastrow ? 0 : (size_t)adv * DM);
                u32x4 gn[2], tn[2];
#pragma unroll
                for (int bj = 0; bj < 2; ++bj) { gn[bj] = *(const PG8_GAS u32x4*)(gpn + bj * HALF); if (MODE == 1) tn[bj] = *(const PG8_GAS u32x4*)(tpn + bj * HALF); }
#pragma unroll
                for (int bj = 0; bj < 2; ++bj) {
                    f32x4 v0 = acc[ai][bj][m][0], v1 = acc[ai][bj][m][1];
                    v0[0] *= __uint_as_float(gw[bj].x << 16); v0[1] *= __uint_as_float(gw[bj].x & 0xffff0000u); v0[2] *= __uint_as_float(gw[bj].y << 16); v0[3] *= __uint_as_float(gw[bj].y & 0xffff0000u);
                    v1[0] *= __uint_as_float(gw[bj].z << 16); v1[1] *= __uint_as_float(gw[bj].z & 0xffff0000u); v1[2] *= __uint_as_float(gw[bj].w << 16); v1[3] *= __uint_as_float(gw[bj].w & 0xffff0000u);
                    if (MODE == 1) {
                        v0[0] += __uint_as_float(tw[bj].x << 16); v0[1] += __uint_as_float(tw[bj].x & 0xffff0000u); v0[2] += __uint_as_float(tw[bj].y << 16); v0[3] += __uint_as_float(tw[bj].y & 0xffff0000u);
                        v1[0] += __uint_as_float(tw[bj].z << 16); v1[1] += __uint_as_float(tw[bj].z & 0xffff0000u); v1[2] += __uint_as_float(tw[bj].w << 16); v1[3] += __uint_as_float(tw[bj].w & 0xffff0000u); }
                    *(PG8_GAS u32x4*)(op + bj * HALF) = pack8(v0, v1); }
                op += (size_t)adv * DM; gp = gpn; tp = tpn; gw[0] = gn[0]; gw[1] = gn[1]; if (MODE == 1) { tw[0] = tn[0]; tw[1] = tn[1]; }
                asm volatile("" : "+v"(op), "+v"(gp), "+v"(tp));
            }
    }
};


struct EpiMerge {
    static constexpr bool PERM = true, AFTER_DRAIN = false, MIDK = true;
    bf16_t* O; const bf16_t* G;
    __device__ __forceinline__ void mid(f32x4 (&acc)[2][2][4][2], const Unit& u, int wr, int wc, int fr_, int fq_) const {
        int fr = fr_, fq = fq_; asm volatile("" : "+v"(fr), "+v"(fq));
        const PG8_GAS bf16_t* gp = (const PG8_GAS bf16_t*)G + (size_t)(u.pm * BM + wr * 64 + fr) * GLD + u.pn * BM + wc * 32 + 8 * fq;
        u32x4 ga[2], gb[2];
#pragma unroll
        for (int bj = 0; bj < 2; ++bj) { ga[bj] = *(const PG8_GAS u32x4*)(gp + bj * HALF); gb[bj] = *(const PG8_GAS u32x4*)(gp + 1024 + bj * HALF); }
#pragma unroll
        for (int ai = 0; ai < 2; ++ai)
#pragma unroll
            for (int m = 0; m < 4; ++m) {
                const bool lastrow = (ai == 1 && m == 3);
                const PG8_GAS bf16_t* gpn = gp + (lastrow ? 0 : (size_t)((m < 3) ? 16 : (HALF - 48)) * GLD);
                u32x4 na[2], nb[2];
#pragma unroll
                for (int bj = 0; bj < 2; ++bj) { na[bj] = *(const PG8_GAS u32x4*)(gpn + bj * HALF); nb[bj] = *(const PG8_GAS u32x4*)(gpn + 1024 + bj * HALF); }
#pragma unroll
                for (int bj = 0; bj < 2; ++bj) {
                    const unsigned gaw[4] = {ga[bj].x, ga[bj].y, ga[bj].z, ga[bj].w}, gbw[4] = {gb[bj].x, gb[bj].y, gb[bj].z, gb[bj].w};
#pragma unroll
                    for (int i = 0; i < 4; ++i) {
                        const float r0 = __uint_as_float(gaw[i] << 16) * __builtin_amdgcn_rcpf(fmaxf(__uint_as_float(gbw[i] << 16), 1e-20f)), r1 = __uint_as_float(gaw[i] & 0xffff0000u) * __builtin_amdgcn_rcpf(fmaxf(__uint_as_float(gbw[i] & 0xffff0000u), 1e-20f));
                        acc[ai][bj][m][i >> 1][2 * (i & 1)] *= r0; acc[ai][bj][m][i >> 1][2 * (i & 1) + 1] *= r1; }
                }
                gp = gpn; asm volatile("" : "+v"(gp));
#pragma unroll
                for (int bj = 0; bj < 2; ++bj) { ga[bj] = na[bj]; gb[bj] = nb[bj]; }
            }
    }
    __device__ __forceinline__ void operator()(const f32x4 (&acc)[2][2][4][2], const Unit& u, int wr, int wc, int fr_, int fq_) const {
        int fr = fr_, fq = fq_; asm volatile("" : "+v"(fr), "+v"(fq));
        const int row0 = u.pm * BM + wr * 64 + fr, col0 = u.pn * BM + wc * 32 + 8 * fq;
        const PG8_GAS bf16_t* gp = (const PG8_GAS bf16_t*)G + (size_t)row0 * GLD + 1024 + col0; PG8_GAS bf16_t* op = (PG8_GAS bf16_t*)O + (size_t)row0 * DM + col0;
        u32x4 gw[2];
#pragma unroll
        for (int bj = 0; bj < 2; ++bj) gw[bj] = *(const PG8_GAS u32x4*)(gp + bj * HALF);
#pragma unroll
        for (int ai = 0; ai < 2; ++ai)
#pragma unroll
            for (int m = 0; m < 4; ++m) {
                const int adv = (m < 3) ? 16 : (HALF - 48); const bool lastrow = (ai == 1 && m == 3);
                const PG8_GAS bf16_t* gpn = gp + (lastrow ? 0 : (size_t)adv * GLD);
                u32x4 gn[2];
#pragma unroll
                for (int bj = 0; bj < 2; ++bj) gn[bj] = *(const PG8_GAS u32x4*)(gpn + bj * HALF);
#pragma unroll
                for (int bj = 0; bj < 2; ++bj) {
                    f32x4 v0 = acc[ai][bj][m][0], v1 = acc[ai][bj][m][1];
                    v0[0] *= fmaxf(__uint_as_float(gw[bj].x << 16), 1e-20f); v0[1] *= fmaxf(__uint_as_float(gw[bj].x & 0xffff0000u), 1e-20f); v0[2] *= fmaxf(__uint_as_float(gw[bj].y << 16), 1e-20f); v0[3] *= fmaxf(__uint_as_float(gw[bj].y & 0xffff0000u), 1e-20f);
                    v1[0] *= fmaxf(__uint_as_float(gw[bj].z << 16), 1e-20f); v1[1] *= fmaxf(__uint_as_float(gw[bj].z & 0xffff0000u), 1e-20f); v1[2] *= fmaxf(__uint_as_float(gw[bj].w << 16), 1e-20f); v1[3] *= fmaxf(__uint_as_float(gw[bj].w & 0xffff0000u), 1e-20f);
                    *(PG8_GAS u32x4*)(op + bj * HALF) = pack8(v0, v1); }
                op += (size_t)adv * DM; gp = gpn; gw[0] = gn[0]; gw[1] = gn[1]; asm volatile("" : "+v"(op), "+v"(gp));
            }
    }
};

struct EpiResid {
    static constexpr bool PERM = false, AFTER_DRAIN = false, MIDK = false;
    const float* SRC; float* OUT; const float* gate;
    __device__ __forceinline__ void operator()(const f32x4 (&acc)[2][2][4][2], const Unit& u, int wr, int wc, int fr_, int fq_) const {
        int fr = fr_, fq = fq_; asm volatile("" : "+v"(fr), "+v"(fq));
        const int row0 = u.pm * BM + wr * 64 + fr, col0 = u.pn * BM + wc * 32 + 4 * fq;
        const float* gb = gate + (size_t)(u.pm / (SEQ / BM)) * 6144 + col0;
        f32x4 g[2][2];
#pragma unroll
        for (int bj = 0; bj < 2; ++bj) { g[bj][0] = *(const PG8_GAS f32x4*)(gb + bj * HALF); g[bj][1] = *(const PG8_GAS f32x4*)(gb + bj * HALF + 16); }
        const PG8_GAS float* sp = (const PG8_GAS float*)SRC + (size_t)row0 * DM + col0; PG8_GAS float* op = (PG8_GAS float*)OUT + (size_t)row0 * DM + col0;
        f32x4 sv[2][2];
#pragma unroll
        for (int bj = 0; bj < 2; ++bj) { sv[bj][0] = *(const PG8_GAS f32x4*)(sp + bj * HALF); sv[bj][1] = *(const PG8_GAS f32x4*)(sp + bj * HALF + 16); }
#pragma unroll
        for (int ai = 0; ai < 2; ++ai)
#pragma unroll
            for (int m = 0; m < 4; ++m) {
                const int adv = (m < 3) ? 16 : (HALF - 48); const bool lastrow = (ai == 1 && m == 3);
                const PG8_GAS float* spn = sp + (lastrow ? 0 : (size_t)adv * DM);
                f32x4 sn[2][2];
#pragma unroll
                for (int bj = 0; bj < 2; ++bj) { sn[bj][0] = *(const PG8_GAS f32x4*)(spn + bj * HALF); sn[bj][1] = *(const PG8_GAS f32x4*)(spn + bj * HALF + 16); }
#pragma unroll
                for (int bj = 0; bj < 2; ++bj) {
                    *(PG8_GAS f32x4*)(op + bj * HALF) = sv[bj][0] + g[bj][0] * acc[ai][bj][m][0];
                    *(PG8_GAS f32x4*)(op + bj * HALF + 16) = sv[bj][1] + g[bj][1] * acc[ai][bj][m][1]; }
                op += (size_t)adv * DM; sp = spn;
#pragma unroll
                for (int bj = 0; bj < 2; ++bj) { sv[bj][0] = sn[bj][0]; sv[bj][1] = sn[bj][1]; }
                asm volatile("" : "+v"(op), "+v"(sp));
            }
    }
};

__device__ __forceinline__ float dpp_shr1(float old, float src) { return __builtin_bit_cast(float, __builtin_amdgcn_update_dpp(__builtin_bit_cast(int, old), __builtin_bit_cast(int, src), 0x111, 0xf, 0xf, false)); }
__device__ __forceinline__ float dpp_shr2(float old, float src) { return __builtin_bit_cast(float, __builtin_amdgcn_update_dpp(__builtin_bit_cast(int, old), __builtin_bit_cast(int, src), 0x112, 0xf, 0xf, false)); }
__device__ __forceinline__ float dpp_ror1(float src) { return __builtin_bit_cast(float, __builtin_amdgcn_update_dpp(0, __builtin_bit_cast(int, src), 0x121, 0xf, 0xf, false)); }
__device__ __forceinline__ float dpp_ror2(float src) { return __builtin_bit_cast(float, __builtin_amdgcn_update_dpp(0, __builtin_bit_cast(int, src), 0x122, 0xf, 0xf, false)); }
struct EpiUpConv {
    static constexpr bool PERM = true, AFTER_DRAIN = false, MIDK = false;
    bf16_t* ACT; float* UH; float* UT; const float* cw; const float* cb;
    __device__ __forceinline__ void operator()(const f32x4 (&acc)[2][2][4][2], const Unit& u, int wr, int wc, int fr_, int fq_) const {
        int fr = fr_, fq = fq_; asm volatile("" : "+v"(fr), "+v"(fq));
        const int row0 = u.pm * BM + wr * 64 + fr, cl = wc * 32 + 8 * fq;
        const int jc = u.pn * HALF + cl;
#pragma unroll
        for (int n = 0; n < 2; ++n) {
            const float* cwp = cw + jc + 4 * n; asm volatile("" : "+v"(cwp));
            const f32x4 wa0 = *(const PG8_GAS f32x4*)(cwp), wa1 = *(const PG8_GAS f32x4*)(cwp + NUP), wa2 = *(const PG8_GAS f32x4*)(cwp + 2 * NUP), ba = *(const PG8_GAS f32x4*)(cb + jc + 4 * n);
            const f32x4 wb0 = *(const PG8_GAS f32x4*)(cwp + DFF), wb1 = *(const PG8_GAS f32x4*)(cwp + NUP + DFF), wb2 = *(const PG8_GAS f32x4*)(cwp + 2 * NUP + DFF), bb = *(const PG8_GAS f32x4*)(cb + DFF + jc + 4 * n);
            bf16_t* ap = ACT + (size_t)row0 * DFF + jc + 4 * n;
#pragma unroll
            for (int ai = 0; ai < 2; ++ai) {
#pragma unroll
                for (int m = 0; m < 4; ++m) {
                    const f32x4 a = acc[ai][0][m][n], b = acc[ai][1][m][n];
                    const f32x4 z4 = {0.f, 0.f, 0.f, 0.f};
                    const f32x4 ap_ = (m > 0) ? acc[ai][0][m > 0 ? m - 1 : 0][n] : z4, bp_ = (m > 0) ? acc[ai][1][m > 0 ? m - 1 : 0][n] : z4;
                    f32x4 res;
#pragma unroll
                    for (int i = 0; i < 4; ++i) {
                        const float a1 = dpp_shr1(dpp_ror1(ap_[i]), a[i]), a2 = dpp_shr2(dpp_ror2(ap_[i]), a[i]), b1 = dpp_shr1(dpp_ror1(bp_[i]), b[i]), b2 = dpp_shr2(dpp_ror2(bp_[i]), b[i]);
                        const float ca = ba[i] + wa0[i] * a2 + wa1[i] * a1 + wa2[i] * a[i];
                        const float cbv = bb[i] + wb0[i] * b2 + wb1[i] * b1 + wb2[i] * b[i];
                        res[i] = ca * fast_sigmoid(ca) * cbv;
                    }
                    if (!(m == 0 && fr < 2)) { u32x2 w; w.x = cvt_pk_bf16(res[0], res[1]); w.y = cvt_pk_bf16(res[2], res[3]); *(PG8_GAS u32x2*)ap = w; }
                    ap += (m < 3) ? 16 * DFF : (HALF - 48) * DFF; asm volatile("" : "+v"(ap));
                    __builtin_amdgcn_sched_barrier(0);
                }
            }
        }
#pragma unroll
        for (int ai = 0; ai < 2; ++ai) {
            const int G = (u.pm * BM + ai * HALF + wr * 64) >> 6;
            if (fr < 2) { float* p = UH + ((size_t)G * 2 + fr) * NUP + u.pn * BM + cl; asm volatile("" : "+v"(p));
#pragma unroll
                for (int bj = 0; bj < 2; ++bj) { *(PG8_GAS f32x4*)(p + bj * HALF) = acc[ai][bj][0][0]; *(PG8_GAS f32x4*)(p + bj * HALF + 4) = acc[ai][bj][0][1]; } }
            if (fr >= 14) { float* p = UT + ((size_t)G * 2 + (fr - 14)) * NUP + u.pn * BM + cl; asm volatile("" : "+v"(p));
#pragma unroll
                for (int bj = 0; bj < 2; ++bj) { *(PG8_GAS f32x4*)(p + bj * HALF) = acc[ai][bj][3][0]; *(PG8_GAS f32x4*)(p + bj * HALF + 4) = acc[ai][bj][3][1]; } }
            __builtin_amdgcn_sched_barrier(0);
        }
    }
};
template <class Epi, class Sched, bool ALIGN_EPI = false, bool SP2 = false>
__device__ __forceinline__ void gemm_phase(PG8_LAS unsigned char* lds, const Gemm g, const Sched& S, const Epi& E, int wave_in) {
    int tid_; { int ln_; asm volatile("v_mbcnt_lo_u32_b32 %0, -1, 0\n\tv_mbcnt_hi_u32_b32 %0, -1, %0" : "=v"(ln_)); tid_ = wave_in * 64 + ln_; }
    const int tid = tid_, wid = __builtin_amdgcn_readfirstlane(tid >> 6), lane = tid & 63, wr = wid >> 2, wc = wid & 3, fr = lane & 15, fq = lane >> 4;
    const int K = g.K, nt = K / BK;
    unsigned voffA[2], voffB[2];
#pragma unroll
    for (int i = 0; i < 2; ++i) { int R, C; stage_rc(tid * 16 + i * 8192, R, C); const int Rb = Epi::PERM ? ((R & ~31) + perm32(R & 31)) : R;
        voffA[i] = (unsigned)(R * K + C) * 2u; voffB[i] = (unsigned)(Rb * K + C) * 2u; }
    const size_t kstep = (size_t)(BK * 2);
    const size_t hstep = (size_t)HALF * K * 2;
    const size_t tstep = 2 * hstep;
    const unsigned ldsw = (unsigned)wid * 1024u;
    const int aoff = lds_byte(wr * 64 + fr, fq * 8), boff = lds_byte(wc * 32 + fr, fq * 8);
#define PG8_SA(b, h) (((b) * 2 + (h)) * HTB)
#define PG8_SB(b, h) ((4 + (b) * 2 + (h)) * HTB)
#define PG8_STAGE(bufoff, gbase, voff) do { _Pragma("unroll") for (int _i = 0; _i < 2; ++_i) \
        __builtin_amdgcn_global_load_lds((const unsigned*)((const char*)(gbase) + (voff)[_i]), (PG8_LAS unsigned*)(lds + (bufoff) + ldsw + _i * 8192), 16, 0, 0); } while (0)
#define PG8_LDA(dst, b, h) do { _Pragma("unroll") for (int m = 0; m < 4; ++m) _Pragma("unroll") for (int k = 0; k < 2; ++k) dst[m][k] = *(const PG8_LAS bf16x8*)(lds + PG8_SA(b, h) + aoff + m * 2048 + k * 1024); } while (0)
#define PG8_LDB(dst, b, h) do { _Pragma("unroll") for (int n = 0; n < 2; ++n) _Pragma("unroll") for (int k = 0; k < 2; ++k) dst[n][k] = *(const PG8_LAS bf16x8*)(lds + PG8_SB(b, h) + boff + n * 2048 + k * 1024); } while (0)
#define PG8_MMA(ai, bj, At, Bt) do { __builtin_amdgcn_s_setprio(1); _Pragma("unroll") for (int m = 0; m < 4; ++m) _Pragma("unroll") for (int n = 0; n < 2; ++n) _Pragma("unroll") for (int k = 0; k < 2; ++k) \
        acc[ai][bj][m][n] = __builtin_amdgcn_mfma_f32_16x16x32_bf16(Bt[n][k], At[m][k], acc[ai][bj][m][n], 0, 0, 0); __builtin_amdgcn_s_setprio(0); } while (0)
#define PG8_WAIT_V(n) asm volatile("s_waitcnt vmcnt(" #n ")" ::: "memory")
#define PG8_WAIT_L(n) asm volatile("s_waitcnt lgkmcnt(" #n ")" ::: "memory")
#define PG8_BAR __builtin_amdgcn_s_barrier()
#define PG8_SCHED __builtin_amdgcn_sched_barrier(0)
    Unit cur, nxt; int ui = 0;
    if (!S.next(0, cur)) return;
    f32x4 acc[2][2][4][2];
#pragma unroll
    for (int a = 0; a < 2; ++a)
#pragma unroll
        for (int b = 0; b < 2; ++b)
#pragma unroll
            for (int m = 0; m < 4; ++m)
#pragma unroll
                for (int n = 0; n < 2; ++n) acc[a][b][m][n] = (f32x4){0.f, 0.f, 0.f, 0.f};
    bf16x8 At[4][2], B0[2][2], B1[2][2];
    const char* cA = (const char*)g.A + (size_t)cur.pm * tstep; const char* cB = (const char*)g.Bt + (size_t)cur.pn * tstep;
    S.a_ready(cur);
    if constexpr (SP2) {
        PG8_STAGE(PG8_SB(0, 0), cB, voffB); PG8_STAGE(PG8_SB(0, 1), cB + hstep, voffB); PG8_STAGE(PG8_SA(0, 0), cA, voffA); PG8_STAGE(PG8_SA(0, 1), cA + hstep, voffA);
        if (wr == 1) PG8_BAR;
        PG8_WAIT_V(2); PG8_BAR;
        PG8_STAGE(PG8_SB(1, 0), cB + kstep, voffB); PG8_STAGE(PG8_SA(1, 0), cA + kstep, voffA); PG8_STAGE(PG8_SB(1, 1), cB + hstep + kstep, voffB);
        PG8_WAIT_V(6); PG8_BAR;
    } else {
        PG8_STAGE(PG8_SB(0, 0), cB, voffB); PG8_STAGE(PG8_SA(0, 0), cA, voffA); PG8_STAGE(PG8_SB(0, 1), cB + hstep, voffB); PG8_STAGE(PG8_SA(0, 1), cA + hstep, voffA);
        if (wr == 1) PG8_BAR;
        PG8_WAIT_V(4); PG8_BAR;
        PG8_STAGE(PG8_SB(1, 0), cB + kstep, voffB); PG8_STAGE(PG8_SA(1, 0), cA + kstep, voffA); PG8_STAGE(PG8_SB(1, 1), cB + hstep + kstep, voffB);
        PG8_WAIT_V(6); PG8_BAR;
    }
    for (;;) {
        const bool has_next = S.next(ui + 1, nxt);
        const char* nA = has_next ? (const char*)g.A + (size_t)nxt.pm * tstep : cA; const char* nB = has_next ? (const char*)g.Bt + (size_t)nxt.pn * tstep : cB;
        for (int t = 0; t < nt; t += 2) {
            if constexpr (Epi::MIDK) { if (t == (nt >> 1)) E.mid(acc, cur, wr, wc, fr, fq); }
            const bool last = (t == nt - 2);
            const char* a1 = cA + (size_t)(t + 1) * kstep;
            const char* a2 = last ? nA : cA + (size_t)(t + 2) * kstep; const char* b2 = last ? nB : cB + (size_t)(t + 2) * kstep;
            const char* a3 = a2 + kstep; const char* b3 = b2 + kstep;
            if (last && has_next) S.a_ready(nxt);
            if constexpr (SP2) {
            PG8_LDB(B0, 0, 0); PG8_LDB(B1, 0, 1); PG8_SCHED; PG8_LDA(At, 0, 0); PG8_STAGE(PG8_SA(1, 1), a1 + hstep, voffA);
            PG8_WAIT_V(8); PG8_WAIT_L(0); PG8_BAR; PG8_MMA(0, 0, At, B0); PG8_MMA(0, 1, At, B1); PG8_BAR; PG8_SCHED;
            PG8_LDA(At, 0, 1); PG8_STAGE(PG8_SB(0, 0), b2, voffB); PG8_STAGE(PG8_SB(0, 1), b2 + hstep, voffB); PG8_STAGE(PG8_SA(0, 0), a2, voffA);
            PG8_WAIT_V(8); PG8_WAIT_L(0); PG8_BAR; PG8_MMA(1, 0, At, B0); PG8_MMA(1, 1, At, B1); PG8_BAR; PG8_SCHED;
            PG8_LDB(B0, 1, 0); PG8_LDB(B1, 1, 1); PG8_SCHED; PG8_LDA(At, 1, 0); PG8_STAGE(PG8_SA(0, 1), a2 + hstep, voffA);
            PG8_WAIT_V(8); PG8_WAIT_L(0); PG8_BAR; PG8_MMA(0, 0, At, B0); PG8_MMA(0, 1, At, B1); PG8_BAR; PG8_SCHED;
            PG8_LDA(At, 1, 1); PG8_STAGE(PG8_SB(1, 0), b3, voffB); PG8_STAGE(PG8_SB(1, 1), b3 + hstep, voffB); PG8_STAGE(PG8_SA(1, 0), a3, voffA);
            PG8_WAIT_V(8); PG8_WAIT_L(0); PG8_BAR; PG8_MMA(1, 0, At, B0); PG8_MMA(1, 1, At, B1); PG8_BAR; PG8_SCHED;
            } else {
            PG8_LDB(B0, 0, 0); PG8_SCHED; PG8_LDA(At, 0, 0); PG8_STAGE(PG8_SA(1, 1), a1 + hstep, voffA);
            PG8_WAIT_L(8); PG8_BAR; PG8_WAIT_L(0); PG8_MMA(0, 0, At, B0); PG8_BAR; PG8_SCHED;
            PG8_LDB(B1, 0, 1); PG8_STAGE(PG8_SB(0, 0), b2, voffB);
            PG8_BAR; PG8_WAIT_L(0); PG8_MMA(0, 1, At, B1); PG8_BAR;
            PG8_LDA(At, 0, 1); PG8_STAGE(PG8_SA(0, 0), a2, voffA);
            PG8_BAR; PG8_WAIT_L(0); PG8_MMA(1, 0, At, B0); PG8_BAR; PG8_SCHED;
            PG8_STAGE(PG8_SB(0, 1), b2 + hstep, voffB);
            PG8_WAIT_V(6); PG8_BAR; PG8_MMA(1, 1, At, B1); PG8_BAR;
            PG8_LDB(B0, 1, 0); PG8_SCHED; PG8_LDA(At, 1, 0); PG8_STAGE(PG8_SA(0, 1), a2 + hstep, voffA);
            PG8_WAIT_L(8); PG8_BAR; PG8_WAIT_L(0); PG8_MMA(0, 0, At, B0); PG8_BAR; PG8_SCHED;
            PG8_LDB(B1, 1, 1); PG8_STAGE(PG8_SB(1, 0), b3, voffB);
            PG8_BAR; PG8_WAIT_L(0); PG8_MMA(0, 1, At, B1); PG8_BAR;
            PG8_LDA(At, 1, 1); PG8_STAGE(PG8_SA(1, 0), a3, voffA);
            PG8_BAR; PG8_WAIT_L(0); PG8_MMA(1, 0, At, B0); PG8_BAR; PG8_SCHED;
            PG8_STAGE(PG8_SB(1, 1), b3 + hstep, voffB);
            PG8_WAIT_V(6); PG8_BAR; PG8_MMA(1, 1, At, B1); PG8_BAR;
            }
        }
        if constexpr (ALIGN_EPI) { if (wr == 0) PG8_BAR; }
        if constexpr (!Epi::AFTER_DRAIN) { E(acc, cur, wr, wc, fr, fq); S.done(cur); }
        if (!has_next) break;
#pragma unroll
        for (int a = 0; a < 2; ++a)
#pragma unroll
            for (int b = 0; b < 2; ++b)
#pragma unroll
                for (int m = 0; m < 4; ++m)
#pragma unroll
                    for (int n = 0; n < 2; ++n) acc[a][b][m][n] = (f32x4){0.f, 0.f, 0.f, 0.f};
        cur = nxt; cA = nA; cB = nB; ++ui;
        if constexpr (ALIGN_EPI) { if (wr == 1) PG8_BAR; }
    }
    PG8_WAIT_V(0);
    if constexpr (!ALIGN_EPI) { if (wr == 0) PG8_BAR; }
    PG8_BAR;
    if constexpr (Epi::AFTER_DRAIN) { E.fused(acc, cur, wr, wc, fr, fq, lds, wid, lane); S.done(cur); }
#undef PG8_SA
#undef PG8_SB
#undef PG8_STAGE
#undef PG8_LDA
#undef PG8_LDB
#undef PG8_MMA
#undef PG8_WAIT_V
#undef PG8_WAIT_L
#undef PG8_BAR
#undef PG8_SCHED
}
}
#include <hip/hip_bf16.h>
#include <cmath>
namespace attn_body {
using bf16=__hip_bfloat16;
using bf16x8=__attribute__((ext_vector_type(8)))short;
using s16x4=__attribute__((ext_vector_type(4)))short;
using f32x16=__attribute__((ext_vector_type(16)))float;
using u32x4=__attribute__((ext_vector_type(4)))unsigned;
constexpr int BATCH=4,NHEAD=8,SEQ=8192,D=64,DM=NHEAD*D;
constexpr int ODM=1024; constexpr int NW=8,QBLK=32,QB=QBLK*NW,KVBLK=64,NQB=SEQ/QB;
constexpr int ATTN_PITCH=DM, ATTN_UNIT_ROWS=QB;
__device__ __forceinline__ int crow(int r,int hi){return (r&3)+8*(r>>2)+4*hi;}
#define SBAR() __builtin_amdgcn_sched_barrier(0)
__device__ __forceinline__ void cmask(f32x16&p0,f32x16&p1,int jb,int qrel,int hi){
  const float NEG=-INFINITY; int kb=64*jb+4*hi;
  #pragma unroll
  for(int r=0;r<16;++r){int kv=kb+(r&3)+8*(r>>2); if(kv>qrel)p0[r]=NEG; if(kv+32>qrel)p1[r]=NEG;}
}

constexpr int NSLOT=3, SLOTB=8192;
constexpr int LDS_K=0, LDS_V=NSLOT*SLOTB, LDS_WS=2*NSLOT*SLOTB, LDS_OST=LDS_WS+NW*64*4, LDS_BYTES=LDS_OST+NW*4096;
constexpr float C2=0.125f*1.4426950408889634f; constexpr int LDS_KB=LDS_BYTES;
__device__ __forceinline__ void glds16(const void*gsrc,unsigned lds_dst){unsigned keep;
  asm volatile("s_mov_b32 %0, m0\n\ts_mov_b32 m0, %2\n\ts_nop 0\n\tglobal_load_lds_dwordx4 %1, off\n\ts_mov_b32 m0, %0":"=&s"(keep):"v"(gsrc),"s"(lds_dst):"memory");}
__device__ __forceinline__ float max3f(float a,float b,float c){float r;asm("v_max3_f32 %0, %1, %2, %3":"=v"(r):"v"(a),"v"(b),"v"(c));return r;}
__device__ __forceinline__ float max2f(float a,float b){float r;asm("v_max_f32_e32 %0, %1, %2":"=v"(r):"v"(a),"v"(b));return r;}
__device__ __forceinline__ float fadd_s(float a,float b){float r;asm("v_add_f32_e32 %0, %1, %2":"=v"(r):"v"(a),"v"(b));return r;}
__device__ __forceinline__ float fsub_s(float a,float b){float r;asm("v_sub_f32_e32 %0, %1, %2":"=v"(r):"v"(a),"v"(b));return r;}
typedef float f32x2_t __attribute__((ext_vector_type(2))); typedef __bf16 bf16x2_t __attribute__((ext_vector_type(2)));
__device__ __forceinline__ unsigned cvtpk_s(float lo,float hi){f32x2_t v={lo,hi};bf16x2_t b=__builtin_convertvector(v,bf16x2_t);return __builtin_bit_cast(unsigned,b);}
#define WAIT_BAR(N) asm volatile("s_waitcnt vmcnt(" #N ") lgkmcnt(0)\n\ts_barrier":::"memory")

__device__ __forceinline__ void qkt(f32x16&p0,f32x16&p1,const char*Kslot,const bf16x8*qr,const f32x16&negm,int r32,int hi){
  const char*kb=Kslot+hi*1024+r32*16;
  #pragma unroll
  for(int d0=0;d0<4;++d0){
    const bf16x8 b0=*reinterpret_cast<const bf16x8*>(kb+d0*2048);
    const bf16x8 b1=*reinterpret_cast<const bf16x8*>(kb+d0*2048+512);
    if(d0==0){p0=__builtin_amdgcn_mfma_f32_32x32x16_bf16(b0,qr[0],negm,0,0,0);p1=__builtin_amdgcn_mfma_f32_32x32x16_bf16(b1,qr[0],negm,0,0,0);}
    else{p0=__builtin_amdgcn_mfma_f32_32x32x16_bf16(b0,qr[d0],p0,0,0,0);p1=__builtin_amdgcn_mfma_f32_32x32x16_bf16(b1,qr[d0],p1,0,0,0);}}
}
__device__ __forceinline__ bf16x8 bias_frag(float v,int hi){
  const unsigned h=cvtpk_s(v,0.f)&0xffffu; const float r1=v-__uint_as_float(h<<16);
  const unsigned m=cvtpk_s(r1,0.f)&0xffffu; const float r2=r1-__uint_as_float(m<<16);
  const unsigned l=cvtpk_s(r2,0.f)&0xffffu;
  u32x4 w; w.x=hi?0u:(h|(m<<16)); w.y=hi?0u:l; w.z=0u; w.w=0u; return __builtin_bit_cast(bf16x8,w);
}
typedef __attribute__((address_space(3))) const char* lds_cptr;
typedef short v4i16_t __attribute__((ext_vector_type(4)));
__device__ __forceinline__ void kload8(bf16x8*kf,lds_cptr kp){
  kf[0]=*(const __attribute__((address_space(3))) bf16x8*)(kp);      kf[1]=*(const __attribute__((address_space(3))) bf16x8*)(kp+512);
  kf[2]=*(const __attribute__((address_space(3))) bf16x8*)(kp+2048); kf[3]=*(const __attribute__((address_space(3))) bf16x8*)(kp+2560);
  kf[4]=*(const __attribute__((address_space(3))) bf16x8*)(kp+4096); kf[5]=*(const __attribute__((address_space(3))) bf16x8*)(kp+4608);
  kf[6]=*(const __attribute__((address_space(3))) bf16x8*)(kp+6144); kf[7]=*(const __attribute__((address_space(3))) bf16x8*)(kp+6656);
}
__device__ __forceinline__ void kload2(bf16x8*kf,lds_cptr kp,int j){ kf[2*j]=*(const __attribute__((address_space(3))) bf16x8*)(kp+j*2048); kf[2*j+1]=*(const __attribute__((address_space(3))) bf16x8*)(kp+j*2048+512); }
__device__ __forceinline__ s16x4 vtr(lds_cptr p){ return __builtin_bit_cast(s16x4,__builtin_amdgcn_ds_read_tr16_b64_v4i16((__attribute__((address_space(3))) v4i16_t*)p)); }
__device__ __forceinline__ float rowmax(const f32x16&p0,const f32x16&p1){
  float a=max3f(p0[0],p0[1],p1[0]),b=max3f(p0[2],p0[3],p1[1]);a=max3f(a,p1[2],p1[3]);
  #pragma unroll
  for(int r=4;r<16;r+=4){a=max3f(a,p0[r],p0[r+1]);b=max3f(b,p0[r+2],p0[r+3]);a=max3f(a,p1[r],p1[r+1]);b=max3f(b,p1[r+2],p1[r+3]);}
  const float m=max2f(a,b);
  auto rr=__builtin_amdgcn_permlane32_swap(__float_as_uint(m),__float_as_uint(m),false,false);
  return max2f(__uint_as_float(rr[0]),__uint_as_float(rr[1]));
}
__device__ __forceinline__ void pv(f32x16*o,int vb,bf16x8 pa0,bf16x8 pa1,bf16x8 pa2,bf16x8 pa3){
  #pragma unroll
  for(int d0=0;d0<2;++d0){s16x4 lo[4],hi[4];
    #pragma unroll
    for(int ks=0;ks<4;++ks){
      asm volatile("ds_read_b64_tr_b16 %0,%1 offset:%c2":"=&v"(lo[ks]):"v"(vb),"i"(d0*4096+ks*1024):"memory");
      asm volatile("ds_read_b64_tr_b16 %0,%1 offset:%c2":"=&v"(hi[ks]):"v"(vb),"i"(d0*4096+ks*1024+512):"memory");}
    asm volatile("s_waitcnt lgkmcnt(0)":::"memory");SBAR();
    #define PK(k) (bf16x8){lo[k][0],lo[k][1],lo[k][2],lo[k][3],hi[k][0],hi[k][1],hi[k][2],hi[k][3]}
    o[d0]=__builtin_amdgcn_mfma_f32_32x32x16_bf16(pa0,PK(0),o[d0],0,0,0);
    o[d0]=__builtin_amdgcn_mfma_f32_32x32x16_bf16(pa1,PK(1),o[d0],0,0,0);
    o[d0]=__builtin_amdgcn_mfma_f32_32x32x16_bf16(pa2,PK(2),o[d0],0,0,0);
    o[d0]=__builtin_amdgcn_mfma_f32_32x32x16_bf16(pa3,PK(3),o[d0],0,0,0);
    #undef PK
  }
}

#ifndef ATTN_STORE16
#define ATTN_STORE16(p,v) (*(u32x4*)(p)=(v))
#endif
template<int THRL> __device__ __forceinline__ void attn_unit(int b,int h,int qb,const bf16*Q,const bf16*__restrict__ K,const bf16*__restrict__ V,bf16*O,const float*__restrict__ CUM,const float*NRM,char*shm,int wave_in){
  int tid_; { int ln_; asm volatile("v_mbcnt_lo_u32_b32 %0, -1, 0\n\tv_mbcnt_hi_u32_b32 %0, -1, %0" : "=v"(ln_)); tid_ = wave_in * 64 + ln_; }
  const int tid=tid_,lane=tid&63,r32=lane&31,hi=lane>>5; const int wid=__builtin_amdgcn_readfirstlane(tid>>6);
  const long rowbase=(long)b*SEQ; const int q0=qb*QB;
  const __attribute__((address_space(1))) float*cu=(const __attribute__((address_space(1))) float*)(CUM+((long)b*NHEAD+h)*SEQ); const float c0=cu[q0];
  int t0;
  { const __attribute__((address_space(1))) float*nrm=(const __attribute__((address_space(1))) float*)NRM; const int bh32=(b*NHEAD+h)*32;
    float kn=(lane<=qb)?nrm[1024+bh32+lane]:0.f;
    #pragma unroll
    for(int o=1;o<64;o<<=1)kn=__builtin_fmaxf(kn,lane_read(kn,lane^o));
    const float thr=-(2.f*nrm[bh32+qb]*kn+49.f);
    int cnt=0; for(int i=lane;i<(q0+QB)/KVBLK;i+=64)cnt+=((c0-cu[KVBLK*i+KVBLK-1])*1.4426950408889634f<thr)?1:0;
    #pragma unroll
    for(int o=1;o<64;o<<=1)cnt+=(int)lane_read_u((unsigned)cnt,lane^o);
    cnt&=~1; const int lim=(q0+QB)/KVBLK-4; t0=__builtin_amdgcn_readfirstlane(cnt<lim?cnt:lim); }
  const bf16*Qw=Q+(rowbase+q0+wid*QBLK)*DM+h*D;
  const bf16*Kh=K+(rowbase+(long)t0*KVBLK)*DM+h*D,*Vh=V+(rowbase+(long)t0*KVBLK)*DM+h*D;
  const unsigned lds0=(unsigned)(uintptr_t)shm;
  float*wsf=(float*)(shm+LDS_WS)+wid*64;
  const bf16*ksrc=Kh+(long)lane*DM+wid*8;
  const bf16*vsrc=Vh+(long)(16*(wid&3)+(lane>>2))*DM+(wid>>2)*32+(lane&3)*8;
  const unsigned kdst=lds0+LDS_K+wid*1024, vdst=lds0+LDS_V+wid*1024;
  #define DMA_K(t,slot) glds16(ksrc+(long)(t)*KVBLK*DM,(unsigned)__builtin_amdgcn_readfirstlane(kdst+(slot)))
  #define DMA_V(t,slot) glds16(vsrc+(long)(t)*KVBLK*DM,(unsigned)__builtin_amdgcn_readfirstlane(vdst+(slot)))
  const int vb0=(int)(lds0+LDS_V)+((lane>>4)&1)*32+(lane&3)*8+(4*hi+((lane&15)>>2))*64;
  const char*Kbase=shm+LDS_K; bf16x8 kf[8];
  const lds_cptr shm3=(lds_cptr)shm; const lds_cptr kp0=shm3+LDS_K+hi*1024+r32*16; const lds_cptr vp0=shm3+LDS_V+((lane>>4)&1)*32+(lane&3)*8+(4*hi+((lane&15)>>2))*64;
  const int NT=(q0+QB)/KVBLK-t0;
  float*kbl=(float*)(shm+LDS_KB);
  { const int sk=t0*KVBLK;
    for(int s=tid;s<q0+QB-sk;s+=NW*64)kbl[s]=(c0-cu[s+sk])*1.4426950408889634f;
    asm volatile("s_waitcnt vmcnt(0)":::"memory"); }
  const bf16x8 ones=__builtin_bit_cast(bf16x8,(u32x4){hi?0u:0x3f803f80u,hi?0u:0x00003f80u,0u,0u});
  DMA_K(0,0);DMA_V(0,0);DMA_K(1,SLOTB);
  bf16x8 qr[4];
  #pragma unroll
  for(int d0=0;d0<4;++d0)qr[d0]=*reinterpret_cast<const bf16x8*>(&Qw[(long)r32*DM+d0*16+hi*8]);
  float mhat=0.f,l_reg=0.f;f32x16 o[2];o[0]=f32x16{};o[1]=f32x16{};f32x16 negm=f32x16{};asm volatile("":"+v"(negm));
  const int qrel=wid*QBLK+r32;
  #define CMASK(P0,P1,t) do{int jb_=(t)-(NT-4); if(jb_>=0)cmask(P0,P1,jb_,qrel,hi);}while(0)
  bool resc=false;
  #define START(P0,P1) do{ const float rm=rowmax(P0,P1); resc=false; \
    { const float dl=__builtin_fmaxf(rm,0.f); mhat=fadd_s(mhat,dl); \
      _Pragma("unroll") for(int r=0;r<16;++r){P0[r]=fsub_s(P0[r],dl);P1[r]=fsub_s(P1[r],dl);} \
      _Pragma("unroll") for(int r=0;r<16;++r)negm[r]=-mhat; asm volatile("":"+v"(negm)); } \
    _Pragma("unroll") for(int r=0;r<16;++r)P0[r]=__builtin_amdgcn_exp2f(P0[r]); }while(0)
  #define RESC() do{ if(resc){ asm volatile("s_waitcnt lgkmcnt(0)":::"memory"); \
      _Pragma("unroll") for(int d_=0;d_<2;++d_) _Pragma("unroll") for(int r=0;r<16;++r)o[d_][r]*=wsf[crow(r,hi)]; } }while(0)
  f32x16 pA0,pA1,pB0,pB1;
  int sl_prev=0,sl_cur=0,sl_next=SLOTB;
  #define ROT() do{sl_prev=sl_cur;sl_cur=sl_next;sl_next=(sl_next==(NSLOT-1)*SLOTB)?0:sl_next+SLOTB;}while(0)
  DMA_K(2,2*SLOTB);
  WAIT_BAR(3);
  qkt(pA0,pA1,Kbase,qr,negm,r32,hi);
  pA0=__builtin_amdgcn_mfma_f32_32x32x16_bf16(bias_frag(kbl[r32],hi),ones,pA0,0,0,0);pA1=__builtin_amdgcn_mfma_f32_32x32x16_bf16(bias_frag(kbl[32+r32],hi),ones,pA1,0,0,0);
  asm volatile("s_nop 15\n\ts_nop 7":"+v"(pA0),"+v"(pA1));CMASK(pA0,pA1,0);
  START(pA0,pA1);
  _Pragma("unroll") for(int r=0;r<16;++r)pA1[r]=__builtin_amdgcn_exp2f(pA1[r]);
  WAIT_BAR(0);
  DMA_K(3,0);DMA_V(1,SLOTB);
  ROT();
  kload8(kf,kp0+sl_cur);
  WAIT_BAR(2);
  s16x4 vlo[8],vhi[8]; u32x4 pw0,pw1,pw2,pw3;
  #define PKW(P,B) cvtpk_s(P[B],P[B+1])
  #define PAF(k) __builtin_bit_cast(bf16x8,pw##k)
  #define VFR(i) (bf16x8){vlo[i][0],vlo[i][1],vlo[i][2],vlo[i][3],vhi[i][0],vhi[i][1],vhi[i][2],vhi[i][3]}
  #define PIN(x) asm volatile("":"+v"(x))
  #define MX3(a,b,c) __builtin_fmaxf(__builtin_fmaxf((a),(b)),(c))
  #define GAPA(MF,A0,A1,A2,A3,W0,W1,PW) do{ MF; sacc+=A0; sacc+=A1; sacc+=A2; sacc+=A3; PIN(sacc); W0; W1; PIN(PW); SBAR(); }while(0)
  #define EX(v) __builtin_amdgcn_exp2f(v)
  #define GAPB(MF,X,B) do{ MF; X[B]=EX(X[B]); X[B+1]=EX(X[B+1]); X[B+2]=EX(X[B+2]); X[B+3]=EX(X[B+3]); PIN(X); SBAR(); }while(0)
  #define VRD(i) do{ vlo[i]=vtr(vp_+(((i)>>2)*4096+((i)&3)*1024)); vhi[i]=vtr(vp_+(((i)>>2)*4096+((i)&3)*1024+512)); }while(0)
  #define KRD(G,j) do{ if(G){ kload2(kf,kp0+sl_next,j); SBAR(); } }while(0)
  #define STEP(C0,C1,P0,P1,t,GK,GV,GL) do{ SBAR(); \
    const lds_cptr vp_=vp0+sl_prev; \
    const bf16x8 kbf0_=bias_frag(kbl[(t)*KVBLK+r32],hi), kbf1_=bias_frag(kbl[(t)*KVBLK+32+r32],hi); \
    VRD(0); SBAR(); float sacc=(P0[0]+P0[1]); \
    GAPA(C0=__builtin_amdgcn_mfma_f32_32x32x16_bf16(kf[0],qr[0],negm,0,0,0), P0[2],P0[3],P0[4],P0[5],     pw0[0]=PKW(P0,0), pw0[1]=PKW(P0,2), pw0); \
    VRD(4); SBAR(); GAPA(C1=__builtin_amdgcn_mfma_f32_32x32x16_bf16(kf[1],qr[0],negm,0,0,0), P0[6],P0[7],P0[8],P0[9],     pw0[2]=PKW(P0,4), pw0[3]=PKW(P0,6), pw0); \
    VRD(1); SBAR(); GAPA(C0=__builtin_amdgcn_mfma_f32_32x32x16_bf16(kf[2],qr[1],C0,0,0,0),   P0[10],P0[11],P0[12],P0[13], pw1[0]=PKW(P0,8), pw1[1]=PKW(P0,10), pw1); \
    VRD(5); SBAR(); GAPA(C1=__builtin_amdgcn_mfma_f32_32x32x16_bf16(kf[3],qr[1],C1,0,0,0),   P0[14],P0[15],P1[0],P1[1],   pw1[2]=PKW(P0,12),pw1[3]=PKW(P0,14), pw1); \
    VRD(2); SBAR(); GAPA(C0=__builtin_amdgcn_mfma_f32_32x32x16_bf16(kf[4],qr[2],C0,0,0,0),   P1[2],P1[3],P1[4],P1[5],     pw2[0]=PKW(P1,0), pw2[1]=PKW(P1,2), pw2); \
    VRD(6); SBAR(); GAPA(C1=__builtin_amdgcn_mfma_f32_32x32x16_bf16(kf[5],qr[2],C1,0,0,0),   P1[6],P1[7],P1[8],P1[9],     pw2[2]=PKW(P1,4), pw2[3]=PKW(P1,6), pw2); \
    VRD(3); SBAR(); GAPA(C0=__builtin_amdgcn_mfma_f32_32x32x16_bf16(kf[6],qr[3],C0,0,0,0),   P1[10],P1[11],P1[12],P1[13], pw3[0]=PKW(P1,8), pw3[1]=PKW(P1,10), pw3); \
    VRD(7); SBAR(); GAPA(C1=__builtin_amdgcn_mfma_f32_32x32x16_bf16(kf[7],qr[3],C1,0,0,0),   P1[14],P1[15],0.f,0.f,       pw3[2]=PKW(P1,12),pw3[3]=PKW(P1,14), pw3); \
    C0=__builtin_amdgcn_mfma_f32_32x32x16_bf16(kbf0_,ones,C0,0,0,0); C1=__builtin_amdgcn_mfma_f32_32x32x16_bf16(kbf1_,ones,C1,0,0,0); \
    l_reg+=sacc; \
    if(GK){DMA_K((t)+3,sl_cur);} if(GV){DMA_V((t)+1,sl_next);} \
    CMASK(C0,C1,t); \
    { float a=MX3(C0[0],C0[1],C1[0]),b=MX3(C0[2],C0[3],C1[1]); a=MX3(a,C1[2],C1[3]); \
      _Pragma("unroll") for(int r=4;r<16;r+=4){a=MX3(a,C0[r],C0[r+1]);b=MX3(b,C0[r+2],C0[r+3]);a=MX3(a,C1[r],C1[r+1]);b=MX3(b,C1[r+2],C1[r+3]);} \
      float rm=__builtin_fmaxf(a,b); { auto rr=__builtin_amdgcn_permlane32_swap(__float_as_uint(rm),__float_as_uint(rm),false,false); rm=__builtin_fmaxf(__uint_as_float(rr[0]),__uint_as_float(rr[1])); } \
      resc=false; \
      if(__builtin_expect(__any(rm>(float)THRL),0)){ const float dl=__builtin_fmaxf(rm,0.f); mhat+=dl; \
        _Pragma("unroll") for(int r=0;r<16;++r){C0[r]-=dl;C1[r]-=dl;} \
        _Pragma("unroll") for(int r=0;r<16;++r)negm[r]=-mhat; asm volatile("":"+v"(negm)); \
        const float f=__builtin_amdgcn_exp2f(-dl); l_reg*=f; if(hi==0)wsf[r32]=f; resc=true; } } \
    SBAR(); \
    GAPB(o[0]=__builtin_amdgcn_mfma_f32_32x32x16_bf16(PAF(0),VFR(0),o[0],0,0,0), C0,0); \
    GAPB(o[1]=__builtin_amdgcn_mfma_f32_32x32x16_bf16(PAF(0),VFR(4),o[1],0,0,0), C0,4); \
    KRD(GL,0); GAPB(o[0]=__builtin_amdgcn_mfma_f32_32x32x16_bf16(PAF(1),VFR(1),o[0],0,0,0), C0,8); \
    KRD(GL,1); GAPB(o[1]=__builtin_amdgcn_mfma_f32_32x32x16_bf16(PAF(1),VFR(5),o[1],0,0,0), C0,12); \
    KRD(GL,2); GAPB(o[0]=__builtin_amdgcn_mfma_f32_32x32x16_bf16(PAF(2),VFR(2),o[0],0,0,0), C1,0); \
    KRD(GL,3); GAPB(o[1]=__builtin_amdgcn_mfma_f32_32x32x16_bf16(PAF(2),VFR(6),o[1],0,0,0), C1,4); \
    GAPB(o[0]=__builtin_amdgcn_mfma_f32_32x32x16_bf16(PAF(3),VFR(3),o[0],0,0,0), C1,8); \
    GAPB(o[1]=__builtin_amdgcn_mfma_f32_32x32x16_bf16(PAF(3),VFR(7),o[1],0,0,0), C1,12); \
    }while(0)
  int t=1;
  #undef CMASK
  #define CMASK(P0,P1,t) do{}while(0)
  for(;t+5<NT;t+=2){
    STEP(pB0,pB1,pA0,pA1,t,true,true,true);     WAIT_BAR(2); RESC(); ROT();
    STEP(pA0,pA1,pB0,pB1,t+1,true,true,true);   WAIT_BAR(2); RESC(); ROT();
  }
  #undef CMASK
  #define CMASK(P0,P1,t) do{int jb_=(t)-(NT-4); if(jb_>=0)cmask(P0,P1,jb_,qrel,hi);}while(0)
  #define ENDW(tt) do{ if((tt)+3<NT){WAIT_BAR(2);} else if((tt)+2<NT){WAIT_BAR(1);} else {WAIT_BAR(0);} }while(0)
  for(;t+1<NT;t+=2){
    STEP(pB0,pB1,pA0,pA1,t,(t+3<NT),(t+1<NT),(t+1<NT));       ENDW(t);   RESC(); ROT();
    STEP(pA0,pA1,pB0,pB1,t+1,(t+4<NT),(t+2<NT),(t+2<NT));     ENDW(t+1); RESC(); ROT();
  }
  STEP(pB0,pB1,pA0,pA1,NT-1,false,false,false); RESC();
  { float sacc=pB0[0]+pB0[1]; _Pragma("unroll") for(int r=2;r<16;++r)sacc+=pB0[r]; _Pragma("unroll") for(int r=0;r<16;++r)sacc+=pB1[r]; l_reg+=sacc;
    pw0=(u32x4){PKW(pB0,0),PKW(pB0,2),PKW(pB0,4),PKW(pB0,6)};pw1=(u32x4){PKW(pB0,8),PKW(pB0,10),PKW(pB0,12),PKW(pB0,14)};pw2=(u32x4){PKW(pB1,0),PKW(pB1,2),PKW(pB1,4),PKW(pB1,6)};pw3=(u32x4){PKW(pB1,8),PKW(pB1,10),PKW(pB1,12),PKW(pB1,14)};
    SBAR(); pv(o,vb0+sl_cur,PAF(0),PAF(1),PAF(2),PAF(3)); }
  #undef PKW
  #undef PAF
  #undef VFR
  #undef PIN
  #undef MX3
  #undef GAPA
  #undef GAPB
  #undef EX
  #undef VRD
  #undef KRD
  #undef STEP
  #undef ENDW
  {auto rr=__builtin_amdgcn_permlane32_swap(__float_as_uint(l_reg),__float_as_uint(l_reg),false,false);l_reg=__uint_as_float(rr[0])+__uint_as_float(rr[1]);}
  if(hi==0)wsf[32+r32]=l_reg;asm volatile("s_waitcnt lgkmcnt(0)":::"memory");
  float rli[16];
  #pragma unroll
  for(int r=0;r<16;++r)rli[r]=__builtin_amdgcn_rcpf(wsf[32+crow(r,hi)]);
  bf16*Ow=O+(rowbase+q0+wid*QBLK)*ODM+h*D;
  { bf16*stg=(bf16*)(shm+LDS_OST)+wid*2048;
    #pragma unroll
    for(int r=0;r<16;++r){const int orow=crow(r,hi);
      #pragma unroll
      for(int d0=0;d0<2;++d0)stg[orow*64+d0*32+r32]=__float2bfloat16(o[d0][r]*rli[r]);}
    asm volatile("s_waitcnt lgkmcnt(0)":::"memory");
    #pragma unroll
    for(int i=0;i<4;++i){const int row=i*8+(lane>>3),ch=lane&7; const u32x4 v=*(const u32x4*)(stg+row*64+ch*8); ATTN_STORE16(Ow+(long)row*ODM+ch*8,v);} }
  asm volatile("s_waitcnt lgkmcnt(0)\n\ts_barrier":::"memory");
  #undef DMA_K
  #undef DMA_V
  #undef CMASK
  #undef START
  #undef RESC
  #undef ROT
}
constexpr int ATTN_LDS_BYTES=LDS_BYTES+SEQ*4;
struct AttnTensors { const bf16* Q; const bf16* K; const bf16* V; bf16* O; const float* CUM; const float* NRM; };
struct AttnUnit { int bh; int qb; };
struct StaticOrder {
  int vcu;
  __device__ __forceinline__ explicit StaticOrder(int grid,int block):vcu((block%8)*(grid/8)+block/8){}
  __device__ __forceinline__ bool next(int i,AttnUnit&u)const{ if(i>=4)return false; const int s=vcu&7; u.bh=vcu>>3; u.qb=(i==0)?s:(i==1)?15-s:(i==2)?16+s:31-s; return true; }
  __device__ __forceinline__ void a_ready(const AttnUnit&)const{}
  __device__ __forceinline__ void done(const AttnUnit&)const{}
};
template<class Sched,int THRL=8> __device__ __forceinline__ void attn_phase(char*lds,const AttnTensors&T,const Sched&S,int wave_in){
  AttnUnit u;
  for(int i=0;S.next(i,u);++i){ S.a_ready(u); attn_unit<THRL>(u.bh/NHEAD,u.bh%NHEAD,u.qb,T.Q,T.K,T.V,T.O,T.CUM,T.NRM,lds,wave_in); S.done(u); }
}
#undef SBAR
#undef WAIT_BAR
}
namespace dsa {
typedef __attribute__((address_space(3))) unsigned char* ldsp;
typedef float f32x16 __attribute__((ext_vector_type(16)));
typedef float f32x4 __attribute__((ext_vector_type(4)));
typedef short bf16x8 __attribute__((ext_vector_type(8)));
typedef short s16x4 __attribute__((ext_vector_type(4)));
typedef unsigned u32x4 __attribute__((ext_vector_type(4)));
typedef unsigned u32x2 __attribute__((ext_vector_type(2)));
typedef unsigned short bf16;
#define DLAS __attribute__((address_space(3)))
#define DGAS __attribute__((address_space(1)))
constexpr int NBIN = 512, CAP2 = 192, TOPK = 256;
constexpr int L_LBK = 64 * CAP2 * 4;
constexpr int L_HIST = 0;
constexpr int L_LISTA = 73728;
constexpr int L_CNTA = L_LISTA + 32768, L_CNTB = L_CNTA + 256, L_THR = L_CNTB + 256, L_R = L_THR + 256, L_NSEL = L_R + 256, L_LSUM = L_NSEL + 256, L_POOLC = L_LSUM + 512, L_END = L_POOLC + 16;
constexpr int POOLCAP = 8192;
constexpr int VST = 144;
static_assert(8 * 64 * VST <= L_LISTA && 64 * CAP2 * 6 <= L_LISTA && 64 * NBIN * 2 <= L_LISTA && L_END <= 131072, "dsa LDS map");

__device__ __forceinline__ int score_bin(float s, int e0) {
    const unsigned u = __float_as_uint(s);
    int rel = (int)((u >> 19) & 0xFFFu) - e0; rel = rel < 0 ? 0 : (rel > 255 ? 255 : rel);
    return ((int)u < 0) ? 255 - rel : 256 + rel;
}
__device__ __forceinline__ float fmac_s(float a, float b, float acc) { asm("v_fmac_f32_e32 %0, %1, %2" : "+v"(acc) : "v"(a), "v"(b)); return acc; }
__device__ __forceinline__ float bin_edge(int b, int e0) {
    if (b >= 257) { const int r = b - 256; if (r > 255) return INFINITY; int E = e0 + r; if (E <= 0) return 0.f; if (E > 0xFF0) E = 0xFF0; return __uint_as_float((unsigned)E << 19); }
    if (b == 256) return 0.f;
    const int rp = 255 - b; if (rp >= 255) return -INFINITY;
    const int E = e0 + rp + 1; if (E <= 0) return 0.f; if (E > 0xFF0) return -3.402823466e38f;
    return __uint_as_float(0x80000000u | (((unsigned)E << 19) - 1u));
}
__device__ __forceinline__ void abs_fma8(f32x4& s0, f32x4& s1, const f32x4& a0, const f32x4& a1, float wh) {
    asm volatile("s_nop 7\n\tv_fma_f32 %0, |%8|, %16, %0\n\tv_fma_f32 %1, |%9|, %16, %1\n\tv_fma_f32 %2, |%10|, %16, %2\n\tv_fma_f32 %3, |%11|, %16, %3\n\t"
                 "v_fma_f32 %4, |%12|, %16, %4\n\tv_fma_f32 %5, |%13|, %16, %5\n\tv_fma_f32 %6, |%14|, %16, %6\n\tv_fma_f32 %7, |%15|, %16, %7"
                 : "+v"(s0[0]), "+v"(s0[1]), "+v"(s0[2]), "+v"(s0[3]), "+v"(s1[0]), "+v"(s1[1]), "+v"(s1[2]), "+v"(s1[3])
                 : "v"(a0[0]), "v"(a0[1]), "v"(a0[2]), "v"(a0[3]), "v"(a1[0]), "v"(a1[1]), "v"(a1[2]), "v"(a1[3]), "v"(wh));
}
__device__ __forceinline__ float relu_i(float x) { const int b = __builtin_bit_cast(int, x); return __builtin_bit_cast(float, b > 0 ? b : 0); }
__device__ __forceinline__ bool ahead(float sj, unsigned ij, float si, unsigned ii) { return sj > si || (sj == si && ij < ii); }

template <bool PASS2>
__device__ __forceinline__ void score_tile(ldsp L, DGAS u32x2* pool, const bf16x8 (&kf)[2][2], int j, int qloc, int g, const bf16x8 (&qf)[8][2], const bf16x8 (&ql)[2], const float (&w)[8], int e0, float tauA, float tauB) {
    const f32x4 z4 = {0.f, 0.f, 0.f, 0.f};
    f32x4 sc0 = z4, sc1 = z4;
#pragma unroll
    for (int ks = 0; ks < 2; ++ks) { sc0 = __builtin_amdgcn_mfma_f32_16x16x32_bf16(kf[0][ks], ql[ks], sc0, 0, 0, 0); sc1 = __builtin_amdgcn_mfma_f32_16x16x32_bf16(kf[1][ks], ql[ks], sc1, 0, 0, 0); }
#pragma unroll
    for (int h = 0; h < 8; ++h) {
        f32x4 a0 = z4, a1 = z4;
#pragma unroll
        for (int ks = 0; ks < 2; ++ks) { a0 = __builtin_amdgcn_mfma_f32_16x16x32_bf16(kf[0][ks], qf[h][ks], a0, 0, 0, 0); a1 = __builtin_amdgcn_mfma_f32_16x16x32_bf16(kf[1][ks], qf[h][ks], a1, 0, 0, 0); }
        abs_fma8(sc0, sc1, a0, a1, w[h]);
    }
    if (!PASS2) {
#pragma unroll
        for (int k = 0; k < 8; ++k) { const int bin = score_bin((k >> 2) ? sc1[k & 3] : sc0[k & 3], e0);
            __hip_atomic_fetch_add((DLAS unsigned*)(L + L_HIST + qloc * (NBIN * 2)) + (bin >> 1), 1u << ((bin & 1) << 4), __ATOMIC_RELAXED, __HIP_MEMORY_SCOPE_WORKGROUP); }
    } else {
        unsigned mA = 0u, mB = 0u;
#pragma unroll
        for (int k = 0; k < 8; ++k) { const float x = (k >> 2) ? sc1[k & 3] : sc0[k & 3]; mA |= (x >= tauA) ? (1u << k) : 0u; mB |= (x >= tauB && !(x >= tauA)) ? (1u << k) : 0u; }
        if (mA) {
            unsigned pos = __hip_atomic_fetch_add((DLAS unsigned*)(L + L_CNTA) + qloc, (unsigned)__builtin_popcount(mA), __ATOMIC_RELAXED, __HIP_MEMORY_SCOPE_WORKGROUP);
            DLAS unsigned short* la = (DLAS unsigned short*)(L + L_LISTA) + qloc * TOPK;
#pragma unroll
            for (int k = 0; k < 8; ++k) if (mA & (1u << k)) { if (pos < (unsigned)TOPK) la[pos] = (unsigned short)(32 * j + 16 * (k >> 2) + 4 * g + (k & 3)); ++pos; }
        }
        if (mB) {
            unsigned pos = __hip_atomic_fetch_add((DLAS unsigned*)(L + L_CNTB) + qloc, (unsigned)__builtin_popcount(mB), __ATOMIC_RELAXED, __HIP_MEMORY_SCOPE_WORKGROUP);
            DLAS float* lbs = (DLAS float*)(L + L_HIST) + qloc * CAP2; DLAS unsigned short* lbk = (DLAS unsigned short*)(L + L_LBK) + qloc * CAP2;
#pragma unroll
            for (int k = 0; k < 8; ++k) if (mB & (1u << k)) { const float xs = (k >> 2) ? sc1[k & 3] : sc0[k & 3]; const unsigned key = (unsigned)(32 * j + 16 * (k >> 2) + 4 * g + (k & 3));
                if (pos < (unsigned)CAP2) { lbs[pos] = xs; lbk[pos] = (unsigned short)key; }
                else { const unsigned gp = __hip_atomic_fetch_add((DLAS unsigned*)(L + L_POOLC), 1u, __ATOMIC_RELAXED, __HIP_MEMORY_SCOPE_WORKGROUP); if (gp < (unsigned)POOLCAP) pool[gp] = (u32x2){__float_as_uint(xs), ((unsigned)qloc << 16) | key}; }
                ++pos; }
        }
    }
}
template <bool PASS2>
__device__ __forceinline__ void score_pass(ldsp L, DGAS u32x2* pool, const DGAS bf16* __restrict__ KIb, int NT, int kh, int qloc, int n16, int g, const bf16x8 (&qf)[8][2], const bf16x8 (&ql)[2], const float (&w)[8], int e0, float tauA, float tauB) {
    const int nIt = (NT - kh + 1) >> 1;
    const DGAS bf16* kb = KIb + (size_t)(32 * kh + n16) * 64 + 8 * g;
    bf16x8 k0[2][2], k1[2][2], k2[2][2];
#define DSA_LOADK(KF, IT) do { const int it_ = (IT) < nIt ? (IT) : nIt - 1; const DGAS bf16* p_ = kb + (size_t)it_ * (64 * 64); \
        _Pragma("unroll") for (int t = 0; t < 2; ++t) _Pragma("unroll") for (int ks = 0; ks < 2; ++ks) KF[t][ks] = *(const DGAS bf16x8*)(p_ + t * 16 * 64 + 32 * ks); } while (0)
    DSA_LOADK(k0, 0); DSA_LOADK(k1, 1);
    for (int it = 0; it < nIt; it += 3) {
        DSA_LOADK(k2, it + 2); score_tile<PASS2>(L, pool, k0, kh + 2 * it, qloc, g, qf, ql, w, e0, tauA, tauB);
        if (it + 1 < nIt) { DSA_LOADK(k0, it + 3); score_tile<PASS2>(L, pool, k1, kh + 2 * it + 2, qloc, g, qf, ql, w, e0, tauA, tauB); }
        if (it + 2 < nIt) { DSA_LOADK(k1, it + 4); score_tile<PASS2>(L, pool, k2, kh + 2 * it + 4, qloc, g, qf, ql, w, e0, tauA, tauB); }
    }
#undef DSA_LOADK
}

struct Tensors { const DGAS bf16* QI; const DGAS bf16* KI; const DGAS float* WI; const DGAS bf16* QA; const DGAS bf16* KA; const DGAS bf16* VA; DGAS bf16* OA; const DGAS float* KMAX; };

__device__ __forceinline__ void unit(ldsp L, unsigned char* wsb, int b, int c, int wave_in) {
    asm volatile("" : "+s"(wsb));
    const Tensors T{(const DGAS bf16*)(wsb + WS_QI), (const DGAS bf16*)(wsb + WS_KI), (const DGAS float*)(wsb + WS_WI), (const DGAS bf16*)(wsb + WS_QA), (const DGAS bf16*)(wsb + WS_KA), (const DGAS bf16*)(wsb + WS_VA), (DGAS bf16*)(wsb + WS_OB), (const DGAS float*)(wsb + WS_CUM + MiB)};
    int tid_; { int ln_; asm volatile("v_mbcnt_lo_u32_b32 %0, -1, 0\n\tv_mbcnt_hi_u32_b32 %0, -1, %0" : "=v"(ln_)); tid_ = wave_in * 64 + ln_; }
    const int tid = tid_, lane = tid & 63, wave = __builtin_amdgcn_readfirstlane(tid >> 6);
    const int N = 64 * (c + 1), t0 = 64 * c;
    DGAS u32x2* const pool = (DGAS u32x2*)(wsb + WS_H) + (size_t)blockIdx.x * POOLCAP;
    const size_t rowb = (size_t)b * 8192;
#ifndef REP_DSA_IDX
#define REP_DSA_IDX 1
#endif
#ifndef REP_DSA_ATT
#define REP_DSA_ATT 1
#endif
    for (int rep_i = 0; rep_i < REP_DSA_IDX; ++rep_i) {
    for (int i = tid; i < 64 * 6; i += 512) ((DLAS unsigned*)(L + L_CNTA))[i] = 0u;
    if (tid == 0) *(DLAS unsigned*)(L + L_POOLC) = 0u;
    if (N > TOPK) { u32x4 z4u = {0u, 0u, 0u, 0u}; asm volatile("" : "+v"(z4u)); for (int i = tid; i < 64 * NBIN / 2 / 4; i += 512) ((DLAS u32x4*)(L + L_HIST))[i] = z4u; }
    __syncthreads();
    if (N > TOPK) {
        const int n16 = lane & 15, g = lane >> 4, qsub = wave & 3, kh = wave >> 2, qloc = 16 * qsub + n16;
        const size_t rowq = rowb + t0 + qloc;
        bf16x8 qf[8][2]; float w[8];
#pragma unroll
        for (int h = 0; h < 8; ++h)
#pragma unroll
            for (int ks = 0; ks < 2; ++ks) qf[h][ks] = *(const DGAS bf16x8*)(T.QI + rowq * 512 + h * 64 + 32 * ks + 8 * g);
        { const f32x4 w0 = *(const DGAS f32x4*)(T.WI + rowq * 8), w1 = *(const DGAS f32x4*)(T.WI + rowq * 8 + 4);
          w[0] = w0[0]; w[1] = w0[1]; w[2] = w0[2]; w[3] = w0[3]; w[4] = w1[0]; w[5] = w1[1]; w[6] = w1[2]; w[7] = w1[3]; }
        float U = 0.f;
#pragma unroll
        for (int h = 0; h < 8; ++h) { float n2 = 0.f;
#pragma unroll
            for (int ks = 0; ks < 2; ++ks)
#pragma unroll
                for (int e = 0; e < 8; ++e) { const float x = __uint_as_float(((unsigned)(unsigned short)qf[h][ks][e]) << 16); n2 = fmaf(x, x, n2); }
            n2 += lane_read(n2, lane ^ 16); n2 += lane_read(n2, lane ^ 32);
            U += fabsf(w[h]) * sqrtf(n2); }
        U *= T.KMAX[b] * 1.01f;
        bf16x8 ql[2];
#pragma unroll
        for (int h = 0; h < 8; ++h) w[h] *= 0.5f;
#pragma unroll
        for (int ks = 0; ks < 2; ++ks) { float acc8[8];
#pragma unroll
            for (int e = 0; e < 8; ++e) { float a = 0.f;
#pragma unroll
                for (int h = 0; h < 8; ++h) a = fmaf(w[h], __uint_as_float(((unsigned)(unsigned short)qf[h][ks][e]) << 16), a);
                acc8[e] = a; }
            u32x4 pk; pk.x = attn_body::cvtpk_s(acc8[0], acc8[1]); pk.y = attn_body::cvtpk_s(acc8[2], acc8[3]); pk.z = attn_body::cvtpk_s(acc8[4], acc8[5]); pk.w = attn_body::cvtpk_s(acc8[6], acc8[7]);
            ql[ks] = __builtin_bit_cast(bf16x8, pk); }
        const int e0 = (int)((__float_as_uint(U) >> 19) & 0xFFFu) + 1 - 255;
        const int NT = N / 32;
        score_pass<false>(L, pool, T.KI + rowb * 64, NT, kh, qloc, n16, g, qf, ql, w, e0, 0.f, 0.f);
        __syncthreads();
        { int lane_t = lane; asm volatile("" : "+v"(lane_t)); const int lane = lane_t;
        for (int qq = 0; qq < 8; ++qq) {
            const int q = 8 * wave + qq;
            const u32x4 hw = *((DLAS u32x4*)(L + L_HIST + q * (NBIN * 2)) + lane);
            unsigned cb[8] = {hw.x & 0xffffu, hw.x >> 16, hw.y & 0xffffu, hw.y >> 16, hw.z & 0xffffu, hw.z >> 16, hw.w & 0xffffu, hw.w >> 16};
            unsigned tot = 0;
#pragma unroll
            for (int k = 0; k < 8; ++k) tot += cb[k];
            unsigned suf = tot;
#pragma unroll
            for (int o = 1; o < 64; o <<= 1) { const unsigned t = lane_read_u(suf, (lane + o) & 63); if (lane + o < 64) suf += t; }
            const unsigned above = suf - tot;
            if (above < (unsigned)TOPK && suf >= (unsigned)TOPK) {
                unsigned run = above; int bsel = 8 * lane, found = 0;
#pragma unroll
                for (int k = 7; k >= 0; --k) { if (!found) { if (run + cb[k] >= (unsigned)TOPK) { bsel = 8 * lane + k; found = 1; } else run += cb[k]; } }
                ((DLAS int*)(L + L_THR))[q] = bsel; ((DLAS int*)(L + L_R))[q] = TOPK - (int)run;
            }
        }
        }
        __syncthreads();
        const int thr = ((DLAS int*)(L + L_THR))[qloc];
        __syncthreads();
        score_pass<true>(L, pool, T.KI + rowb * 64, NT, kh, qloc, n16, g, qf, ql, w, e0, bin_edge(thr + 1, e0), bin_edge(thr, e0));
        __syncthreads();
        for (int qq = 0; qq < 8; ++qq) {
            const int q = 8 * wave + qq;
            const unsigned nBraw = ((DLAS unsigned*)(L + L_CNTB))[q]; const int nB = nBraw < (unsigned)CAP2 ? (int)nBraw : CAP2;
            const int R = ((DLAS int*)(L + L_R))[q]; const int base = TOPK - R;
            const DLAS float* lbs = (const DLAS float*)(L + L_HIST) + q * CAP2; const DLAS unsigned short* lbk = (const DLAS unsigned short*)(L + L_LBK) + q * CAP2;
            float s0 = 0.f, s1 = 0.f, s2 = 0.f; unsigned i0 = 0u, i1 = 0u, i2 = 0u;
            if (lane < nB) { s0 = lbs[lane]; i0 = lbk[lane]; }
            if (lane + 64 < nB) { s1 = lbs[lane + 64]; i1 = lbk[lane + 64]; }
            if (lane + 128 < nB) { s2 = lbs[lane + 128]; i2 = lbk[lane + 128]; }
            int rk0 = 0, rk1 = 0, rk2 = 0;
            for (int j = 0; j < nB; ++j) { const float sj = lbs[j]; const unsigned ij = lbk[j];
                rk0 += ahead(sj, ij, s0, i0) ? 1 : 0; rk1 += ahead(sj, ij, s1, i1) ? 1 : 0; rk2 += ahead(sj, ij, s2, i2) ? 1 : 0; }
            DLAS unsigned short* la = (DLAS unsigned short*)(L + L_LISTA) + q * TOPK;
            int ntot = nB;
            if (nBraw > (unsigned)CAP2) {
                const unsigned pcr = *(const DLAS unsigned*)(L + L_POOLC); const int np = pcr < (unsigned)POOLCAP ? (int)pcr : POOLCAP;
                for (int p = 0; p < np; ++p) { const unsigned long long e = __hip_atomic_load((DGAS unsigned long long*)(pool + p), __ATOMIC_RELAXED, __HIP_MEMORY_SCOPE_AGENT);
                    const unsigned tg = (unsigned)(e >> 32); if ((tg >> 16) != (unsigned)q) continue; const float sj = __uint_as_float((unsigned)e); const unsigned ij = tg & 0xffffu; ++ntot;
                    rk0 += ahead(sj, ij, s0, i0) ? 1 : 0; rk1 += ahead(sj, ij, s1, i1) ? 1 : 0; rk2 += ahead(sj, ij, s2, i2) ? 1 : 0; }
                for (int p0 = 0; p0 < np; p0 += 64) {
                    const int p = p0 + lane; unsigned long long e = 0ull; if (p < np) e = __hip_atomic_load((DGAS unsigned long long*)(pool + p), __ATOMIC_RELAXED, __HIP_MEMORY_SCOPE_AGENT);
                    const unsigned tg = (unsigned)(e >> 32); const bool mine = (p < np) && ((tg >> 16) == (unsigned)q); const float si = __uint_as_float((unsigned)e); const unsigned ii = tg & 0xffffu;
                    int rk = 0;
                    for (int j = 0; j < nB; ++j) rk += ahead(lbs[j], lbk[j], si, ii) ? 1 : 0;
                    for (int j = 0; j < np; ++j) { const unsigned long long f = __hip_atomic_load((DGAS unsigned long long*)(pool + j), __ATOMIC_RELAXED, __HIP_MEMORY_SCOPE_AGENT);
                        const unsigned tf = (unsigned)(f >> 32); if ((tf >> 16) == (unsigned)q) rk += ahead(__uint_as_float((unsigned)f), tf & 0xffffu, si, ii) ? 1 : 0; }
                    if (mine && rk < R) la[base + rk] = (unsigned short)ii;
                }
            }
            if (lane < nB && rk0 < R) la[base + rk0] = (unsigned short)i0;
            if (lane + 64 < nB && rk1 < R) la[base + rk1] = (unsigned short)i1;
            if (lane + 128 < nB && rk2 < R) la[base + rk2] = (unsigned short)i2;
            if (lane == 0) ((DLAS int*)(L + L_NSEL))[q] = base + (ntot < R ? ntot : R);
        }
    } else {
        for (int i = tid; i < 64 * TOPK; i += 512) ((DLAS unsigned short*)(L + L_LISTA))[i] = (unsigned short)(i & (TOPK - 1));
        if (tid < 64) ((DLAS int*)(L + L_NSEL))[tid] = N;
    }
    __syncthreads();
    }
    {
        int lane_a = lane; asm volatile("" : "+v"(lane_a));
        const int lane = lane_a, n16 = lane & 15, g = lane >> 4, q4 = n16 >> 2, p4 = lane & 3;
        ldsp vst = L + L_HIST + wave * (64 * VST);
        const attn_body::lds_cptr vrd = (attn_body::lds_cptr)(vst + (4 * g + q4) * VST + 4 * p4 * 2);
        const DGAS bf16* KAb = T.KA + rowb * 64; const DGAS bf16* VAb = T.VA + rowb * 64;
        const int vsl = lane >> 3, vch = lane & 7;
        for (int qq = 0; qq < 8 * REP_DSA_ATT; ++qq) {
            const int q = 8 * wave + (qq & 7); const size_t row = rowb + t0 + q;
            const int nsel = ((DLAS int*)(L + L_NSEL))[q];
            const DLAS unsigned short* la = (const DLAS unsigned short*)(L + L_LISTA) + q * TOPK;
            u32x4 vr[8];
#pragma unroll
            for (int i = 0; i < 8; ++i) { const int slot = 8 * i + vsl; const int key = (slot < nsel) ? (int)la[slot] : 0; vr[i] = *(const DGAS u32x4*)(KAb + (size_t)key * 64 + 8 * vch); }
            const bf16x8 zf = {0, 0, 0, 0, 0, 0, 0, 0};
            bf16x8 qb0 = zf, qb1 = zf;
            if (n16 < 8) { qb0 = *(const DGAS bf16x8*)(T.QA + row * 512 + n16 * 64 + 8 * g); qb1 = *(const DGAS bf16x8*)(T.QA + row * 512 + n16 * 64 + 32 + 8 * g); }
            f32x4 sa[16];
#pragma unroll
            for (int cst = 0; cst < 4; ++cst) {
#pragma unroll
                for (int i = 0; i < 8; ++i) *(DLAS u32x4*)(vst + (8 * i + vsl) * VST + vch * 16) = vr[i];
#pragma unroll
                for (int i = 0; i < 8; ++i) { const int slot = ((cst < 3) ? 64 * (cst + 1) : 0) + 8 * i + vsl; const int key = (slot < nsel) ? (int)la[slot] : 0;
                    vr[i] = *(const DGAS u32x4*)(((cst < 3) ? KAb : VAb) + (size_t)key * 64 + 8 * vch); }
#pragma unroll
                for (int t4 = 0; t4 < 4; ++t4) {
                    const bf16x8 a0 = *(const DLAS bf16x8*)(vst + (16 * t4 + n16) * VST + 16 * g), a1 = *(const DLAS bf16x8*)(vst + (16 * t4 + n16) * VST + 64 + 16 * g);
                    f32x4 s = {0.f, 0.f, 0.f, 0.f};
                    s = __builtin_amdgcn_mfma_f32_16x16x32_bf16(a0, qb0, s, 0, 0, 0);
                    s = __builtin_amdgcn_mfma_f32_16x16x32_bf16(a1, qb1, s, 0, 0, 0);
                    sa[4 * cst + t4] = s;
                }
            }
            float m = -INFINITY;
#pragma unroll
            for (int tt = 0; tt < 16; ++tt)
#pragma unroll
                for (int i = 0; i < 4; ++i) { if (16 * tt + 4 * g + i >= nsel) sa[tt][i] = -INFINITY; m = fmaxf(m, sa[tt][i]); }
            m = fmaxf(m, lane_read(m, lane ^ 16)); m = fmaxf(m, lane_read(m, lane ^ 32));
            float ls = 0.f;
#pragma unroll
            for (int tt = 0; tt < 16; ++tt)
#pragma unroll
                for (int i = 0; i < 4; ++i) { const float p = __builtin_amdgcn_exp2f(sa[tt][i] - m); sa[tt][i] = p; ls += p; }
            ls += lane_read(ls, lane ^ 16); ls += lane_read(ls, lane ^ 32);
            if (g == 0) ((DLAS float*)(L + L_LSUM))[wave * 16 + n16] = ls;
            f32x4 o[4];
#pragma unroll
            for (int nb = 0; nb < 4; ++nb) o[nb] = (f32x4){0.f, 0.f, 0.f, 0.f};
#pragma unroll
            for (int cst = 0; cst < 4; ++cst) {
#pragma unroll
                for (int i = 0; i < 8; ++i) *(DLAS u32x4*)(vst + (8 * i + vsl) * VST + vch * 16) = vr[i];
                if (cst < 3) {
#pragma unroll
                    for (int i = 0; i < 8; ++i) { const int slot = 64 * (cst + 1) + 8 * i + vsl; const int key = (slot < nsel) ? (int)la[slot] : 0; vr[i] = *(const DGAS u32x4*)(VAb + (size_t)key * 64 + 8 * vch); }
                }
#pragma unroll
                for (int s2 = 0; s2 < 2; ++s2) {
                    const int s = 2 * cst + s2;
                    u32x4 pw; pw.x = attn_body::cvtpk_s(sa[2 * s][0], sa[2 * s][1]); pw.y = attn_body::cvtpk_s(sa[2 * s][2], sa[2 * s][3]);
                    pw.z = attn_body::cvtpk_s(sa[2 * s + 1][0], sa[2 * s + 1][1]); pw.w = attn_body::cvtpk_s(sa[2 * s + 1][2], sa[2 * s + 1][3]);
                    const bf16x8 pa = __builtin_bit_cast(bf16x8, pw);
#pragma unroll
                    for (int nb = 0; nb < 4; ++nb) {
                        const s16x4 t1 = attn_body::vtr(vrd + (32 * s2) * VST + 32 * nb), t2 = attn_body::vtr(vrd + (32 * s2 + 16) * VST + 32 * nb);
                        const bf16x8 vb = {t1[0], t1[1], t1[2], t1[3], t2[0], t2[1], t2[2], t2[3]};
                        o[nb] = __builtin_amdgcn_mfma_f32_16x16x32_bf16(pa, vb, o[nb], 0, 0, 0);
                    }
                }
            }
            if (g < 2) {
                const f32x4 lv = *(const DLAS f32x4*)(L + L_LSUM + (wave * 16 + 4 * g) * 4);
#pragma unroll
                for (int i = 0; i < 4; ++i) { const float li = __builtin_amdgcn_rcpf(lv[i]);
#pragma unroll
                    for (int nb = 0; nb < 4; ++nb) T.OA[row * 1024 + (4 * g + i) * 64 + 16 * nb + n16] = (bf16)(attn_body::cvtpk_s(o[nb][i] * li, 0.f) & 0xffffu); }
            }
        }
    }
    __syncthreads();
}
#undef DLAS
#undef DGAS
}

constexpr int NWAVES = 8, NTHR = NWAVES * 64;
#define GAS __attribute__((address_space(1)))
#define LAS __attribute__((address_space(3)))
typedef unsigned short bf16;
typedef unsigned v4u __attribute__((ext_vector_type(4)));
typedef float f32x4 __attribute__((ext_vector_type(4)));
typedef short bf16x8 __attribute__((ext_vector_type(8)));
typedef GAS unsigned gu32;
#define RLX_AGENT __ATOMIC_RELAXED, __HIP_MEMORY_SCOPE_AGENT
#define LDS_WAIT() asm volatile("s_waitcnt lgkmcnt(0)" ::: "memory")
#define VM_WAIT() asm volatile("s_waitcnt vmcnt(0)" ::: "memory")
__device__ __forceinline__ unsigned f2bf(float f) { unsigned u = __builtin_bit_cast(unsigned, f); return (u + 0x7fffu + ((u >> 16) & 1u)) >> 16; }
__device__ __forceinline__ unsigned pk2(float lo, float hi) { return f2bf(lo) | (f2bf(hi) << 16); }

constexpr int RING_BYTES = 131072;
constexpr int LDSCTL_OFF = RING_BYTES, MISC_OFF = LDSCTL_OFF + 320;
constexpr int LDS_BYTES = 147456;
#define XB_TMO      128
#define XB_XCNT(j)  (256  + 64 * (j))
#define XB_XSUB(j)  (1280 + 64 * (j))
#define XB_XGEN(j)  (2304 + 64 * (j))
#define XB_TOP      3328
#define XB_TOPGEN   3392
#define XCD_BAR_WORDS 3456
#define XB_SPIN_CAP (1u << 18)

__device__ __forceinline__ unsigned xb_ld(unsigned* p)              { return __hip_atomic_load(p, __ATOMIC_RELAXED, __HIP_MEMORY_SCOPE_AGENT); }
__device__ __forceinline__ unsigned xb_add(unsigned* p, unsigned v) { return __hip_atomic_fetch_add(p, v, __ATOMIC_RELAXED, __HIP_MEMORY_SCOPE_AGENT); }
__device__ __forceinline__ unsigned xb_xcc_id() { return (unsigned)__builtin_amdgcn_s_getreg((3 << 11) | 20) & 0xFu; }
#define XB_SPIN(cond, bar) do { unsigned _sp = 0; while (cond) { __builtin_amdgcn_s_sleep(1); \
    if ((++_sp & 255u) == 0u) { if (xb_ld(&(bar)[XB_TMO])) break; if (_sp > XB_SPIN_CAP) { atomicAdd(&(bar)[XB_TMO], 1u); break; } } } } while (0)

struct XcdBarrier {
    unsigned* bar; unsigned x;
    volatile LAS unsigned* st;
};

__device__ __forceinline__ XcdBarrier xcd_barrier_post(unsigned* bar, volatile LAS unsigned* st, bool tid0) {
    XcdBarrier b; b.bar = bar; b.x = xb_xcc_id(); b.st = st;
    if (tid0) (void)xb_add(&bar[XB_XCNT(b.x)], 1u);
    return b;
}
__device__ __forceinline__ void xcd_barrier_complete(unsigned* bar, unsigned x, unsigned& nloc, unsigned& nx) {
    const unsigned G = gridDim.x * gridDim.y * gridDim.z;
    unsigned sum, cnt, mine, sp = 0u;
    for (;;) {
        sum = 0u; cnt = 0u; mine = 0u;
#pragma unroll
        for (unsigned j = 0; j < 16; ++j) { const unsigned c = xb_ld(&bar[XB_XCNT(j)]); sum += c; cnt += (c > 0u) ? 1u : 0u; mine = (j == x) ? c : mine; }
        if (sum == G) break;
        __builtin_amdgcn_s_sleep(1);
        if ((++sp & 255u) == 0u) { if (xb_ld(&bar[XB_TMO])) break; if (sp > XB_SPIN_CAP) { atomicAdd(&bar[XB_TMO], 1u); break; } }
    }
    nloc = mine > 0u ? mine : 1u; nx = cnt > 0u ? cnt : 1u;
}

__device__ __forceinline__ void xcd_barrier(const XcdBarrier& b, bool tid0) {
    asm volatile("s_waitcnt vmcnt(0)" ::: "memory");
    __syncthreads();
    if (tid0) {
        unsigned* bar = b.bar;
        __builtin_amdgcn_s_waitcnt(0);
        unsigned nloc = b.st[0], nx = b.st[1];
        if (nloc == 0u) { xcd_barrier_complete(bar, b.x, nloc, nx); b.st[0] = nloc; b.st[1] = nx; }
        const unsigned old = xb_add(&bar[XB_XSUB(b.x)], 1u);
        const unsigned gen = old / nloc;
        if (old + 1u == (gen + 1u) * nloc) {
            __builtin_amdgcn_fence(__ATOMIC_RELEASE, "agent");
            asm volatile("s_waitcnt vmcnt(0)" ::: "memory");
            const unsigned og = xb_add(&bar[XB_TOP], 1u);
            const unsigned tg = og / nx;
            if (og + 1u == (tg + 1u) * nx) xb_add(&bar[XB_TOPGEN], 1u);
            else XB_SPIN(xb_ld(&bar[XB_TOPGEN]) == tg, bar);
            __builtin_amdgcn_fence(__ATOMIC_ACQUIRE, "agent");
            xb_add(&bar[XB_XGEN(b.x)], 1u);
            asm volatile("s_waitcnt vmcnt(0)" ::: "memory");
        } else {
            XB_SPIN(xb_ld(&bar[XB_XGEN(b.x)]) == gen, bar);
            __builtin_amdgcn_fence(__ATOMIC_ACQUIRE, "agent");
            asm volatile("s_waitcnt vmcnt(0)" ::: "memory");
        }
    }
    __syncthreads();
}

__device__ __forceinline__ float wave_sum(float v, int lane) {
#pragma unroll
    for (int o = 1; o < 64; o <<= 1) v += lane_read(v, lane ^ o);
    return v;
}
__device__ __forceinline__ int ropeperm(int j) { return j < 4 ? j : j < 8 ? j + 4 : j < 12 ? j - 4 : j; }
template <int MAP> __device__ __forceinline__ int src_col(int n) {
    if (MAP == 0) return n;
    if (MAP == 2) { const int pn = n >> 8, w = n & 255; return w < 128 ? 128 * pn + w : DFF + 128 * pn + (w - 128); }
    const int t = n >> 8, w = n & 255;
    if (t < 2) return (n & ~63) + ropeperm(n & 63);
    if (t == 2) { if (w < 64) return 512 + ropeperm(w); if (w < 128) return 576 + (w - 64); if (w < 192) return 1152 + ropeperm(w - 128);
                  const int s = w - 192; return s < 8 ? 1216 + s : s < 16 ? 2760 + (s - 8) : -1; }
    if (t < 5) { const int hc = n - 768; return 640 + (hc & ~63) + ropeperm(hc & 63); }
    if (t < 7) return 1224 + (n - 1280);
    if (t < 9) return 1736 + (n - 1792);
    if (t < 11) return 2248 + (n - 2304);
    return 2768 + (n - 2816);
}
template <int MAP> __device__ __forceinline__ void transpose_item(const float* W, int K, int Nsrc, int Ndst, bf16* WT, LAS float* scr, int item, int lane, int ldk = 0, int kofs = 0) {
    if (ldk == 0) ldk = K;
    const int nblk = Ndst / 32, kb = item / nblk, nb = item % nblk, k0 = 64 * kb, n0 = 32 * nb;
    const int sc = src_col<MAP>(n0 + (lane & 31));
#pragma unroll 8
    for (int i = 0; i < 32; ++i) { const int kk = 2 * i + (lane >> 5); scr[kk * 33 + (lane & 31)] = sc >= 0 ? ((const GAS float*)W)[(size_t)(k0 + kk) * Nsrc + sc] : 0.f; }
    LDS_WAIT(); asm volatile("" ::: "memory");
    const int c = lane & 7;
#pragma unroll
    for (int j = 0; j < 4; ++j) { const int n = (lane >> 3) + 8 * j; const LAS float* s = scr + (8 * c) * 33 + n;
        v4u o; o.x = pk2(s[0 * 33], s[1 * 33]); o.y = pk2(s[2 * 33], s[3 * 33]); o.z = pk2(s[4 * 33], s[5 * 33]); o.w = pk2(s[6 * 33], s[7 * 33]);
        *(GAS v4u*)(WT + (size_t)(n0 + n) * ldk + kofs + k0 + 8 * c) = o; }
    LDS_WAIT(); asm volatile("" ::: "memory");
}
__device__ __forceinline__ void cos_sin_acc(float angf, float& co, float& si) {
    const double a = (double)angf, k = rint(a * 0.63661977236758134308), r = fma(-k, 6.123233995736766e-17, fma(-k, 1.5707963267948966, a)), r2 = r * r;
    double s = -1.0 / 39916800.0; s = fma(s, r2, 1.0 / 362880.0); s = fma(s, r2, -1.0 / 5040.0); s = fma(s, r2, 1.0 / 120.0); s = fma(s, r2, -1.0 / 6.0); s = fma(s * r2, r, r);
    double c = 1.0 / 479001600.0; c = fma(c, r2, -1.0 / 3628800.0); c = fma(c, r2, 1.0 / 40320.0); c = fma(c, r2, -1.0 / 720.0); c = fma(c, r2, 1.0 / 24.0); c = fma(c, r2, -0.5); c = fma(c, r2, 1.0);
    const int q = (int)((long long)k & 3);
    const double cc = (q == 0) ? c : (q == 1) ? -s : (q == 2) ? -c : s, ss = (q == 0) ? s : (q == 1) ? c : (q == 2) ? -s : -c;
    co = (float)cc; si = (float)ss;
}
__device__ __forceinline__ void load_vec16(const float* p, int lane, f32x4 (&v)[4]) {
#pragma unroll
    for (int j = 0; j < 4; ++j) v[j] = *((const GAS f32x4*)p + lane + 64 * j);
}

#ifndef MK_ONE_LAUNCH
#define MK_ONE_LAUNCH 1
#endif
#ifndef REP_FOX
#define REP_FOX 1
#endif
#ifndef REP_DSA
#define REP_DSA 1
#endif
#ifndef REP_INPROJ
#define REP_INPROJ 1
#endif
#ifndef REP_UP
#define REP_UP 1
#endif
#ifndef MK_STEP
#define MK_STEP 3
#endif
constexpr int NPL = 10, PH_FINAL = 1 + DEPTH * NPL, N_PHASES = PH_FINAL + 1;
struct Args { const float* in[17]; float* out; unsigned char* ws; int ph_lo, ph_hi, use_bar, pad; };
__global__ void __launch_bounds__(NTHR, 2) mk_fwd(Args args) {
    extern __shared__ __attribute__((aligned(16))) unsigned char lds[];
    LAS unsigned char* const L = (LAS unsigned char*)lds;
    volatile LAS unsigned* const MISC = (volatile LAS unsigned*)(L + MISC_OFF); (void)MISC;
#define PHASE_IDS() int tid; { int ws_ = wave_s, ln_; asm volatile("v_mbcnt_lo_u32_b32 %0, -1, 0\n\tv_mbcnt_hi_u32_b32 %0, -1, %0" : "=v"(ln_)); asm volatile("" : "+s"(ws_)); tid = ws_ * 64 + ln_; } int bx = blockIdx.x; asm volatile("" : "+s"(bx)); int G = (int)gridDim.x; asm volatile("" : "+s"(G)); \
    unsigned char* ws_l = args.ws; asm volatile("" : "+s"(ws_l)); unsigned char* const ws = ws_l; float* outp_l = args.out; asm volatile("" : "+s"(outp_l)); float* const outp = outp_l; \
    float* const MOD = (float*)(ws + WS_MOD); float* const CS = (float*)(ws + WS_CS); bf16* const H = (bf16*)(ws + WS_H); \
    const int lane = tid & 63, wave = __builtin_amdgcn_readfirstlane(tid >> 6), vcu = (G % 8 == 0) ? (bx % 8) * (G / 8) + bx / 8 : bx, gw = vcu * NWAVES + wave, NGW = G * NWAVES; \
    (void)lane; (void)wave; (void)vcu; (void)gw; (void)NGW; (void)MOD; (void)CS; (void)H; (void)outp
    const int wave_s = __builtin_amdgcn_readfirstlane((int)threadIdx.x >> 6);
    for (int u = wave_s * 64 + (int)__builtin_amdgcn_mbcnt_hi(~0u, __builtin_amdgcn_mbcnt_lo(~0u, 0u)); u < (LDS_BYTES - LDSCTL_OFF) / 4; u += NTHR) ((LAS unsigned*)(L + LDSCTL_OFF))[u] = 0u;
    __syncthreads();
#if MK_ONE_LAUNCH
    (void)xcd_barrier_post((unsigned*)((gu32*)(args.ws + WS_CTL) + CW_BAR), MISC + 8, wave_s == 0 && __builtin_amdgcn_mbcnt_hi(~0u, __builtin_amdgcn_mbcnt_lo(~0u, 0u)) == 0);
#define IN(k) true
#define GRID_BAR() do { unsigned char* wb_ = args.ws; asm volatile("" : "+s"(wb_)); XcdBarrier bar_; bar_.bar = (unsigned*)((gu32*)(wb_ + WS_CTL) + CW_BAR); bar_.x = xb_xcc_id(); bar_.st = (volatile LAS unsigned*)(L + MISC_OFF) + 8; int ln0_; asm volatile("v_mbcnt_lo_u32_b32 %0, -1, 0\n\tv_mbcnt_hi_u32_b32 %0, -1, %0" : "=v"(ln0_)); xcd_barrier(bar_, wave_s == 0 && ln0_ == 0); } while (0)
#else
    const int lo = args.ph_lo, hi = args.ph_hi;
#define IN(k) (lo <= (k) && (k) < hi)
#define GRID_BAR() do { } while (0)
#endif

#define KA_PTR() ({ const char __attribute__((address_space(4)))* kp_ = (const char __attribute__((address_space(4)))*)__builtin_amdgcn_kernarg_segment_ptr(); asm volatile("" : "+s"(kp_)); kp_; })
#define KIN(kp, k) (*(const float* const __attribute__((address_space(4)))*)((kp) + 8 * (k)))

    if (IN(0)) {
        const int l = 0; PHASE_IDS(); const float* const modl = MOD + (size_t)l * NB * 6144; (void)modl;
        {
            LAS float* cl = (LAS float*)L;
            LAS float* red = (LAS float*)(L + 16384);
            const char __attribute__((address_space(4)))* kp = KA_PTR(); const float* cin = KIN(kp, 1); const float* modw = KIN(kp, 3); const float* modb = KIN(kp, 4);
            bool loaded = false;
            for (int un = bx; un < DEPTH * 96; un += G) {
                if (!loaded) { for (int i = tid; i < NB * DM; i += NTHR) cl[i] = ((const GAS float*)cin)[i]; loaded = true; }
                __syncthreads();
                const int l = un / 96, col = (un % 96) * 64 + (tid & 63), kg = tid >> 6;
                const float* W = modw + (size_t)l * DM * 6144 + col;
                float a0 = 0.f, a1 = 0.f, a2 = 0.f, a3 = 0.f;
#pragma unroll 8
                for (int k = kg * 128; k < kg * 128 + 128; ++k) { const float w = ((const GAS float*)W)[(size_t)k * 6144]; a0 += cl[k] * w; a1 += cl[DM + k] * w; a2 += cl[2 * DM + k] * w; a3 += cl[3 * DM + k] * w; }
                red[(kg * 4 + 0) * 64 + (tid & 63)] = a0; red[(kg * 4 + 1) * 64 + (tid & 63)] = a1; red[(kg * 4 + 2) * 64 + (tid & 63)] = a2; red[(kg * 4 + 3) * 64 + (tid & 63)] = a3;
                __syncthreads();
                if (tid < 256) { const int b = tid >> 6, j = tid & 63; float s = 0.f;
#pragma unroll
                    for (int g = 0; g < 8; ++g) s += red[(g * 4 + b) * 64 + j];
                    const int cc = (un % 96) * 64 + j;
                    ((GAS float*)MOD)[((size_t)l * NB + b) * 6144 + cc] = s + ((const GAS float*)modb)[(size_t)l * 6144 + cc]; }
                __syncthreads();
            }
            __syncthreads();
        }
        {
            const char __attribute__((address_space(4)))* kp = KA_PTR(); const int* pos = (const int*)KIN(kp, 2);
            for (int i = (vcu * NTHR + tid); i < MTOK * 8; i += G * NTHR) {
                const int row = i >> 3, j = i & 7;
                const float invf = (j == 0) ? 1.0f : (j == 1) ? 0.19392274f : (j == 2) ? 0.03760603f : (j == 3) ? 0.0072926646f : (j == 4) ? 0.0014142136f : (j == 5) ? 0.0002742482f : (j == 6) ? 5.3182957e-05f : 1.0313385e-05f;
                const float ang = (float)((const GAS int*)pos)[row] * invf;
                float co, si; cos_sin_acc(ang, co, si);
                { typedef float f32x2g __attribute__((ext_vector_type(2))); *(GAS f32x2g*)(CS + (size_t)i * 2) = (f32x2g){co, si}; }
            }
        }
        {
            const char __attribute__((address_space(4)))* kp = KA_PTR();
            LAS float* scr = (LAS float*)(L + wave * 16384);
            constexpr int I_IN = (DM / 64) * (NIN / 32), I_A = (WSP / 64) * (DM / 32), I_O = (DM / 64) * (DM / 32), I_UP = (DM / 64) * (NUP / 32), I_D = (DFF / 64) * (DM / 32);
            constexpr int I_L = I_IN + 2 * I_A + I_O + I_UP + I_D;
            for (int it = gw; it < DEPTH * I_L; it += NGW) {
                const int l = it / I_L; int r = it % I_L;
                if (r < I_IN) { transpose_item<1>(KIN(kp, 7) + (size_t)l * DM * NIN_SRC, DM, NIN_SRC, NIN, (bf16*)(ws + WS_WIN + l * WIN_L), scr, r, lane); continue; } r -= I_IN;
                if (r < I_A) { transpose_item<0>(KIN(kp, 9) + (size_t)l * WSP * DM, WSP, DM, DM, (bf16*)(ws + WS_WA + l * 2 * WA_L), scr, r, lane, DM, 0); continue; } r -= I_A;
                if (r < I_A) { transpose_item<0>(KIN(kp, 10) + (size_t)l * WSP * DM, WSP, DM, DM, (bf16*)(ws + WS_WA + l * 2 * WA_L), scr, r, lane, DM, WSP); continue; } r -= I_A;
                if (r < I_O) { transpose_item<0>(KIN(kp, 11) + (size_t)l * DM * DM, DM, DM, DM, (bf16*)(ws + WS_WO + l * WO_L), scr, r, lane); continue; } r -= I_O;
                if (r < I_UP) { transpose_item<2>(KIN(kp, 12) + (size_t)l * DM * NUP, DM, NUP, NUP, (bf16*)(ws + WS_WUP + l * WUP_L), scr, r, lane); continue; } r -= I_UP;
                transpose_item<0>(KIN(kp, 15) + (size_t)l * DFF * DM, DFF, DM, DM, (bf16*)(ws + WS_WD + l * WD_L), scr, r, lane);
            }
        }
        GRID_BAR();
    }

    for (int l = 0; l < DEPTH; ++l) {
        const int pb = 1 + l * NPL;
#if MK_STEP < 2
        if (IN(pb + 5)) {
            PHASE_IDS(); const float* const modl = MOD + (size_t)l * NB * 6144; (void)modl;
            if (l == 0) { const float* x_in = KIN(KA_PTR(), 0); for (size_t i = (size_t)vcu * NTHR + tid; i < (size_t)MTOK * DM / 4; i += (size_t)G * NTHR) ((GAS f32x4*)outp)[i] = ((const GAS f32x4*)x_in)[i]; }
            GRID_BAR();
        }
#else
        if (IN(pb + 0)) {
            PHASE_IDS(); const float* const modl = MOD + (size_t)l * NB * 6144; (void)modl;
            const char __attribute__((address_space(4)))* kp = KA_PTR();
            const float* g = KIN(kp, 5) + (size_t)l * DM; const float* xs = (l == 0) ? KIN(kp, 0) : outp;
            constexpr int RPW = MTOK / (256 * NWAVES);
            for (int r0 = gw * RPW; r0 < MTOK; r0 += NGW * RPW) {
                const int b = r0 / SEQ; const float* mb = modl + (size_t)b * 6144;
                f32x4 gv[4], scv[4], shv[4]; load_vec16(g, lane, gv); load_vec16(mb + 1024, lane, scv); load_vec16(mb, lane, shv);
#pragma unroll
                for (int j = 0; j < 4; ++j) gv[j] = gv[j] * (scv[j] + 1.0f);
                for (int r = r0; r < r0 + RPW; ++r) {
                    f32x4 v[4]; load_vec16(xs + (size_t)r * DM, lane, v); float s = 0.f;
#pragma unroll
                    for (int j = 0; j < 4; ++j) s += (v[j].x * v[j].x + v[j].y * v[j].y) + (v[j].z * v[j].z + v[j].w * v[j].w);
                    const float rstd = rsqrtf(wave_sum(s, lane) * (1.f / DM) + EPS);
                    GAS unsigned long long* o8 = (GAS unsigned long long*)(H + (size_t)r * DM) + lane;
#pragma unroll
                    for (int j = 0; j < 4; ++j) { const f32x4 y = v[j] * rstd * gv[j] + shv[j]; o8[64 * j] = (unsigned long long)pk2(y.x, y.y) | ((unsigned long long)pk2(y.z, y.w) << 32); }
                }
            }
            GRID_BAR();
        }
        if (IN(pb + 1)) {
            PHASE_IDS(); const float* const modl = MOD + (size_t)l * NB * 6144; (void)modl;
            pg8::Gemm g{H, (const bf16*)(ws + WS_WIN + l * WIN_L), MTOK, NIN, DM}; pg8::StaticOrder S; S.init(MTOK, NIN, G, bx);
            pg8::EpiInProj E{ws, CS, KIN(KA_PTR(), 8) + (size_t)l * 8};
            for (int rep = 0; rep < REP_INPROJ; ++rep) pg8::gemm_phase<pg8::EpiInProj, pg8::StaticOrder, true, true>(L, g, S, E, wave_s);
            GRID_BAR();
        }
        if (IN(pb + 2)) {
            PHASE_IDS(); const float* const modl = MOD + (size_t)l * NB * 6144; (void)modl;
            const float* LOGF = (const float*)(ws + WS_LOGF); float* CUM = (float*)(ws + WS_CUM);
            {
                GAS float* NRM = (GAS float*)(ws + WS_CUM + MiB + 4096);
                for (int jb = gw; jb < 2048; jb += NGW) {
                    const int idx = jb & 1023, b = idx >> 8, h = (idx >> 5) & 7, qb = idx & 31;
                    const bf16* P = (const bf16*)(ws + ((jb >> 10) ? WS_KF : WS_QF)) + ((size_t)b * SEQ + 256 * qb + 4 * lane) * 512 + h * 64; float mx = 0.f;
#pragma unroll
                    for (int r = 0; r < 4; ++r) { float n2 = 0.f;
#pragma unroll
                        for (int c8 = 0; c8 < 8; ++c8) { const v4u wv = *(const GAS v4u*)(P + (size_t)r * 512 + 8 * c8); const unsigned ww[4] = {wv.x, wv.y, wv.z, wv.w};
#pragma unroll
                            for (int e = 0; e < 4; ++e) { const float a = __uint_as_float(ww[e] << 16), bb = __uint_as_float(ww[e] & 0xffff0000u); n2 = fmaf(a, a, n2); n2 = fmaf(bb, bb, n2); } }
                        mx = fmaxf(mx, n2); }
#pragma unroll
                    for (int o = 1; o < 64; o <<= 1) mx = fmaxf(mx, lane_read(mx, lane ^ o));
                    if (lane == 0) NRM[jb] = sqrtf(mx) * 1.0001f;
                }
            }
            LAS float* wtot = (LAS float*)L;
            for (int sq = bx; sq < NB * 8 + NB; sq += G) {
                if (sq >= NB * 8) {
                    const int b = sq - NB * 8; const bf16* KI = (const bf16*)(ws + WS_KI) + (size_t)b * SEQ * 64; float mx = 0.f;
                    for (int k = tid * 16; k < tid * 16 + 16; ++k) { float n2 = 0.f;
#pragma unroll
                        for (int c8 = 0; c8 < 8; ++c8) { const v4u wv = *(const GAS v4u*)(KI + (size_t)k * 64 + 8 * c8);
                            const unsigned ww[4] = {wv.x, wv.y, wv.z, wv.w};
#pragma unroll
                            for (int e = 0; e < 4; ++e) { const float a = __uint_as_float(ww[e] << 16), bb = __uint_as_float(ww[e] & 0xffff0000u); n2 = fmaf(a, a, n2); n2 = fmaf(bb, bb, n2); } }
                        mx = fmaxf(mx, n2); }
#pragma unroll
                    for (int o = 1; o < 64; o <<= 1) mx = fmaxf(mx, lane_read(mx, lane ^ o));
                    if (lane == 0) wtot[wave] = mx;
                    __syncthreads();
                    if (tid == 0) { float m2 = wtot[0]; for (int w = 1; w < NWAVES; ++w) m2 = fmaxf(m2, wtot[w]); ((GAS float*)(ws + WS_CUM + MiB))[b] = sqrtf(m2); }
                    __syncthreads();
                    continue;
                }
                const int b = sq >> 3, h = sq & 7; float v[16]; float run = 0.f;
#pragma unroll
                for (int i = 0; i < 16; ++i) { run += ((const GAS float*)LOGF)[((size_t)b * SEQ + tid * 16 + i) * 8 + h]; v[i] = run; }
                float inc = run;
#pragma unroll
                for (int o = 1; o < 64; o <<= 1) { const float t = lane_read(inc, (lane - o) & 63); if (lane >= o) inc += t; }
                if (lane == 63) wtot[wave] = inc;
                __syncthreads();
                float base = inc - run;
                for (int w = 0; w < wave; ++w) base += wtot[w];
                float* o = CUM + (size_t)sq * SEQ + tid * 16;
#pragma unroll
                for (int i = 0; i < 16; i += 4) *(GAS f32x4*)(o + i) = (f32x4){v[i] + base, v[i + 1] + base, v[i + 2] + base, v[i + 3] + base};
                __syncthreads();
            }
            GRID_BAR();
        }
        if (IN(pb + 3)) {
            PHASE_IDS(); const float* const modl = MOD + (size_t)l * NB * 6144; (void)modl;
            gu32* const qctr = (gu32*)(ws + WS_CTL) + 8192 + 64 * l;
            volatile LAS unsigned* const qslot = (volatile LAS unsigned*)(L + MISC_OFF) + 12;
            for (;;) {
                if (tid == 0) *qslot = __hip_atomic_fetch_add(qctr, 1u, __ATOMIC_RELAXED, __HIP_MEMORY_SCOPE_AGENT);
                __syncthreads();
                const int u = (int)*qslot;
                __syncthreads();
                if (u >= 1536) break;
                if (u < 512) {
#if MK_STEP >= 3
                    dsa::unit(L, ws, u & 3, 127 - (u >> 2), wave_s);
#endif
                } else {
                    const int r = u - 512, qb = 31 - (r >> 5), bh = r & 31;
                    attn_body::attn_unit<8>(bh >> 3, bh & 7, qb, (const attn_body::bf16*)(ws + WS_QF), (const attn_body::bf16*)(ws + WS_KF), (const attn_body::bf16*)(ws + WS_VF), (attn_body::bf16*)(ws + WS_OB) + 512,
                                            (const float*)(ws + WS_CUM), (const float*)(ws + WS_CUM + MiB + 4096), (char*)lds, wave_s);
                }
            }
            GRID_BAR();
        }
        if (IN(pb + 4)) {
            PHASE_IDS(); const float* const modl = MOD + (size_t)l * NB * 6144; (void)modl;
            { pg8::Gemm g{(const bf16*)(ws + WS_OB), (const bf16*)(ws + WS_WA + l * 2 * WA_L), MTOK, DM, DM}; pg8::StaticOrder S; S.init(MTOK, DM, G, bx);
              pg8::EpiMerge E{H, (const bf16*)(ws + WS_GATES)};
              pg8::gemm_phase<pg8::EpiMerge, pg8::StaticOrder, true, true>(L, g, S, E, wave_s); }
            GRID_BAR();
        }
        if (IN(pb + 5)) {
            PHASE_IDS(); const float* const modl = MOD + (size_t)l * NB * 6144; (void)modl;
            const float* xs = (l == 0) ? KIN(KA_PTR(), 0) : outp;
            pg8::Gemm g{H, (const bf16*)(ws + WS_WO + l * WO_L), MTOK, DM, DM}; pg8::StaticOrder S; S.init(MTOK, DM, G, bx);
            pg8::EpiResid E{xs, outp, modl + 2048};
            pg8::gemm_phase<pg8::EpiResid, pg8::StaticOrder, true, true>(L, g, S, E, wave_s);
            GRID_BAR();
        }
#endif
        if (IN(pb + 6)) {
            PHASE_IDS(); const float* const modl = MOD + (size_t)l * NB * 6144; (void)modl;
            const float* g = KIN(KA_PTR(), 6) + (size_t)l * DM;
            constexpr int RPW = MTOK / (256 * NWAVES);
            for (int r0 = gw * RPW; r0 < MTOK; r0 += NGW * RPW) {
                const int b = r0 / SEQ; const float* mb = modl + (size_t)b * 6144;
                f32x4 gv[4], scv[4], shv[4]; load_vec16(g, lane, gv); load_vec16(mb + 4096, lane, scv); load_vec16(mb + 3072, lane, shv);
#pragma unroll
                for (int j = 0; j < 4; ++j) gv[j] = gv[j] * (scv[j] + 1.0f);
                for (int r = r0; r < r0 + RPW; ++r) {
                    f32x4 v[4]; load_vec16(outp + (size_t)r * DM, lane, v); float s = 0.f;
#pragma unroll
                    for (int j = 0; j < 4; ++j) s += (v[j].x * v[j].x + v[j].y * v[j].y) + (v[j].z * v[j].z + v[j].w * v[j].w);
                    const float rstd = rsqrtf(wave_sum(s, lane) * (1.f / DM) + EPS);
                    GAS unsigned long long* o8 = (GAS unsigned long long*)(H + (size_t)r * DM) + lane;
#pragma unroll
                    for (int j = 0; j < 4; ++j) { const f32x4 y = v[j] * rstd * gv[j] + shv[j]; o8[64 * j] = (unsigned long long)pk2(y.x, y.y) | ((unsigned long long)pk2(y.z, y.w) << 32); }
                }
            }
            GRID_BAR();
        }
        if (IN(pb + 7)) {
            PHASE_IDS(); const float* const modl = MOD + (size_t)l * NB * 6144; (void)modl;
            pg8::Gemm g{H, (const bf16*)(ws + WS_WUP + l * WUP_L), MTOK, NUP, DM}; pg8::StaticOrder S; S.init(MTOK, NUP, G, bx);
            const char __attribute__((address_space(4)))* kp = KA_PTR();
            pg8::EpiUpConv E{(bf16*)(ws + WS_ACT), (float*)(ws + WS_UH), (float*)(ws + WS_UT), KIN(kp, 13) + (size_t)l * 3 * NUP, KIN(kp, 14) + (size_t)l * NUP};
            for (int rep = 0; rep < REP_UP; ++rep) pg8::gemm_phase<pg8::EpiUpConv, pg8::StaticOrder, true, true>(L, g, S, E, wave_s);
            GRID_BAR();
        }
        if (IN(pb + 8)) {
            PHASE_IDS();
            const float* UH = (const float*)(ws + WS_UH); const float* UT = (const float*)(ws + WS_UT);
            const char __attribute__((address_space(4)))* kp = KA_PTR(); const float* cw = KIN(kp, 13) + (size_t)l * 3 * NUP; const float* cb = KIN(kp, 14) + (size_t)l * NUP;
            bf16* ACT = (bf16*)(ws + WS_ACT);
            pg8::StaticOrder S; S.init(MTOK, DM, G, bx); pg8::Unit uu;
            for (int ui = 0; S.next(ui, uu); ++ui) {
                int pm4 = 4 * uu.pm; asm volatile("" : "+v"(pm4));
                for (int it = tid; it < 4 * 2 * (DFF / 4); it += NTHR) {
                    const int c4 = it % (DFF / 4), rr = (it / (DFF / 4)) & 1, Gq = pm4 + it / (2 * (DFF / 4));
                    const int j = 4 * c4, pn = j >> 7, cl = j & 127, ua = 256 * pn + cl;
                    const bool first = (Gq % (SEQ / 64)) == 0;
                    const f32x4 z = {0.f, 0.f, 0.f, 0.f};
                    f32x4 res;
                    f32x4 cv[2];
#pragma unroll
                    for (int hb = 0; hb < 2; ++hb) {
                        const int uc = ua + 128 * hb, ch = hb * DFF + j;
                        const f32x4 u0 = *(const GAS f32x4*)(UH + ((size_t)Gq * 2 + rr) * NUP + uc);
                        const f32x4 u1 = rr ? *(const GAS f32x4*)(UH + ((size_t)Gq * 2) * NUP + uc) : (first ? z : *(const GAS f32x4*)(UT + ((size_t)(Gq - 1) * 2 + 1) * NUP + uc));
                        const f32x4 u2 = first ? z : *(const GAS f32x4*)(UT + ((size_t)(Gq - 1) * 2 + (rr ? 1 : 0)) * NUP + uc);
                        cv[hb] = *(const GAS f32x4*)(cb + ch) + *(const GAS f32x4*)(cw + ch) * u2 + *(const GAS f32x4*)(cw + NUP + ch) * u1 + *(const GAS f32x4*)(cw + 2 * NUP + ch) * u0;
                    }
#pragma unroll
                    for (int i = 0; i < 4; ++i) res[i] = cv[0][i] * pg8::fast_sigmoid(cv[0][i]) * cv[1][i];
                    *(GAS unsigned long long*)(ACT + (size_t)(Gq * 64 + rr) * DFF + j) = (unsigned long long)pk2(res[0], res[1]) | ((unsigned long long)pk2(res[2], res[3]) << 32);
                }
            }
            VM_WAIT(); __syncthreads();
        }
        if (IN(pb + 9)) {
            PHASE_IDS(); const float* const modl = MOD + (size_t)l * NB * 6144; (void)modl;
            pg8::Gemm g{(const bf16*)(ws + WS_ACT), (const bf16*)(ws + WS_WD + l * WD_L), MTOK, DM, DFF}; pg8::StaticOrder S; S.init(MTOK, DM, G, bx);
            pg8::EpiResid E{outp, outp, modl + 5120};
            pg8::gemm_phase<pg8::EpiResid, pg8::StaticOrder, true, true>(L, g, S, E, wave_s);
            GRID_BAR();
        }
    }
    if (IN(PH_FINAL)) {
        const int l = 0; PHASE_IDS(); const float* const modl = MOD + (size_t)l * NB * 6144; (void)modl;
        f32x4 gv[4]; load_vec16(KIN(KA_PTR(), 16), lane, gv);
        for (int r = gw; r < MTOK; r += NGW) {
            f32x4 v[4]; load_vec16(outp + (size_t)r * DM, lane, v); float s = 0.f;
#pragma unroll
            for (int j = 0; j < 4; ++j) s += (v[j].x * v[j].x + v[j].y * v[j].y) + (v[j].z * v[j].z + v[j].w * v[j].w);
            const float rstd = rsqrtf(wave_sum(s, lane) * (1.f / DM) + EPS);
#pragma unroll
            for (int j = 0; j < 4; ++j) *((GAS f32x4*)(outp + (size_t)r * DM) + lane + 64 * j) = v[j] * rstd * gv[j];
        }
    }
#undef IN
#undef GRID_BAR
}

extern "C" void kernel_launch(void* const* d_in, const int* in_sizes, int n_in, void* d_out, int out_size, void* d_ws, size_t ws_size, hipStream_t stream) {
    static int grid = 0;
    if (grid == 0) {
        if (n_in != 17 || out_size != MTOK * DM || ws_size < WS_END) { fprintf(stderr, "kernel_launch: unexpected problem (n_in %d, out %d, ws %zu)\n", n_in, out_size, ws_size); grid = -1; return; }
        int dev = 0, cus = 0, per_cu = 0;
        if (hipGetDevice(&dev) != hipSuccess || hipDeviceGetAttribute(&cus, hipDeviceAttributeMultiprocessorCount, dev) != hipSuccess) { grid = -1; return; }
        if (hipFuncSetAttribute((const void*)mk_fwd, hipFuncAttributeMaxDynamicSharedMemorySize, LDS_BYTES) != hipSuccess) { fprintf(stderr, "kernel_launch: hipFuncSetAttribute failed\n"); grid = -1; return; }
        if (hipOccupancyMaxActiveBlocksPerMultiprocessor(&per_cu, (const void*)mk_fwd, NTHR, LDS_BYTES) != hipSuccess || per_cu < 1) { fprintf(stderr, "kernel_launch: occupancy query says %d\n", per_cu); (void)hipGetLastError(); grid = -1; return; }
        grid = cus;
    }
    if (grid < 0) return;
    (void)hipMemsetAsync((char*)d_ws + WS_CTL, 0, CTL_ZERO_BYTES, stream);
    Args a{};
    for (int i = 0; i < 17; ++i) a.in[i] = (const float*)d_in[i];
    a.out = (float*)d_out; a.ws = (unsigned char*)d_ws; a.pad = 0;
#if MK_ONE_LAUNCH
    a.ph_lo = 0; a.ph_hi = N_PHASES; a.use_bar = 1;
    hipLaunchKernelGGL(mk_fwd, dim3(grid), dim3(NTHR), LDS_BYTES, stream, a);
#else
    for (int p = 0; p < N_PHASES; ++p) { a.ph_lo = p; a.ph_hi = p + 1; a.use_bar = 0; hipLaunchKernelGGL(mk_fwd, dim3(grid), dim3(NTHR), LDS_BYTES, stream, a); }
#endif
}
```

```cpp
#include <hip/hip_runtime.h>
#include <cstdio>
#include <cstdint>

constexpr int DM = 1024, NB = 4, SEQ = 8192, MTOK = NB * SEQ, DEPTH = 2;
constexpr int NIN_SRC = 4816, NIN = 4864;
constexpr int DFF = 2816, NUP = 2 * DFF;
constexpr int WSP = 512;
constexpr float EPS = 1e-6f;
constexpr float LOG2E = 1.4426950408889634f;
constexpr float C2 = 0.125f * LOG2E;


__device__ __forceinline__ float lane_read(float v, int src_lane) { return __builtin_bit_cast(float, __builtin_amdgcn_ds_bpermute(src_lane << 2, __builtin_bit_cast(int, v))); }
__device__ __forceinline__ unsigned lane_read_u(unsigned v, int src_lane) { return (unsigned)__builtin_amdgcn_ds_bpermute(src_lane << 2, (int)v); }

constexpr size_t MiB = 1u << 20;
constexpr size_t WS_CTL = 0, CTL_ZERO_BYTES = 1 * MiB;
constexpr size_t WS_MOD = 1 * MiB;
constexpr size_t WS_CS = 2 * MiB;
constexpr size_t WS_WIN = 4 * MiB, WIN_L = (size_t)NIN * DM * 2;
constexpr size_t WS_WA = 23 * MiB, WA_L = (size_t)DM * WSP * 2;
constexpr size_t WS_WB = 25 * MiB;
constexpr size_t WS_WO = 27 * MiB, WO_L = (size_t)DM * DM * 2;
constexpr size_t WS_WUP = 31 * MiB, WUP_L = (size_t)NUP * DM * 2;
constexpr size_t WS_WD = 53 * MiB, WD_L = (size_t)DM * DFF * 2;
constexpr size_t WS_H = 64 * MiB;
constexpr size_t WS_QA = 128 * MiB, WS_QF = 160 * MiB, WS_QI = 192 * MiB, WS_KF = 224 * MiB, WS_VF = 256 * MiB;
constexpr int GLD = 2080;
constexpr size_t WS_GATES = 288 * MiB;
constexpr size_t WS_KA = 419 * MiB, WS_VA = 423 * MiB, WS_KI = 427 * MiB, WS_WI = 431 * MiB, WS_LOGF = 432 * MiB, WS_CUM = 433 * MiB;
constexpr size_t WS_XB = 436 * MiB;
constexpr size_t WS_ACT = 128 * MiB;
constexpr size_t WS_UH = 304 * MiB, WS_UT = 326 * MiB;
constexpr size_t WS_END = 500 * MiB;
static_assert(WS_GATES + (size_t)MTOK * GLD * 2 <= WS_KA && WS_CUM + 2 * MiB <= WS_XB, "projection map");
static_assert(WS_WIN + 2 * WIN_L <= WS_WA && WS_WUP + 2 * WUP_L <= WS_WD && WS_WD + 2 * WD_L <= WS_H, "weight map");
static_assert(WS_ACT + (size_t)MTOK * DFF * 2 <= WS_UH && WS_UH + (size_t)512 * 2 * NUP * 4 <= WS_UT && WS_UT + (size_t)512 * 2 * NUP * 4 <= WS_GATES + 128 * MiB, "ffn map");
constexpr int CW_TMO = 0, CW_CODE = 1, CW_BAR = 4096;


namespace pg8 {
#define PG8_LAS __attribute__((address_space(3)))
typedef unsigned short bf16_t;
typedef short bf16x8 __attribute__((ext_vector_type(8)));
typedef float f32x4 __attribute__((ext_vector_type(4)));
typedef unsigned u32x4 __attribute__((ext_vector_type(4)));
constexpr int BM = 256, BK = 64, HALF = 128, HTB = HALF * BK * 2  , STAGE_BYTES = 8 * HTB, NXCD = 8, WGM = 8;

__host__ __device__ __forceinline__ int lds_byte(int r, int c) { const int st = (r >> 4) * 2 + (c >> 5), rr = r & 15, cc = c & 31, ob = rr * 64 + cc * 2; return st * 1024 + (ob ^ (((ob >> 9) & 1) << 5)); }
__host__ __device__ __forceinline__ void stage_rc(int b, int& R, int& C) { const int st = b / 1024, sb = b % 1024, swz = sb ^ (((sb >> 9) & 1) << 5); R = (st >> 1) * 16 + swz / 64; C = (st & 1) * 32 + (swz % 64) / 2; }
__host__ __device__ __forceinline__ int perm32(int rho) { const int n = rho >> 4, i = rho & 15; return 8 * (i >> 2) + 4 * n + (i & 3); }

struct Unit { int pm, pn; };
struct Gemm { const bf16_t* A; const bf16_t* Bt; int M, N, K; };

struct StaticOrder {
    int nM, nN, nwg, G, c;
    __host__ __device__ void init(int M, int N, int G_, int c_) { nM = M / BM; nN = N / BM; nwg = nM * nN; G = G_; c = c_; }
    __host__ __device__ __forceinline__ bool next(int i, Unit& u) const {
        const long L = (long)i * G + c; if (L >= nwg) return false;
        int wgid = (int)L; { const int q = nwg / NXCD, r = nwg % NXCD, xcd = wgid % NXCD, off = wgid / NXCD; wgid = (xcd < r ? xcd * (q + 1) : r * (q + 1) + (xcd - r) * q) + off; }
        const int nig = WGM * nN, gid = wgid / nig, fm = gid * WGM, gsz = (nM - fm) < WGM ? (nM - fm) : WGM;
        u.pm = fm + ((wgid % nig) % gsz); u.pn = (wgid % nig) / gsz; return true;
    }
    __device__ __forceinline__ void a_ready(const Unit&) const {}
    __device__ __forceinline__ void done(const Unit&) const {}
};

typedef float f32x2_cv __attribute__((ext_vector_type(2))); typedef __bf16 bf16x2_cv __attribute__((ext_vector_type(2)));
__device__ __forceinline__ unsigned cvt_pk_bf16(float lo, float hi) { const f32x2_cv v = {lo, hi}; const bf16x2_cv b = __builtin_convertvector(v, bf16x2_cv); return __builtin_bit_cast(unsigned, b); }

typedef float f32x2 __attribute__((ext_vector_type(2)));
typedef unsigned u32x2 __attribute__((ext_vector_type(2)));
#define PG8_GAS __attribute__((address_space(1)))
__device__ __forceinline__ float fast_sigmoid(float z) { return __builtin_amdgcn_rcpf(1.f + __builtin_amdgcn_exp2f(-z * 1.4426950408889634f)); }
__device__ __forceinline__ u32x4 pack8(const f32x4& v0, const f32x4& v1) { u32x4 w; w.x = cvt_pk_bf16(v0[0], v0[1]); w.y = cvt_pk_bf16(v0[2], v0[3]); w.z = cvt_pk_bf16(v1[0], v1[1]); w.w = cvt_pk_bf16(v1[2], v1[3]); return w; }

struct EpiInProj {
    static constexpr bool PERM = true, AFTER_DRAIN = false, MIDK = false;
    unsigned char* ws; const float* CS; const float* fbias;
    enum { K_PLAIN = 0, K_ROPE = 1, K_SIG = 2, K_SMALL = 3, K_NONE = 4 };
    __device__ __forceinline__ void operator()(const f32x4 (&acc)[2][2][4][2], const Unit& u, int wr, int wc, int fr_, int fq_) const {
        int fr = fr_, fq = fq_; asm volatile("" : "+v"(fr), "+v"(fq));
        const int row0 = u.pm * BM + wr * 64 + fr, pn = u.pn;
#pragma unroll
        for (int bj = 0; bj < 2; ++bj) {
            const int cg = 128 * bj + 32 * wc;
            int kind = K_PLAIN; size_t off = 0; int ld = 512, dcol = 0; float sc = 1.f;
            if (pn < 2)       { off = WS_QA; dcol = 256 * pn + cg; kind = (cg & 32) ? K_PLAIN : K_ROPE; sc = C2; }
            else if (pn == 2) {
                ld = 64;
                if (cg < 64)       { off = WS_KA; dcol = cg; kind = (cg == 0) ? K_ROPE : K_PLAIN; }
                else if (cg < 128) { off = WS_VA; dcol = cg - 64; }
                else if (cg < 192) { off = WS_KI; dcol = cg - 128; kind = (cg == 128) ? K_ROPE : K_PLAIN; }
                else kind = (cg == 192) ? K_SMALL : K_NONE;
            }
            else if (pn < 5)  { off = WS_QI; dcol = 256 * (pn - 3) + cg; kind = (cg & 32) ? K_PLAIN : K_ROPE; }
            else if (pn < 7)  { off = WS_QF; dcol = 256 * (pn - 5) + cg; sc = C2; }
            else if (pn < 9)  { off = WS_KF; dcol = 256 * (pn - 7) + cg; }
            else if (pn < 11) { off = WS_VF; dcol = 256 * (pn - 9) + cg; }
            else              { off = WS_GATES; ld = GLD; dcol = 256 * (pn - 11) + cg; kind = K_SIG; }
            kind = __builtin_amdgcn_readfirstlane(kind);
            if (kind == K_NONE) continue;
            if (kind == K_SMALL) {
                PG8_GAS float* p = (PG8_GAS float*)(ws + (fq == 0 ? WS_WI : WS_LOGF)) + (size_t)row0 * 8;
                const f32x4 fb0 = *(const PG8_GAS f32x4*)(fbias), fb1 = *(const PG8_GAS f32x4*)(fbias + 4);
#pragma unroll
                for (int ai = 0; ai < 2; ++ai)
#pragma unroll
                    for (int m = 0; m < 4; ++m) {
                        const f32x4 v0 = acc[ai][bj][m][0], v1 = acc[ai][bj][m][1];
                        const f32x4 z0 = v0 + fb0, z1 = v1 + fb1; f32x4 l0, l1;
#pragma unroll
                        for (int i = 0; i < 4; ++i) { l0[i] = fminf(z0[i], 0.f) - log1pf(__expf(-fabsf(z0[i]))); l1[i] = fminf(z1[i], 0.f) - log1pf(__expf(-fabsf(z1[i]))); }
                        const float s8 = 0.35355339059327373f;
                        const f32x4 o0 = (fq == 0) ? v0 * s8 : l0, o1 = (fq == 0) ? v1 * s8 : l1;
                        if (fq < 2) { *(PG8_GAS f32x4*)p = o0; *(PG8_GAS f32x4*)(p + 4) = o1; }
                        p += ((m < 3) ? 16 : (HALF - 48)) * 8; asm volatile("" : "+v"(p));
                    }
                continue;
            }
            PG8_GAS bf16_t* p = (PG8_GAS bf16_t*)(ws + off) + (size_t)row0 * ld + dcol + 8 * fq;
            if (kind == K_ROPE) {
                const int f4 = 4 * (fq & 1);
                const PG8_GAS float* cp = (const PG8_GAS float*)CS + (size_t)row0 * 16 + 2 * f4;
                PG8_GAS bf16_t* ph = p - 8 * fq;
                f32x4 cs0 = *(const PG8_GAS f32x4*)cp, cs1 = *(const PG8_GAS f32x4*)(cp + 4);
#pragma unroll
                for (int ai = 0; ai < 2; ++ai)
#pragma unroll
                    for (int m = 0; m < 4; ++m) {
                        const int adv = (m < 3) ? 16 : (HALF - 48);
                        const bool lastrow = (ai == 1 && m == 3);
                        const PG8_GAS float* cpn = cp + (lastrow ? 0 : adv * 16);
                        const f32x4 ns0 = *(const PG8_GAS f32x4*)cpn, ns1 = *(const PG8_GAS f32x4*)(cpn + 4);
                        const f32x4 v0 = acc[ai][bj][m][0] * sc, v1 = acc[ai][bj][m][1] * sc;
                        f32x4 o1, o2;
                        o1[0] = v0[0] * cs0[0] - v1[0] * cs0[1]; o2[0] = v1[0] * cs0[0] + v0[0] * cs0[1];
                        o1[1] = v0[1] * cs0[2] - v1[1] * cs0[3]; o2[1] = v1[1] * cs0[2] + v0[1] * cs0[3];
                        o1[2] = v0[2] * cs1[0] - v1[2] * cs1[1]; o2[2] = v1[2] * cs1[0] + v0[2] * cs1[1];
                        o1[3] = v0[3] * cs1[2] - v1[3] * cs1[3]; o2[3] = v1[3] * cs1[2] + v0[3] * cs1[3];
                        u32x2 w1, w2; w1.x = cvt_pk_bf16(o1[0], o1[1]); w1.y = cvt_pk_bf16(o1[2], o1[3]); w2.x = cvt_pk_bf16(o2[0], o2[1]); w2.y = cvt_pk_bf16(o2[2], o2[3]);
                        if (fq < 2) { *(PG8_GAS u32x2*)(ph + f4) = w1; *(PG8_GAS u32x2*)(ph + 8 + f4) = w2; }
                        else *(PG8_GAS u32x4*)p = pack8(v0, v1);
                        p += (size_t)adv * ld; ph += (size_t)adv * ld; cp = cpn; cs0 = ns0; cs1 = ns1; asm volatile("" : "+v"(p), "+v"(ph), "+v"(cp));
                    }
            } else if (kind == K_SIG) {
#pragma unroll
                for (int ai = 0; ai < 2; ++ai)
#pragma unroll
                    for (int m = 0; m < 4; ++m) {
                        f32x4 v0 = acc[ai][bj][m][0], v1 = acc[ai][bj][m][1];
#pragma unroll
                        for (int i = 0; i < 4; ++i) { v0[i] = fast_sigmoid(v0[i]); v1[i] = fast_sigmoid(v1[i]); }
                        *(PG8_GAS u32x4*)p = pack8(v0, v1);
                        p += (size_t)((m < 3) ? 16 : (HALF - 48)) * ld; asm volatile("" : "+v"(p));
                    }
            } else {
#pragma unroll
                for (int ai = 0; ai < 2; ++ai)
#pragma unroll
                    for (int m = 0; m < 4; ++m) {
                        *(PG8_GAS u32x4*)p = pack8(acc[ai][bj][m][0] * sc, acc[ai][bj][m][1] * sc);
                        p += (size_t)((m < 3) ? 16 : (HALF - 48)) * ld; asm volatile("" : "+v"(p));
                    }
            }
        }
    }
};

template <int MODE> struct EpiGate {
    static constexpr bool PERM = true, AFTER_DRAIN = false, MIDK = false;
    bf16_t* O; const bf16_t* T; const bf16_t* G; int ldg;
    __device__ __forceinline__ void operator()(const f32x4 (&acc)[2][2][4][2], const Unit& u, int wr, int wc, int fr_, int fq_) const {
        int fr = fr_, fq = fq_; asm volatile("" : "+v"(fr), "+v"(fq));
        const int row0 = u.pm * BM + wr * 64 + fr, col0 = u.pn * BM + wc * 32 + 8 * fq;
        const PG8_GAS bf16_t* gp = (const PG8_GAS bf16_t*)G + (size_t)row0 * ldg + col0; const PG8_GAS bf16_t* tp = (const PG8_GAS bf16_t*)T + (size_t)row0 * DM + col0;
        PG8_GAS bf16_t* op = (PG8_GAS bf16_t*)O + (size_t)row0 * DM + col0;
        u32x4 gw[2], tw[2];
#pragma unroll
        for (int bj = 0; bj < 2; ++bj) { gw[bj] = *(const PG8_GAS u32x4*)(gp + bj * HALF); if (MODE == 1) tw[bj] = *(const PG8_GAS u32x4*)(tp + bj * HALF); }
#pragma unroll
        for (int ai = 0; ai < 2; ++ai)
#pragma unroll
            for (int m = 0; m < 4; ++m) {
                const int adv = (m < 3) ? 16 : (HALF - 48); const bool lastrow = (ai == 1 && m == 3);
                const PG8_GAS bf16_t* gpn = gp + (lastrow ? 0 : (size_t)adv * ldg); const PG8_GAS bf16_t* tpn = tp + (lastrow ? 0 : (size_t)adv * DM);
                u32x4 gn[2], tn[2];
#pragma unroll
                for (int bj = 0; bj < 2; ++bj) { gn[bj] = *(const PG8_GAS u32x4*)(gpn + bj * HALF); if (MODE == 1) tn[bj] = *(const PG8_GAS u32x4*)(tpn + bj * HALF); }
#pragma unroll
                for (int bj = 0; bj < 2; ++bj) {
                    f32x4 v0 = acc[ai][bj][m][0], v1 = acc[ai][bj][m][1];
                    v0[0] *= __uint_as_float(gw[bj].x << 16); v0[1] *= __uint_as_float(gw[bj].x & 0xffff0000u); v0[2] *= __uint_as_float(gw[bj].y << 16); v0[3] *= __uint_as_float(gw[bj].y & 0xffff0000u);
                    v1[0] *= __uint_as_float(gw[bj].z << 16); v1[1] *= __uint_as_float(gw[bj].z & 0xffff0000u); v1[2] *= __uint_as_float(gw[bj].w << 16); v1[3] *= __uint_as_float(gw[bj].w & 0xffff0000u);
                    if (MODE == 1) {
                        v0[0] += __uint_as_float(tw[bj].x << 16); v0[1] += __uint_as_float(tw[bj].x & 0xffff0000u); v0[2] += __uint_as_float(tw[bj].y << 16); v0[3] += __uint_as_float(tw[bj].y & 0xffff0000u);
                        v1[0] += __uint_as_float(tw[bj].z << 16); v1[1] += __uint_as_float(tw[bj].z & 0xffff0000u); v1[2] += __uint_as_float(tw[bj].w << 16); v1[3] += __uint_as_float(tw[bj].w & 0xffff0000u); }
                    *(PG8_GAS u32x4*)(op + bj * HALF) = pack8(v0, v1); }
                op += (size_t)adv * DM; gp = gpn; tp = tpn; gw[0] = gn[0]; gw[1] = gn[1]; if (MODE == 1) { tw[0] = tn[0]; tw[1] = tn[1]; }
                asm volatile("" : "+v"(op), "+v"(gp), "+v"(tp));
            }
    }
};


struct EpiMerge {
    static constexpr bool PERM = true, AFTER_DRAIN = false, MIDK = true;
    bf16_t* O; const bf16_t* G;
    static __device__ __forceinline__ constexpr int roff(int r) { return (r >> 2) * HALF + (r & 3) * 16; }
    __device__ __forceinline__ void mid(f32x4 (&acc)[2][2][4][2], const Unit& u, int wr, int wc, int fr_, int fq_) const {
        int fr = fr_, fq = fq_; asm volatile("" : "+v"(fr), "+v"(fq));
        const PG8_GAS bf16_t* gp = (const PG8_GAS bf16_t*)G + (size_t)(u.pm * BM + wr * 64 + fr) * GLD + u.pn * BM + wc * 32 + 8 * fq;
        u32x4 ga[4][2], gb[4][2];
#pragma unroll
        for (int r = 0; r < 4; ++r)
#pragma unroll
            for (int bj = 0; bj < 2; ++bj) { ga[r][bj] = *(const PG8_GAS u32x4*)(gp + (size_t)roff(r) * GLD + bj * HALF); gb[r][bj] = *(const PG8_GAS u32x4*)(gp + (size_t)roff(r) * GLD + 1024 + bj * HALF); }
#pragma unroll
        for (int r = 0; r < 8; ++r) {
            const int ai = r >> 2, m = r & 3, s = r & 3;
#pragma unroll
            for (int bj = 0; bj < 2; ++bj) {
                const unsigned gaw[4] = {ga[s][bj].x, ga[s][bj].y, ga[s][bj].z, ga[s][bj].w}, gbw[4] = {gb[s][bj].x, gb[s][bj].y, gb[s][bj].z, gb[s][bj].w};
#pragma unroll
                for (int i = 0; i < 4; ++i) {
                    const float r0 = __uint_as_float(gaw[i] << 16) * __builtin_amdgcn_rcpf(fmaxf(__uint_as_float(gbw[i] << 16), 1e-20f)), r1 = __uint_as_float(gaw[i] & 0xffff0000u) * __builtin_amdgcn_rcpf(fmaxf(__uint_as_float(gbw[i] & 0xffff0000u), 1e-20f));
                    acc[ai][bj][m][i >> 1][2 * (i & 1)] *= r0; acc[ai][bj][m][i >> 1][2 * (i & 1) + 1] *= r1; }
            }
            if (r < 4) {
#pragma unroll
                for (int bj = 0; bj < 2; ++bj) { ga[s][bj] = *(const PG8_GAS u32x4*)(gp + (size_t)roff(r + 4) * GLD + bj * HALF); gb[s][bj] = *(const PG8_GAS u32x4*)(gp + (size_t)roff(r + 4) * GLD + 1024 + bj * HALF); }
            }
        }
    }
    __device__ __forceinline__ void operator()(const f32x4 (&acc)[2][2][4][2], const Unit& u, int wr, int wc, int fr_, int fq_) const {
        int fr = fr_, fq = fq_; asm volatile("" : "+v"(fr), "+v"(fq));
        const int row0 = u.pm * BM + wr * 64 + fr, col0 = u.pn * BM + wc * 32 + 8 * fq;
        const PG8_GAS bf16_t* gp = (const PG8_GAS bf16_t*)G + (size_t)row0 * GLD + 1024 + col0; PG8_GAS bf16_t* op = (PG8_GAS bf16_t*)O + (size_t)row0 * DM + col0;
        u32x4 gw[8][2];
#pragma unroll
        for (int r = 0; r < 8; ++r)
#pragma unroll
            for (int bj = 0; bj < 2; ++bj) gw[r][bj] = *(const PG8_GAS u32x4*)(gp + (size_t)roff(r) * GLD + bj * HALF);
#pragma unroll
        for (int r = 0; r < 8; ++r) {
            const int ai = r >> 2, m = r & 3;
#pragma unroll
            for (int bj = 0; bj < 2; ++bj) {
                f32x4 v0 = acc[ai][bj][m][0], v1 = acc[ai][bj][m][1];
                v0[0] *= fmaxf(__uint_as_float(gw[r][bj].x << 16), 1e-20f); v0[1] *= fmaxf(__uint_as_float(gw[r][bj].x & 0xffff0000u), 1e-20f); v0[2] *= fmaxf(__uint_as_float(gw[r][bj].y << 16), 1e-20f); v0[3] *= fmaxf(__uint_as_float(gw[r][bj].y & 0xffff0000u), 1e-20f);
                v1[0] *= fmaxf(__uint_as_float(gw[r][bj].z << 16), 1e-20f); v1[1] *= fmaxf(__uint_as_float(gw[r][bj].z & 0xffff0000u), 1e-20f); v1[2] *= fmaxf(__uint_as_float(gw[r][bj].w << 16), 1e-20f); v1[3] *= fmaxf(__uint_as_float(gw[r][bj].w & 0xffff0000u), 1e-20f);
                *(PG8_GAS u32x4*)(op + (size_t)roff(r) * DM + bj * HALF) = pack8(v0, v1); }
        }
    }
};

struct EpiResid {
    static constexpr bool PERM = false, AFTER_DRAIN = false, MIDK = false;
    const float* SRC; float* OUT; const float* gate;
    __device__ __forceinline__ void operator()(const f32x4 (&acc)[2][2][4][2], const Unit& u, int wr, int wc, int fr_, int fq_) const {
        int fr = fr_, fq = fq_; asm volatile("" : "+v"(fr), "+v"(fq));
        const int row0 = u.pm * BM + wr * 64 + fr, col0 = u.pn * BM + wc * 32 + 4 * fq;
        const float* gb = gate + (size_t)(u.pm / (SEQ / BM)) * 6144 + col0;
        f32x4 g[2][2];
#pragma unroll
        for (int bj = 0; bj < 2; ++bj) { g[bj][0] = *(const PG8_GAS f32x4*)(gb + bj * HALF); g[bj][1] = *(const PG8_GAS f32x4*)(gb + bj * HALF + 16); }
        const PG8_GAS float* sp = (const PG8_GAS float*)SRC + (size_t)row0 * DM + col0; PG8_GAS float* op = (PG8_GAS float*)OUT + (size_t)row0 * DM + col0;
        f32x4 sv[2][2];
#pragma unroll
        for (int bj = 0; bj < 2; ++bj) { sv[bj][0] = *(const PG8_GAS f32x4*)(sp + bj * HALF); sv[bj][1] = *(const PG8_GAS f32x4*)(sp + bj * HALF + 16); }
#pragma unroll
        for (int ai = 0; ai < 2; ++ai)
#pragma unroll
            for (int m = 0; m < 4; ++m) {
                const int adv = (m < 3) ? 16 : (HALF - 48); const bool lastrow = (ai == 1 && m == 3);
                const PG8_GAS float* spn = sp + (lastrow ? 0 : (size_t)adv * DM);
                f32x4 sn[2][2];
#pragma unroll
                for (int bj = 0; bj < 2; ++bj) { sn[bj][0] = *(const PG8_GAS f32x4*)(spn + bj * HALF); sn[bj][1] = *(const PG8_GAS f32x4*)(spn + bj * HALF + 16); }
#pragma unroll
                for (int bj = 0; bj < 2; ++bj) {
                    *(PG8_GAS f32x4*)(op + bj * HALF) = sv[bj][0] + g[bj][0] * acc[ai][bj][m][0];
                    *(PG8_GAS f32x4*)(op + bj * HALF + 16) = sv[bj][1] + g[bj][1] * acc[ai][bj][m][1]; }
                op += (size_t)adv * DM; sp = spn;
#pragma unroll
                for (int bj = 0; bj < 2; ++bj) { sv[bj][0] = sn[bj][0]; sv[bj][1] = sn[bj][1]; }
                asm volatile("" : "+v"(op), "+v"(sp));
            }
    }
};

struct EpiResidB {
    static constexpr bool PERM = true, AFTER_DRAIN = false, MIDK = false;
    const void* SRC; bf16_t* OUT; const float* gate; int src_f32;
    __device__ __forceinline__ void operator()(const f32x4 (&acc)[2][2][4][2], const Unit& u, int wr, int wc, int fr_, int fq_) const {
        int fr = fr_, fq = fq_; asm volatile("" : "+v"(fr), "+v"(fq));
        const int row0 = u.pm * BM + wr * 64 + fr, col0 = u.pn * BM + wc * 32 + 8 * fq;
        const float* gb = gate + (size_t)(u.pm / (SEQ / BM)) * 6144 + col0;
        f32x4 g[2][2];
#pragma unroll
        for (int bj = 0; bj < 2; ++bj) { g[bj][0] = *(const PG8_GAS f32x4*)(gb + bj * HALF); g[bj][1] = *(const PG8_GAS f32x4*)(gb + bj * HALF + 4); }
        PG8_GAS bf16_t* op = (PG8_GAS bf16_t*)OUT + (size_t)row0 * DM + col0;
        if (src_f32) {
            const PG8_GAS float* sp = (const PG8_GAS float*)SRC + (size_t)row0 * DM + col0;
            f32x4 sv[2][2];
#pragma unroll
            for (int bj = 0; bj < 2; ++bj) { sv[bj][0] = *(const PG8_GAS f32x4*)(sp + bj * HALF); sv[bj][1] = *(const PG8_GAS f32x4*)(sp + bj * HALF + 4); }
#pragma unroll
            for (int ai = 0; ai < 2; ++ai)
#pragma unroll
                for (int m = 0; m < 4; ++m) {
                    const int adv = (m < 3) ? 16 : (HALF - 48); const bool lastrow = (ai == 1 && m == 3);
                    const PG8_GAS float* spn = sp + (lastrow ? 0 : (size_t)adv * DM);
                    f32x4 sn[2][2];
#pragma unroll
                    for (int bj = 0; bj < 2; ++bj) { sn[bj][0] = *(const PG8_GAS f32x4*)(spn + bj * HALF); sn[bj][1] = *(const PG8_GAS f32x4*)(spn + bj * HALF + 4); }
#pragma unroll
                    for (int bj = 0; bj < 2; ++bj) *(PG8_GAS u32x4*)(op + bj * HALF) = pack8(sv[bj][0] + g[bj][0] * acc[ai][bj][m][0], sv[bj][1] + g[bj][1] * acc[ai][bj][m][1]);
                    op += (size_t)adv * DM; sp = spn;
#pragma unroll
                    for (int bj = 0; bj < 2; ++bj) { sv[bj][0] = sn[bj][0]; sv[bj][1] = sn[bj][1]; }
                    asm volatile("" : "+v"(op), "+v"(sp));
                }
        } else {
            const PG8_GAS bf16_t* sp = (const PG8_GAS bf16_t*)SRC + (size_t)row0 * DM + col0;
            u32x4 sv[2];
#pragma unroll
            for (int bj = 0; bj < 2; ++bj) sv[bj] = *(const PG8_GAS u32x4*)(sp + bj * HALF);
#pragma unroll
            for (int ai = 0; ai < 2; ++ai)
#pragma unroll
                for (int m = 0; m < 4; ++m) {
                    const int adv = (m < 3) ? 16 : (HALF - 48); const bool lastrow = (ai == 1 && m == 3);
                    const PG8_GAS bf16_t* spn = sp + (lastrow ? 0 : (size_t)adv * DM);
                    u32x4 sn[2];
#pragma unroll
                    for (int bj = 0; bj < 2; ++bj) sn[bj] = *(const PG8_GAS u32x4*)(spn + bj * HALF);
#pragma unroll
                    for (int bj = 0; bj < 2; ++bj) {
                        const f32x4 s0 = {__uint_as_float(sv[bj].x << 16), __uint_as_float(sv[bj].x & 0xffff0000u), __uint_as_float(sv[bj].y << 16), __uint_as_float(sv[bj].y & 0xffff0000u)};
                        const f32x4 s1 = {__uint_as_float(sv[bj].z << 16), __uint_as_float(sv[bj].z & 0xffff0000u), __uint_as_float(sv[bj].w << 16), __uint_as_float(sv[bj].w & 0xffff0000u)};
                        *(PG8_GAS u32x4*)(op + bj * HALF) = pack8(s0 + g[bj][0] * acc[ai][bj][m][0], s1 + g[bj][1] * acc[ai][bj][m][1]); }
                    op += (size_t)adv * DM; sp = spn; sv[0] = sn[0]; sv[1] = sn[1];
                    asm volatile("" : "+v"(op), "+v"(sp));
                }
        }
    }
};

__device__ __forceinline__ float dpp_shr1(float old, float src) { return __builtin_bit_cast(float, __builtin_amdgcn_update_dpp(__builtin_bit_cast(int, old), __builtin_bit_cast(int, src), 0x111, 0xf, 0xf, false)); }
__device__ __forceinline__ float dpp_shr2(float old, float src) { return __builtin_bit_cast(float, __builtin_amdgcn_update_dpp(__builtin_bit_cast(int, old), __builtin_bit_cast(int, src), 0x112, 0xf, 0xf, false)); }
__device__ __forceinline__ float dpp_ror1(float src) { return __builtin_bit_cast(float, __builtin_amdgcn_update_dpp(0, __builtin_bit_cast(int, src), 0x121, 0xf, 0xf, false)); }
__device__ __forceinline__ float dpp_ror2(float src) { return __builtin_bit_cast(float, __builtin_amdgcn_update_dpp(0, __builtin_bit_cast(int, src), 0x122, 0xf, 0xf, false)); }
struct EpiUpConv {
    static constexpr bool PERM = true, AFTER_DRAIN = false, MIDK = false;
    bf16_t* ACT; float* UH; float* UT; const float* cw; const float* cb;
    __device__ __forceinline__ void operator()(const f32x4 (&acc)[2][2][4][2], const Unit& u, int wr, int wc, int fr_, int fq_) const {
        int fr = fr_, fq = fq_; asm volatile("" : "+v"(fr), "+v"(fq));
        const int row0 = u.pm * BM + wr * 64 + fr, cl = wc * 32 + 8 * fq;
        const int jc = u.pn * HALF + cl;
#pragma unroll
        for (int n = 0; n < 2; ++n) {
            const float* cwp = cw + jc + 4 * n; asm volatile("" : "+v"(cwp));
            const f32x4 wa0 = *(const PG8_GAS f32x4*)(cwp), wa1 = *(const PG8_GAS f32x4*)(cwp + NUP), wa2 = *(const PG8_GAS f32x4*)(cwp + 2 * NUP), ba = *(const PG8_GAS f32x4*)(cb + jc + 4 * n);
            const f32x4 wb0 = *(const PG8_GAS f32x4*)(cwp + DFF), wb1 = *(const PG8_GAS f32x4*)(cwp + NUP + DFF), wb2 = *(const PG8_GAS f32x4*)(cwp + 2 * NUP + DFF), bb = *(const PG8_GAS f32x4*)(cb + DFF + jc + 4 * n);
            bf16_t* ap = ACT + (size_t)row0 * DFF + jc + 4 * n;
#pragma unroll
            for (int ai = 0; ai < 2; ++ai) {
#pragma unroll
                for (int m = 0; m < 4; ++m) {
                    const f32x4 a = acc[ai][0][m][n], b = acc[ai][1][m][n];
                    const f32x4 z4 = {0.f, 0.f, 0.f, 0.f};
                    const f32x4 ap_ = (m > 0) ? acc[ai][0][m > 0 ? m - 1 : 0][n] : z4, bp_ = (m > 0) ? acc[ai][1][m > 0 ? m - 1 : 0][n] : z4;
                    f32x4 res;
#pragma unroll
                    for (int i = 0; i < 4; ++i) {
                        const float a1 = dpp_shr1(dpp_ror1(ap_[i]), a[i]), a2 = dpp_shr2(dpp_ror2(ap_[i]), a[i]), b1 = dpp_shr1(dpp_ror1(bp_[i]), b[i]), b2 = dpp_shr2(dpp_ror2(bp_[i]), b[i]);
                        const float ca = ba[i] + wa0[i] * a2 + wa1[i] * a1 + wa2[i] * a[i];
                        const float cbv = bb[i] + wb0[i] * b2 + wb1[i] * b1 + wb2[i] * b[i];
                        res[i] = ca * fast_sigmoid(ca) * cbv;
                    }
                    if (!(m == 0 && fr < 2)) { u32x2 w; w.x = cvt_pk_bf16(res[0], res[1]); w.y = cvt_pk_bf16(res[2], res[3]); *(PG8_GAS u32x2*)ap = w; }
                    ap += (m < 3) ? 16 * DFF : (HALF - 48) * DFF; asm volatile("" : "+v"(ap));
                    __builtin_amdgcn_sched_barrier(0);
                }
            }
        }
#pragma unroll
        for (int ai = 0; ai < 2; ++ai) {
            const int G = (u.pm * BM + ai * HALF + wr * 64) >> 6;
            if (fr < 2) { float* p = UH + ((size_t)G * 2 + fr) * NUP + u.pn * BM + cl; asm volatile("" : "+v"(p));
#pragma unroll
                for (int bj = 0; bj < 2; ++bj) { *(PG8_GAS f32x4*)(p + bj * HALF) = acc[ai][bj][0][0]; *(PG8_GAS f32x4*)(p + bj * HALF + 4) = acc[ai][bj][0][1]; } }
            if (fr >= 14) { float* p = UT + ((size_t)G * 2 + (fr - 14)) * NUP + u.pn * BM + cl; asm volatile("" : "+v"(p));
#pragma unroll
                for (int bj = 0; bj < 2; ++bj) { *(PG8_GAS f32x4*)(p + bj * HALF) = acc[ai][bj][3][0]; *(PG8_GAS f32x4*)(p + bj * HALF + 4) = acc[ai][bj][3][1]; } }
            __builtin_amdgcn_sched_barrier(0);
        }
    }
};
template <class Epi, class Sched, bool ALIGN_EPI = false, bool SP2 = false>
__device__ __forceinline__ void gemm_phase(PG8_LAS unsigned char* lds, const Gemm g, const Sched& S, const Epi& E, int wave_in) {
    int tid_; { int ln_; asm volatile("v_mbcnt_lo_u32_b32 %0, -1, 0\n\tv_mbcnt_hi_u32_b32 %0, -1, %0" : "=v"(ln_)); tid_ = wave_in * 64 + ln_; }
    const int tid = tid_, wid = __builtin_amdgcn_readfirstlane(tid >> 6), lane = tid & 63, wr = wid >> 2, wc = wid & 3, fr = lane & 15, fq = lane >> 4;
    const int K = g.K, nt = K / BK;
    unsigned voffA[2], voffB[2];
#pragma unroll
    for (int i = 0; i < 2; ++i) { int R, C; stage_rc(tid * 16 + i * 8192, R, C); const int Rb = Epi::PERM ? ((R & ~31) + perm32(R & 31)) : R;
        voffA[i] = (unsigned)(R * K + C) * 2u; voffB[i] = (unsigned)(Rb * K + C) * 2u; }
    const size_t kstep = (size_t)(BK * 2);
    const size_t hstep = (size_t)HALF * K * 2;
    const size_t tstep = 2 * hstep;
    const unsigned ldsw = (unsigned)wid * 1024u;
    const int aoff = lds_byte(wr * 64 + fr, fq * 8), boff = lds_byte(wc * 32 + fr, fq * 8);
#define PG8_SA(b, h) (((b) * 2 + (h)) * HTB)
#define PG8_SB(b, h) ((4 + (b) * 2 + (h)) * HTB)
#define PG8_STAGE(bufoff, gbase, voff) do { _Pragma("unroll") for (int _i = 0; _i < 2; ++_i) \
        __builtin_amdgcn_global_load_lds((const unsigned*)((const char*)(gbase) + (voff)[_i]), (PG8_LAS unsigned*)(lds + (bufoff) + ldsw + _i * 8192), 16, 0, 0); } while (0)
#define PG8_LDA(dst, b, h) do { _Pragma("unroll") for (int m = 0; m < 4; ++m) _Pragma("unroll") for (int k = 0; k < 2; ++k) dst[m][k] = *(const PG8_LAS bf16x8*)(lds + PG8_SA(b, h) + aoff + m * 2048 + k * 1024); } while (0)
#define PG8_LDB(dst, b, h) do { _Pragma("unroll") for (int n = 0; n < 2; ++n) _Pragma("unroll") for (int k = 0; k < 2; ++k) dst[n][k] = *(const PG8_LAS bf16x8*)(lds + PG8_SB(b, h) + boff + n * 2048 + k * 1024); } while (0)
#define PG8_MMA(ai, bj, At, Bt) do { __builtin_amdgcn_s_setprio(1); _Pragma("unroll") for (int m = 0; m < 4; ++m) _Pragma("unroll") for (int n = 0; n < 2; ++n) _Pragma("unroll") for (int k = 0; k < 2; ++k) \
        acc[ai][bj][m][n] = __builtin_amdgcn_mfma_f32_16x16x32_bf16(Bt[n][k], At[m][k], acc[ai][bj][m][n], 0, 0, 0); __builtin_amdgcn_s_setprio(0); } while (0)
#define PG8_WAIT_V(n) asm volatile("s_waitcnt vmcnt(" #n ")" ::: "memory")
#define PG8_WAIT_L(n) asm volatile("s_waitcnt lgkmcnt(" #n ")" ::: "memory")
#define PG8_BAR __builtin_amdgcn_s_barrier()
#define PG8_SCHED __builtin_amdgcn_sched_barrier(0)
    Unit cur, nxt; int ui = 0;
    if (!S.next(0, cur)) return;
    f32x4 acc[2][2][4][2];
#pragma unroll
    for (int a = 0; a < 2; ++a)
#pragma unroll
        for (int b = 0; b < 2; ++b)
#pragma unroll
            for (int m = 0; m < 4; ++m)
#pragma unroll
                for (int n = 0; n < 2; ++n) acc[a][b][m][n] = (f32x4){0.f, 0.f, 0.f, 0.f};
    bf16x8 At[4][2], B0[2][2], B1[2][2];
    const char* cA = (const char*)g.A + (size_t)cur.pm * tstep; const char* cB = (const char*)g.Bt + (size_t)cur.pn * tstep;
    S.a_ready(cur);
    if constexpr (SP2) {
        PG8_STAGE(PG8_SB(0, 0), cB, voffB); PG8_STAGE(PG8_SB(0, 1), cB + hstep, voffB); PG8_STAGE(PG8_SA(0, 0), cA, voffA); PG8_STAGE(PG8_SA(0, 1), cA + hstep, voffA);
        if (wr == 1) PG8_BAR;
        PG8_WAIT_V(2); PG8_BAR;
        PG8_STAGE(PG8_SB(1, 0), cB + kstep, voffB); PG8_STAGE(PG8_SA(1, 0), cA + kstep, voffA); PG8_STAGE(PG8_SB(1, 1), cB + hstep + kstep, voffB);
        PG8_WAIT_V(6); PG8_BAR;
    } else {
        PG8_STAGE(PG8_SB(0, 0), cB, voffB); PG8_STAGE(PG8_SA(0, 0), cA, voffA); PG8_STAGE(PG8_SB(0, 1), cB + hstep, voffB); PG8_STAGE(PG8_SA(0, 1), cA + hstep, voffA);
        if (wr == 1) PG8_BAR;
        PG8_WAIT_V(4); PG8_BAR;
        PG8_STAGE(PG8_SB(1, 0), cB + kstep, voffB); PG8_STAGE(PG8_SA(1, 0), cA + kstep, voffA); PG8_STAGE(PG8_SB(1, 1), cB + hstep + kstep, voffB);
        PG8_WAIT_V(6); PG8_BAR;
    }
    for (;;) {
        const bool has_next = S.next(ui + 1, nxt);
        const char* nA = has_next ? (const char*)g.A + (size_t)nxt.pm * tstep : cA; const char* nB = has_next ? (const char*)g.Bt + (size_t)nxt.pn * tstep : cB;
        for (int t = 0; t < nt; t += 2) {
            if constexpr (Epi::MIDK) { if (t == (nt >> 1)) E.mid(acc, cur, wr, wc, fr, fq); }
            const bool last = (t == nt - 2);
            const char* a1 = cA + (size_t)(t + 1) * kstep;
            const char* a2 = last ? nA : cA + (size_t)(t + 2) * kstep; const char* b2 = last ? nB : cB + (size_t)(t + 2) * kstep;
            const char* a3 = a2 + kstep; const char* b3 = b2 + kstep;
            if (last && has_next) S.a_ready(nxt);
            if constexpr (SP2) {
            PG8_LDB(B0, 0, 0); PG8_LDB(B1, 0, 1); PG8_SCHED; PG8_LDA(At, 0, 0); PG8_STAGE(PG8_SA(1, 1), a1 + hstep, voffA);
            PG8_WAIT_V(8); PG8_WAIT_L(0); PG8_BAR; PG8_MMA(0, 0, At, B0); PG8_MMA(0, 1, At, B1); PG8_BAR; PG8_SCHED;
            PG8_LDA(At, 0, 1); PG8_STAGE(PG8_SB(0, 0), b2, voffB); PG8_STAGE(PG8_SB(0, 1), b2 + hstep, voffB); PG8_STAGE(PG8_SA(0, 0), a2, voffA);
            PG8_WAIT_V(8); PG8_WAIT_L(0); PG8_BAR; PG8_MMA(1, 0, At, B0); PG8_MMA(1, 1, At, B1); PG8_BAR; PG8_SCHED;
            PG8_LDB(B0, 1, 0); PG8_LDB(B1, 1, 1); PG8_SCHED; PG8_LDA(At, 1, 0); PG8_STAGE(PG8_SA(0, 1), a2 + hstep, voffA);
            PG8_WAIT_V(8); PG8_WAIT_L(0); PG8_BAR; PG8_MMA(0, 0, At, B0); PG8_MMA(0, 1, At, B1); PG8_BAR; PG8_SCHED;
            PG8_LDA(At, 1, 1); PG8_STAGE(PG8_SB(1, 0), b3, voffB); PG8_STAGE(PG8_SB(1, 1), b3 + hstep, voffB); PG8_STAGE(PG8_SA(1, 0), a3, voffA);
            PG8_WAIT_V(8); PG8_WAIT_L(0); PG8_BAR; PG8_MMA(1, 0, At, B0); PG8_MMA(1, 1, At, B1); PG8_BAR; PG8_SCHED;
            } else {
            PG8_LDB(B0, 0, 0); PG8_SCHED; PG8_LDA(At, 0, 0); PG8_STAGE(PG8_SA(1, 1), a1 + hstep, voffA);
            PG8_WAIT_L(8); PG8_BAR; PG8_WAIT_L(0); PG8_MMA(0, 0, At, B0); PG8_BAR; PG8_SCHED;
            PG8_LDB(B1, 0, 1); PG8_STAGE(PG8_SB(0, 0), b2, voffB);
            PG8_BAR; PG8_WAIT_L(0); PG8_MMA(0, 1, At, B1); PG8_BAR;
            PG8_LDA(At, 0, 1); PG8_STAGE(PG8_SA(0, 0), a2, voffA);
            PG8_BAR; PG8_WAIT_L(0); PG8_MMA(1, 0, At, B0); PG8_BAR; PG8_SCHED;
            PG8_STAGE(PG8_SB(0, 1), b2 + hstep, voffB);
            PG8_WAIT_V(6); PG8_BAR; PG8_MMA(1, 1, At, B1); PG8_BAR;
            PG8_LDB(B0, 1, 0); PG8_SCHED; PG8_LDA(At, 1, 0); PG8_STAGE(PG8_SA(0, 1), a2 + hstep, voffA);
            PG8_WAIT_L(8); PG8_BAR; PG8_WAIT_L(0); PG8_MMA(0, 0, At, B0); PG8_BAR; PG8_SCHED;
            PG8_LDB(B1, 1, 1); PG8_STAGE(PG8_SB(1, 0), b3, voffB);
            PG8_BAR; PG8_WAIT_L(0); PG8_MMA(0, 1, At, B1); PG8_BAR;
            PG8_LDA(At, 1, 1); PG8_STAGE(PG8_SA(1, 0), a3, voffA);
            PG8_BAR; PG8_WAIT_L(0); PG8_MMA(1, 0, At, B0); PG8_BAR; PG8_SCHED;
            PG8_STAGE(PG8_SB(1, 1), b3 + hstep, voffB);
            PG8_WAIT_V(6); PG8_BAR; PG8_MMA(1, 1, At, B1); PG8_BAR;
            }
        }
        if constexpr (ALIGN_EPI) { if (wr == 0) PG8_BAR; }
        if constexpr (!Epi::AFTER_DRAIN) { E(acc, cur, wr, wc, fr, fq); S.done(cur); }
        if (!has_next) break;
#pragma unroll
        for (int a = 0; a < 2; ++a)
#pragma unroll
            for (int b = 0; b < 2; ++b)
#pragma unroll
                for (int m = 0; m < 4; ++m)
#pragma unroll
                    for (int n = 0; n < 2; ++n) acc[a][b][m][n] = (f32x4){0.f, 0.f, 0.f, 0.f};
        cur = nxt; cA = nA; cB = nB; ++ui;
        if constexpr (ALIGN_EPI) { if (wr == 1) PG8_BAR; }
    }
    PG8_WAIT_V(0);
    if constexpr (!ALIGN_EPI) { if (wr == 0) PG8_BAR; }
    PG8_BAR;
    if constexpr (Epi::AFTER_DRAIN) { E.fused(acc, cur, wr, wc, fr, fq, lds, wid, lane); S.done(cur); }
#undef PG8_SA
#undef PG8_SB
#undef PG8_STAGE
#undef PG8_LDA
#undef PG8_LDB
#undef PG8_MMA
#undef PG8_WAIT_V
#undef PG8_WAIT_L
#undef PG8_BAR
#undef PG8_SCHED
}
}
#include <hip/hip_bf16.h>
#include <cmath>
namespace attn_body {
using bf16=__hip_bfloat16;
using bf16x8=__attribute__((ext_vector_type(8)))short;
using s16x4=__attribute__((ext_vector_type(4)))short;
using f32x16=__attribute__((ext_vector_type(16)))float;
using u32x4=__attribute__((ext_vector_type(4)))unsigned;
constexpr int BATCH=4,NHEAD=8,SEQ=8192,D=64,DM=NHEAD*D;
constexpr int ODM=1024; constexpr int NW=8,QBLK=32,QB=QBLK*NW,KVBLK=64,NQB=SEQ/QB;
constexpr int ATTN_PITCH=DM, ATTN_UNIT_ROWS=QB;
__device__ __forceinline__ int crow(int r,int hi){return (r&3)+8*(r>>2)+4*hi;}
#define SBAR() __builtin_amdgcn_sched_barrier(0)
__device__ __forceinline__ void cmask(f32x16&p0,f32x16&p1,int jb,int qrel,int hi){
  const float NEG=-INFINITY; int kb=64*jb+4*hi;
  #pragma unroll
  for(int r=0;r<16;++r){int kv=kb+(r&3)+8*(r>>2); if(kv>qrel)p0[r]=NEG; if(kv+32>qrel)p1[r]=NEG;}
}

constexpr int NSLOT=3, SLOTB=8192;
constexpr int LDS_K=0, LDS_V=NSLOT*SLOTB, LDS_WS=2*NSLOT*SLOTB, LDS_OST=LDS_WS+NW*64*4, LDS_BYTES=LDS_OST+NW*4096;
constexpr float C2=0.125f*1.4426950408889634f; constexpr int LDS_KB=LDS_BYTES;
__device__ __forceinline__ void glds16(const void*gsrc,unsigned lds_dst){unsigned keep;
  asm volatile("s_mov_b32 %0, m0\n\ts_mov_b32 m0, %2\n\ts_nop 0\n\tglobal_load_lds_dwordx4 %1, off\n\ts_mov_b32 m0, %0":"=&s"(keep):"v"(gsrc),"s"(lds_dst):"memory");}
__device__ __forceinline__ float max3f(float a,float b,float c){float r;asm("v_max3_f32 %0, %1, %2, %3":"=v"(r):"v"(a),"v"(b),"v"(c));return r;}
__device__ __forceinline__ float max2f(float a,float b){float r;asm("v_max_f32_e32 %0, %1, %2":"=v"(r):"v"(a),"v"(b));return r;}
__device__ __forceinline__ float fadd_s(float a,float b){float r;asm("v_add_f32_e32 %0, %1, %2":"=v"(r):"v"(a),"v"(b));return r;}
__device__ __forceinline__ float fsub_s(float a,float b){float r;asm("v_sub_f32_e32 %0, %1, %2":"=v"(r):"v"(a),"v"(b));return r;}
typedef float f32x2_t __attribute__((ext_vector_type(2))); typedef __bf16 bf16x2_t __attribute__((ext_vector_type(2)));
__device__ __forceinline__ unsigned cvtpk_s(float lo,float hi){f32x2_t v={lo,hi};bf16x2_t b=__builtin_convertvector(v,bf16x2_t);return __builtin_bit_cast(unsigned,b);}
#define WAIT_BAR(N) asm volatile("s_waitcnt vmcnt(" #N ") lgkmcnt(0)\n\ts_barrier":::"memory")

__device__ __forceinline__ void qkt(f32x16&p0,f32x16&p1,const char*Kslot,const bf16x8*qr,const f32x16&negm,int r32,int hi){
  const char*kb=Kslot+hi*1024+r32*16;
  #pragma unroll
  for(int d0=0;d0<4;++d0){
    const bf16x8 b0=*reinterpret_cast<const bf16x8*>(kb+d0*2048);
    const bf16x8 b1=*reinterpret_cast<const bf16x8*>(kb+d0*2048+512);
    if(d0==0){p0=__builtin_amdgcn_mfma_f32_32x32x16_bf16(b0,qr[0],negm,0,0,0);p1=__builtin_amdgcn_mfma_f32_32x32x16_bf16(b1,qr[0],negm,0,0,0);}
    else{p0=__builtin_amdgcn_mfma_f32_32x32x16_bf16(b0,qr[d0],p0,0,0,0);p1=__builtin_amdgcn_mfma_f32_32x32x16_bf16(b1,qr[d0],p1,0,0,0);}}
}
__device__ __forceinline__ bf16x8 bias_frag(float v,int hi){
  const unsigned h=cvtpk_s(v,0.f)&0xffffu; const float r1=v-__uint_as_float(h<<16);
  const unsigned m=cvtpk_s(r1,0.f)&0xffffu; const float r2=r1-__uint_as_float(m<<16);
  const unsigned l=cvtpk_s(r2,0.f)&0xffffu;
  u32x4 w; w.x=hi?0u:(h|(m<<16)); w.y=hi?0u:l; w.z=0u; w.w=0u; return __builtin_bit_cast(bf16x8,w);
}
typedef __attribute__((address_space(3))) const char* lds_cptr;
typedef short v4i16_t __attribute__((ext_vector_type(4)));
__device__ __forceinline__ void kload8(bf16x8*kf,lds_cptr kp){
  kf[0]=*(const __attribute__((address_space(3))) bf16x8*)(kp);      kf[1]=*(const __attribute__((address_space(3))) bf16x8*)(kp+512);
  kf[2]=*(const __attribute__((address_space(3))) bf16x8*)(kp+2048); kf[3]=*(const __attribute__((address_space(3))) bf16x8*)(kp+2560);
  kf[4]=*(const __attribute__((address_space(3))) bf16x8*)(kp+4096); kf[5]=*(const __attribute__((address_space(3))) bf16x8*)(kp+4608);
  kf[6]=*(const __attribute__((address_space(3))) bf16x8*)(kp+6144); kf[7]=*(const __attribute__((address_space(3))) bf16x8*)(kp+6656);
}
__device__ __forceinline__ void kload2(bf16x8*kf,lds_cptr kp,int j){ kf[2*j]=*(const __attribute__((address_space(3))) bf16x8*)(kp+j*2048); kf[2*j+1]=*(const __attribute__((address_space(3))) bf16x8*)(kp+j*2048+512); }
__device__ __forceinline__ s16x4 vtr(lds_cptr p){ return __builtin_bit_cast(s16x4,__builtin_amdgcn_ds_read_tr16_b64_v4i16((__attribute__((address_space(3))) v4i16_t*)p)); }
__device__ __forceinline__ float rowmax(const f32x16&p0,const f32x16&p1){
  float a=max3f(p0[0],p0[1],p1[0]),b=max3f(p0[2],p0[3],p1[1]);a=max3f(a,p1[2],p1[3]);
  #pragma unroll
  for(int r=4;r<16;r+=4){a=max3f(a,p0[r],p0[r+1]);b=max3f(b,p0[r+2],p0[r+3]);a=max3f(a,p1[r],p1[r+1]);b=max3f(b,p1[r+2],p1[r+3]);}
  const float m=max2f(a,b);
  auto rr=__builtin_amdgcn_permlane32_swap(__float_as_uint(m),__float_as_uint(m),false,false);
  return max2f(__uint_as_float(rr[0]),__uint_as_float(rr[1]));
}
__device__ __forceinline__ void pv(f32x16*o,int vb,bf16x8 pa0,bf16x8 pa1,bf16x8 pa2,bf16x8 pa3){
  #pragma unroll
  for(int d0=0;d0<2;++d0){s16x4 lo[4],hi[4];
    #pragma unroll
    for(int ks=0;ks<4;++ks){
      asm volatile("ds_read_b64_tr_b16 %0,%1 offset:%c2":"=&v"(lo[ks]):"v"(vb),"i"(d0*4096+ks*1024):"memory");
      asm volatile("ds_read_b64_tr_b16 %0,%1 offset:%c2":"=&v"(hi[ks]):"v"(vb),"i"(d0*4096+ks*1024+512):"memory");}
    asm volatile("s_waitcnt lgkmcnt(0)":::"memory");SBAR();
    #define PK(k) (bf16x8){lo[k][0],lo[k][1],lo[k][2],lo[k][3],hi[k][0],hi[k][1],hi[k][2],hi[k][3]}
    o[d0]=__builtin_amdgcn_mfma_f32_32x32x16_bf16(pa0,PK(0),o[d0],0,0,0);
    o[d0]=__builtin_amdgcn_mfma_f32_32x32x16_bf16(pa1,PK(1),o[d0],0,0,0);
    o[d0]=__builtin_amdgcn_mfma_f32_32x32x16_bf16(pa2,PK(2),o[d0],0,0,0);
    o[d0]=__builtin_amdgcn_mfma_f32_32x32x16_bf16(pa3,PK(3),o[d0],0,0,0);
    #undef PK
  }
}

#ifndef ATTN_STORE16
#define ATTN_STORE16(p,v) (*(u32x4*)(p)=(v))
#endif
template<int THRL> __device__ __forceinline__ void attn_unit(int b,int h,int qb,const bf16*Q,const bf16*__restrict__ K,const bf16*__restrict__ V,bf16*O,const float*__restrict__ CUM,const float*NRM,char*shm,int wave_in){
  int tid_; { int ln_; asm volatile("v_mbcnt_lo_u32_b32 %0, -1, 0\n\tv_mbcnt_hi_u32_b32 %0, -1, %0" : "=v"(ln_)); tid_ = wave_in * 64 + ln_; }
  const int tid=tid_,lane=tid&63,r32=lane&31,hi=lane>>5; const int wid=__builtin_amdgcn_readfirstlane(tid>>6);
  const long rowbase=(long)b*SEQ; const int q0=qb*QB;
  const __attribute__((address_space(1))) float*cu=(const __attribute__((address_space(1))) float*)(CUM+((long)b*NHEAD+h)*SEQ); const float c0=cu[q0];
  int t0;
  { const __attribute__((address_space(1))) float*nrm=(const __attribute__((address_space(1))) float*)NRM; const int bh32=(b*NHEAD+h)*32;
    float kn=(lane<=qb)?nrm[1024+bh32+lane]:0.f;
    #pragma unroll
    for(int o=1;o<64;o<<=1)kn=__builtin_fmaxf(kn,lane_read(kn,lane^o));
    const float thr=-(2.f*nrm[bh32+qb]*kn+49.f);
    int cnt=0; for(int i=lane;i<(q0+QB)/KVBLK;i+=64)cnt+=((c0-cu[KVBLK*i+KVBLK-1])*1.4426950408889634f<thr)?1:0;
    #pragma unroll
    for(int o=1;o<64;o<<=1)cnt+=(int)lane_read_u((unsigned)cnt,lane^o);
    cnt&=~1; const int lim=(q0+QB)/KVBLK-4; t0=__builtin_amdgcn_readfirstlane(cnt<lim?cnt:lim); }
  const bf16*Qw=Q+(rowbase+q0+wid*QBLK)*DM+h*D;
  const bf16*Kh=K+(rowbase+(long)t0*KVBLK)*DM+h*D,*Vh=V+(rowbase+(long)t0*KVBLK)*DM+h*D;
  const unsigned lds0=(unsigned)(uintptr_t)shm;
  float*wsf=(float*)(shm+LDS_WS)+wid*64;
  const bf16*ksrc=Kh+(long)lane*DM+wid*8;
  const bf16*vsrc=Vh+(long)(16*(wid&3)+(lane>>2))*DM+(wid>>2)*32+(lane&3)*8;
  const unsigned kdst=lds0+LDS_K+wid*1024, vdst=lds0+LDS_V+wid*1024;
  #define DMA_K(t,slot) glds16(ksrc+(long)(t)*KVBLK*DM,(unsigned)__builtin_amdgcn_readfirstlane(kdst+(slot)))
  #define DMA_V(t,slot) glds16(vsrc+(long)(t)*KVBLK*DM,(unsigned)__builtin_amdgcn_readfirstlane(vdst+(slot)))
  const int vb0=(int)(lds0+LDS_V)+((lane>>4)&1)*32+(lane&3)*8+(4*hi+((lane&15)>>2))*64;
  const char*Kbase=shm+LDS_K; bf16x8 kf[8];
  const lds_cptr shm3=(lds_cptr)shm; const lds_cptr kp0=shm3+LDS_K+hi*1024+r32*16; const lds_cptr vp0=shm3+LDS_V+((lane>>4)&1)*32+(lane&3)*8+(4*hi+((lane&15)>>2))*64;
  const int NT=(q0+QB)/KVBLK-t0;
  float*kbl=(float*)(shm+LDS_KB);
  { const int sk=t0*KVBLK;
    for(int s=tid;s<q0+QB-sk;s+=NW*64)kbl[s]=(c0-cu[s+sk])*1.4426950408889634f;
    asm volatile("s_waitcnt vmcnt(0)":::"memory"); }
  const bf16x8 ones=__builtin_bit_cast(bf16x8,(u32x4){hi?0u:0x3f803f80u,hi?0u:0x00003f80u,0u,0u});
  DMA_K(0,0);DMA_V(0,0);DMA_K(1,SLOTB);
  bf16x8 qr[4];
  #pragma unroll
  for(int d0=0;d0<4;++d0)qr[d0]=*reinterpret_cast<const bf16x8*>(&Qw[(long)r32*DM+d0*16+hi*8]);
  float mhat=0.f,l_reg=0.f;f32x16 o[2];o[0]=f32x16{};o[1]=f32x16{};f32x16 negm=f32x16{};asm volatile("":"+v"(negm));
  const int qrel=wid*QBLK+r32;
  #define CMASK(P0,P1,t) do{int jb_=(t)-(NT-4); if(jb_>=0)cmask(P0,P1,jb_,qrel,hi);}while(0)
  bool resc=false;
  #define START(P0,P1) do{ const float rm=rowmax(P0,P1); resc=false; \
    { const float dl=__builtin_fmaxf(rm,0.f); mhat=fadd_s(mhat,dl); \
      _Pragma("unroll") for(int r=0;r<16;++r){P0[r]=fsub_s(P0[r],dl);P1[r]=fsub_s(P1[r],dl);} \
      _Pragma("unroll") for(int r=0;r<16;++r)negm[r]=-mhat; asm volatile("":"+v"(negm)); } \
    _Pragma("unroll") for(int r=0;r<16;++r)P0[r]=__builtin_amdgcn_exp2f(P0[r]); }while(0)
  #define RESC() do{ if(resc){ asm volatile("s_waitcnt lgkmcnt(0)":::"memory"); \
      _Pragma("unroll") for(int d_=0;d_<2;++d_) _Pragma("unroll") for(int r=0;r<16;++r)o[d_][r]*=wsf[crow(r,hi)]; } }while(0)
  f32x16 pA0,pA1,pB0,pB1;
  int sl_prev=0,sl_cur=0,sl_next=SLOTB;
  #define ROT() do{sl_prev=sl_cur;sl_cur=sl_next;sl_next=(sl_next==(NSLOT-1)*SLOTB)?0:sl_next+SLOTB;}while(0)
  DMA_K(2,2*SLOTB);
  WAIT_BAR(3);
  qkt(pA0,pA1,Kbase,qr,negm,r32,hi);
  pA0=__builtin_amdgcn_mfma_f32_32x32x16_bf16(bias_frag(kbl[r32],hi),ones,pA0,0,0,0);pA1=__builtin_amdgcn_mfma_f32_32x32x16_bf16(bias_frag(kbl[32+r32],hi),ones,pA1,0,0,0);
  asm volatile("s_nop 15\n\ts_nop 7":"+v"(pA0),"+v"(pA1));CMASK(pA0,pA1,0);
  START(pA0,pA1);
  _Pragma("unroll") for(int r=0;r<16;++r)pA1[r]=__builtin_amdgcn_exp2f(pA1[r]);
  WAIT_BAR(0);
  DMA_K(3,0);DMA_V(1,SLOTB);
  ROT();
  kload8(kf,kp0+sl_cur);
  WAIT_BAR(2);
  s16x4 vlo[8],vhi[8]; u32x4 pw0,pw1,pw2,pw3;
  #define PKW(P,B) cvtpk_s(P[B],P[B+1])
  #define PAF(k) __builtin_bit_cast(bf16x8,pw##k)
  #define VFR(i) (bf16x8){vlo[i][0],vlo[i][1],vlo[i][2],vlo[i][3],vhi[i][0],vhi[i][1],vhi[i][2],vhi[i][3]}
  #define PIN(x) asm volatile("":"+v"(x))
  #define MX3(a,b,c) __builtin_fmaxf(__builtin_fmaxf((a),(b)),(c))
  #define GAPA(MF,A0,A1,A2,A3,W0,W1,PW) do{ MF; sacc+=A0; sacc+=A1; sacc+=A2; sacc+=A3; PIN(sacc); W0; W1; PIN(PW); SBAR(); }while(0)
  #define EX(v) __builtin_amdgcn_exp2f(v)
  #define GAPB(MF,X,B) do{ MF; X[B]=EX(X[B]); X[B+1]=EX(X[B+1]); X[B+2]=EX(X[B+2]); X[B+3]=EX(X[B+3]); PIN(X); SBAR(); }while(0)
  #define VRD(i) do{ vlo[i]=vtr(vp_+(((i)>>2)*4096+((i)&3)*1024)); vhi[i]=vtr(vp_+(((i)>>2)*4096+((i)&3)*1024+512)); }while(0)
  #define KRD(G,j) do{ if(G){ kload2(kf,kp0+sl_next,j); SBAR(); } }while(0)
  #define STEP(C0,C1,P0,P1,t,GK,GV,GL) do{ SBAR(); \
    const lds_cptr vp_=vp0+sl_prev; \
    const bf16x8 kbf0_=bias_frag(kbl[(t)*KVBLK+r32],hi), kbf1_=bias_frag(kbl[(t)*KVBLK+32+r32],hi); \
    VRD(0); SBAR(); float sacc=(P0[0]+P0[1]); \
    GAPA(C0=__builtin_amdgcn_mfma_f32_32x32x16_bf16(kf[0],qr[0],negm,0,0,0), P0[2],P0[3],P0[4],P0[5],     pw0[0]=PKW(P0,0), pw0[1]=PKW(P0,2), pw0); \
    VRD(4); SBAR(); GAPA(C1=__builtin_amdgcn_mfma_f32_32x32x16_bf16(kf[1],qr[0],negm,0,0,0), P0[6],P0[7],P0[8],P0[9],     pw0[2]=PKW(P0,4), pw0[3]=PKW(P0,6), pw0); \
    VRD(1); SBAR(); GAPA(C0=__builtin_amdgcn_mfma_f32_32x32x16_bf16(kf[2],qr[1],C0,0,0,0),   P0[10],P0[11],P0[12],P0[13], pw1[0]=PKW(P0,8), pw1[1]=PKW(P0,10), pw1); \
    VRD(5); SBAR(); GAPA(C1=__builtin_amdgcn_mfma_f32_32x32x16_bf16(kf[3],qr[1],C1,0,0,0),   P0[14],P0[15],P1[0],P1[1],   pw1[2]=PKW(P0,12),pw1[3]=PKW(P0,14), pw1); \
    VRD(2); SBAR(); GAPA(C0=__builtin_amdgcn_mfma_f32_32x32x16_bf16(kf[4],qr[2],C0,0,0,0),   P1[2],P1[3],P1[4],P1[5],     pw2[0]=PKW(P1,0), pw2[1]=PKW(P1,2), pw2); \
    VRD(6); SBAR(); GAPA(C1=__builtin_amdgcn_mfma_f32_32x32x16_bf16(kf[5],qr[2],C1,0,0,0),   P1[6],P1[7],P1[8],P1[9],     pw2[2]=PKW(P1,4), pw2[3]=PKW(P1,6), pw2); \
    VRD(3); SBAR(); GAPA(C0=__builtin_amdgcn_mfma_f32_32x32x16_bf16(kf[6],qr[3],C0,0,0,0),   P1[10],P1[11],P1[12],P1[13], pw3[0]=PKW(P1,8), pw3[1]=PKW(P1,10), pw3); \
    VRD(7); SBAR(); GAPA(C1=__builtin_amdgcn_mfma_f32_32x32x16_bf16(kf[7],qr[3],C1,0,0,0),   P1[14],P1[15],0.f,0.f,       pw3[2]=PKW(P1,12),pw3[3]=PKW(P1,14), pw3); \
    C0=__builtin_amdgcn_mfma_f32_32x32x16_bf16(kbf0_,ones,C0,0,0,0); C1=__builtin_amdgcn_mfma_f32_32x32x16_bf16(kbf1_,ones,C1,0,0,0); \
    l_reg+=sacc; \
    if(GK){DMA_K((t)+3,sl_cur);} if(GV){DMA_V((t)+1,sl_next);} \
    CMASK(C0,C1,t); \
    { float a=MX3(C0[0],C0[1],C1[0]),b=MX3(C0[2],C0[3],C1[1]); a=MX3(a,C1[2],C1[3]); \
      _Pragma("unroll") for(int r=4;r<16;r+=4){a=MX3(a,C0[r],C0[r+1]);b=MX3(b,C0[r+2],C0[r+3]);a=MX3(a,C1[r],C1[r+1]);b=MX3(b,C1[r+2],C1[r+3]);} \
      float rm=__builtin_fmaxf(a,b); { auto rr=__builtin_amdgcn_permlane32_swap(__float_as_uint(rm),__float_as_uint(rm),false,false); rm=__builtin_fmaxf(__uint_as_float(rr[0]),__uint_as_float(rr[1])); } \
      resc=false; \
      if(__builtin_expect(__any(rm>(float)THRL),0)){ const float dl=__builtin_fmaxf(rm,0.f); mhat+=dl; \
        _Pragma("unroll") for(int r=0;r<16;++r){C0[r]-=dl;C1[r]-=dl;} \
        _Pragma("unroll") for(int r=0;r<16;++r)negm[r]=-mhat; asm volatile("":"+v"(negm)); \
        const float f=__builtin_amdgcn_exp2f(-dl); l_reg*=f; if(hi==0)wsf[r32]=f; resc=true; } } \
    SBAR(); \
    GAPB(o[0]=__builtin_amdgcn_mfma_f32_32x32x16_bf16(PAF(0),VFR(0),o[0],0,0,0), C0,0); \
    GAPB(o[1]=__builtin_amdgcn_mfma_f32_32x32x16_bf16(PAF(0),VFR(4),o[1],0,0,0), C0,4); \
    KRD(GL,0); GAPB(o[0]=__builtin_amdgcn_mfma_f32_32x32x16_bf16(PAF(1),VFR(1),o[0],0,0,0), C0,8); \
    KRD(GL,1); GAPB(o[1]=__builtin_amdgcn_mfma_f32_32x32x16_bf16(PAF(1),VFR(5),o[1],0,0,0), C0,12); \
    KRD(GL,2); GAPB(o[0]=__builtin_amdgcn_mfma_f32_32x32x16_bf16(PAF(2),VFR(2),o[0],0,0,0), C1,0); \
    KRD(GL,3); GAPB(o[1]=__builtin_amdgcn_mfma_f32_32x32x16_bf16(PAF(2),VFR(6),o[1],0,0,0), C1,4); \
    GAPB(o[0]=__builtin_amdgcn_mfma_f32_32x32x16_bf16(PAF(3),VFR(3),o[0],0,0,0), C1,8); \
    GAPB(o[1]=__builtin_amdgcn_mfma_f32_32x32x16_bf16(PAF(3),VFR(7),o[1],0,0,0), C1,12); \
    }while(0)
  int t=1;
  #undef CMASK
  #define CMASK(P0,P1,t) do{}while(0)
  for(;t+5<NT;t+=2){
    STEP(pB0,pB1,pA0,pA1,t,true,true,true);     WAIT_BAR(2); RESC(); ROT();
    STEP(pA0,pA1,pB0,pB1,t+1,true,true,true);   WAIT_BAR(2); RESC(); ROT();
  }
  #undef CMASK
  #define CMASK(P0,P1,t) do{int jb_=(t)-(NT-4); if(jb_>=0)cmask(P0,P1,jb_,qrel,hi);}while(0)
  #define ENDW(tt) do{ if((tt)+3<NT){WAIT_BAR(2);} else if((tt)+2<NT){WAIT_BAR(1);} else {WAIT_BAR(0);} }while(0)
  for(;t+1<NT;t+=2){
    STEP(pB0,pB1,pA0,pA1,t,(t+3<NT),(t+1<NT),(t+1<NT));       ENDW(t);   RESC(); ROT();
    STEP(pA0,pA1,pB0,pB1,t+1,(t+4<NT),(t+2<NT),(t+2<NT));     ENDW(t+1); RESC(); ROT();
  }
  STEP(pB0,pB1,pA0,pA1,NT-1,false,false,false); RESC();
  { float sacc=pB0[0]+pB0[1]; _Pragma("unroll") for(int r=2;r<16;++r)sacc+=pB0[r]; _Pragma("unroll") for(int r=0;r<16;++r)sacc+=pB1[r]; l_reg+=sacc;
    pw0=(u32x4){PKW(pB0,0),PKW(pB0,2),PKW(pB0,4),PKW(pB0,6)};pw1=(u32x4){PKW(pB0,8),PKW(pB0,10),PKW(pB0,12),PKW(pB0,14)};pw2=(u32x4){PKW(pB1,0),PKW(pB1,2),PKW(pB1,4),PKW(pB1,6)};pw3=(u32x4){PKW(pB1,8),PKW(pB1,10),PKW(pB1,12),PKW(pB1,14)};
    SBAR(); pv(o,vb0+sl_cur,PAF(0),PAF(1),PAF(2),PAF(3)); }
  #undef PKW
  #undef PAF
  #undef VFR
  #undef PIN
  #undef MX3
  #undef GAPA
  #undef GAPB
  #undef EX
  #undef VRD
  #undef KRD
  #undef STEP
  #undef ENDW
  {auto rr=__builtin_amdgcn_permlane32_swap(__float_as_uint(l_reg),__float_as_uint(l_reg),false,false);l_reg=__uint_as_float(rr[0])+__uint_as_float(rr[1]);}
  if(hi==0)wsf[32+r32]=l_reg;asm volatile("s_waitcnt lgkmcnt(0)":::"memory");
  float rli[16];
  #pragma unroll
  for(int r=0;r<16;++r)rli[r]=__builtin_amdgcn_rcpf(wsf[32+crow(r,hi)]);
  bf16*Ow=O+(rowbase+q0+wid*QBLK)*ODM+h*D;
  { bf16*stg=(bf16*)(shm+LDS_OST)+wid*2048;
    #pragma unroll
    for(int r=0;r<16;++r){const int orow=crow(r,hi);
      #pragma unroll
      for(int d0=0;d0<2;++d0)stg[orow*64+d0*32+r32]=__float2bfloat16(o[d0][r]*rli[r]);}
    asm volatile("s_waitcnt lgkmcnt(0)":::"memory");
    #pragma unroll
    for(int i=0;i<4;++i){const int row=i*8+(lane>>3),ch=lane&7; const u32x4 v=*(const u32x4*)(stg+row*64+ch*8); ATTN_STORE16(Ow+(long)row*ODM+ch*8,v);} }
  asm volatile("s_waitcnt lgkmcnt(0)\n\ts_barrier":::"memory");
  #undef DMA_K
  #undef DMA_V
  #undef CMASK
  #undef START
  #undef RESC
  #undef ROT
}
constexpr int ATTN_LDS_BYTES=LDS_BYTES+SEQ*4;
struct AttnTensors { const bf16* Q; const bf16* K; const bf16* V; bf16* O; const float* CUM; const float* NRM; };
struct AttnUnit { int bh; int qb; };
struct StaticOrder {
  int vcu;
  __device__ __forceinline__ explicit StaticOrder(int grid,int block):vcu((block%8)*(grid/8)+block/8){}
  __device__ __forceinline__ bool next(int i,AttnUnit&u)const{ if(i>=4)return false; const int s=vcu&7; u.bh=vcu>>3; u.qb=(i==0)?s:(i==1)?15-s:(i==2)?16+s:31-s; return true; }
  __device__ __forceinline__ void a_ready(const AttnUnit&)const{}
  __device__ __forceinline__ void done(const AttnUnit&)const{}
};
template<class Sched,int THRL=8> __device__ __forceinline__ void attn_phase(char*lds,const AttnTensors&T,const Sched&S,int wave_in){
  AttnUnit u;
  for(int i=0;S.next(i,u);++i){ S.a_ready(u); attn_unit<THRL>(u.bh/NHEAD,u.bh%NHEAD,u.qb,T.Q,T.K,T.V,T.O,T.CUM,T.NRM,lds,wave_in); S.done(u); }
}
#undef SBAR
#undef WAIT_BAR
}
namespace dsa {
typedef __attribute__((address_space(3))) unsigned char* ldsp;
typedef float f32x16 __attribute__((ext_vector_type(16)));
typedef float f32x4 __attribute__((ext_vector_type(4)));
typedef short bf16x8 __attribute__((ext_vector_type(8)));
typedef short s16x4 __attribute__((ext_vector_type(4)));
typedef unsigned u32x4 __attribute__((ext_vector_type(4)));
typedef unsigned u32x2 __attribute__((ext_vector_type(2)));
typedef unsigned short bf16;
#define DLAS __attribute__((address_space(3)))
#define DGAS __attribute__((address_space(1)))
constexpr int NBIN = 512, CAP2 = 192, TOPK = 256;
constexpr int L_LBK = 64 * CAP2 * 4;
constexpr int L_HIST = 0;
constexpr int L_LISTA = 73728;
constexpr int L_CNTA = L_LISTA + 32768, L_CNTB = L_CNTA + 256, L_THR = L_CNTB + 256, L_R = L_THR + 256, L_NSEL = L_R + 256, L_LSUM = L_NSEL + 256, L_POOLC = L_LSUM + 512, L_CNTA1 = L_POOLC + 16, L_KW = L_CNTA1 + 256, L_END = L_KW + 8 * CAP2 * 4;
constexpr int STASH_B = 16, STASH_A = 12;
constexpr int POOLCAP = 8192;
constexpr int VST = 144;
static_assert(8 * 64 * VST <= L_LISTA && 64 * CAP2 * 6 <= L_LISTA && 64 * NBIN * 2 <= L_LISTA && L_END <= 131072, "dsa LDS map");

__device__ __forceinline__ unsigned wave_incl_prefix(unsigned x) {
    x += (unsigned)__builtin_amdgcn_update_dpp(0, (int)x, 0x111, 0xf, 0xf, true);
    x += (unsigned)__builtin_amdgcn_update_dpp(0, (int)x, 0x112, 0xf, 0xf, true);
    x += (unsigned)__builtin_amdgcn_update_dpp(0, (int)x, 0x114, 0xf, 0xf, true);
    x += (unsigned)__builtin_amdgcn_update_dpp(0, (int)x, 0x118, 0xf, 0xf, true);
    x += (unsigned)__builtin_amdgcn_update_dpp(0, (int)x, 0x142, 0xa, 0xf, false);
    x += (unsigned)__builtin_amdgcn_update_dpp(0, (int)x, 0x143, 0xc, 0xf, false);
    return x;
}
__device__ __forceinline__ int score_bin(float s, int e0) {
    const unsigned u = __float_as_uint(s);
    int rel = (int)((u >> 19) & 0xFFFu) - e0; rel = rel < 0 ? 0 : (rel > 255 ? 255 : rel);
    return ((int)u < 0) ? 255 - rel : 256 + rel;
}
__device__ __forceinline__ float fmac_s(float a, float b, float acc) { asm("v_fmac_f32_e32 %0, %1, %2" : "+v"(acc) : "v"(a), "v"(b)); return acc; }
__device__ __forceinline__ float bin_edge(int b, int e0) {
    if (b >= 257) { const int r = b - 256; if (r > 255) return INFINITY; int E = e0 + r; if (E <= 0) return 0.f; if (E > 0xFF0) E = 0xFF0; return __uint_as_float((unsigned)E << 19); }
    if (b == 256) return 0.f;
    const int rp = 255 - b; if (rp >= 255) return -INFINITY;
    const int E = e0 + rp + 1; if (E <= 0) return 0.f; if (E > 0xFF0) return -3.402823466e38f;
    return __uint_as_float(0x80000000u | (((unsigned)E << 19) - 1u));
}
#define DSA_MF "v_mfma_f32_16x16x32_bf16 "
__device__ __forceinline__ void tile_open(f32x4& sc0, f32x4& sc1, f32x4& a0, f32x4& a1, const bf16x8 (&kf)[2][2], const bf16x8 (&ql)[2], const bf16x8 (&q0)[2]) {
    asm volatile(DSA_MF "%0, %4, %8, 0\n\t" DSA_MF "%1, %6, %8, 0\n\t" DSA_MF "%0, %5, %9, %0\n\t" DSA_MF "%1, %7, %9, %1\n\t"
                 DSA_MF "%2, %4, %10, 0\n\t" DSA_MF "%3, %6, %10, 0\n\t" DSA_MF "%2, %5, %11, %2\n\t" DSA_MF "%3, %7, %11, %3"
                 : "=&v"(sc0), "=&v"(sc1), "=&v"(a0), "=&v"(a1)
                 : "v"(kf[0][0]), "v"(kf[0][1]), "v"(kf[1][0]), "v"(kf[1][1]), "v"(ql[0]), "v"(ql[1]), "v"(q0[0]), "v"(q0[1]));
}
template <bool FIRST>
__device__ __forceinline__ void head_step(f32x4& b0, f32x4& b1, f32x4& sc0, f32x4& sc1, const f32x4& a0, const f32x4& a1, float wh, const bf16x8 (&kf)[2][2], const bf16x8 (&qn)[2]) {
#define DSA_HS(NOP) asm volatile(DSA_MF "%0, %19, %23, 0\n\t" DSA_MF "%1, %21, %23, 0\n\t" NOP \
                 "v_fma_f32 %2, |%10|, %18, %2\n\tv_fma_f32 %3, |%11|, %18, %3\n\t" DSA_MF "%0, %20, %24, %0\n\t" \
                 "v_fma_f32 %4, |%12|, %18, %4\n\tv_fma_f32 %5, |%13|, %18, %5\n\t" DSA_MF "%1, %22, %24, %1\n\t" \
                 "v_fma_f32 %6, |%14|, %18, %6\n\tv_fma_f32 %7, |%15|, %18, %7\n\tv_fma_f32 %8, |%16|, %18, %8\n\tv_fma_f32 %9, |%17|, %18, %9" \
                 : "=&v"(b0), "=&v"(b1), "+v"(sc0[0]), "+v"(sc0[1]), "+v"(sc0[2]), "+v"(sc0[3]), "+v"(sc1[0]), "+v"(sc1[1]), "+v"(sc1[2]), "+v"(sc1[3]) \
                 : "v"(a0[0]), "v"(a0[1]), "v"(a0[2]), "v"(a0[3]), "v"(a1[0]), "v"(a1[1]), "v"(a1[2]), "v"(a1[3]), "v"(wh), \
                   "v"(kf[0][0]), "v"(kf[0][1]), "v"(kf[1][0]), "v"(kf[1][1]), "v"(qn[0]), "v"(qn[1]))
    if (FIRST) DSA_HS("s_nop 3\n\t"); else DSA_HS("");
#undef DSA_HS
}
__device__ __forceinline__ void abs_fma8(f32x4& s0, f32x4& s1, const f32x4& a0, const f32x4& a1, float wh) {
    asm volatile("s_nop 1\n\tv_fma_f32 %0, |%8|, %16, %0\n\tv_fma_f32 %1, |%9|, %16, %1\n\tv_fma_f32 %2, |%10|, %16, %2\n\tv_fma_f32 %3, |%11|, %16, %3\n\t"
                 "v_fma_f32 %4, |%12|, %16, %4\n\tv_fma_f32 %5, |%13|, %16, %5\n\tv_fma_f32 %6, |%14|, %16, %6\n\tv_fma_f32 %7, |%15|, %16, %7"
                 : "+v"(s0[0]), "+v"(s0[1]), "+v"(s0[2]), "+v"(s0[3]), "+v"(s1[0]), "+v"(s1[1]), "+v"(s1[2]), "+v"(s1[3])
                 : "v"(a0[0]), "v"(a0[1]), "v"(a0[2]), "v"(a0[3]), "v"(a1[0]), "v"(a1[1]), "v"(a1[2]), "v"(a1[3]), "v"(wh));
}
__device__ __forceinline__ float relu_i(float x) { const int b = __builtin_bit_cast(int, x); return __builtin_bit_cast(float, b > 0 ? b : 0); }
__device__ __forceinline__ bool ahead(float sj, unsigned ij, float si, unsigned ii) { return sj > si || (sj == si && ij < ii); }

template <bool PASS2>
__device__ __forceinline__ void score_consume(ldsp L, DGAS u32x2* pool, const f32x4& sc0, const f32x4& sc1, int j, int qloc, int g, int e0, float tauA, float tauB) {
    if (!PASS2) {
#pragma unroll
        for (int k = 0; k < 8; ++k) { const unsigned u = __float_as_uint((k >> 2) ? sc1[k & 3] : sc0[k & 3]);
            int rel = (int)((u >> 19) & 0xFFFu) - e0; rel = rel < 0 ? 0 : (rel > 255 ? 255 : rel);
            __hip_atomic_fetch_add((DLAS unsigned*)(L + L_HIST + qloc * (NBIN * 2)) + rel, (int)u < 0 ? 0x10000u : 1u, __ATOMIC_RELAXED, __HIP_MEMORY_SCOPE_WORKGROUP); }
    }
}
struct Pend { unsigned mA, mB, pa, pb; int j; f32x4 s0, s1; };
__device__ __forceinline__ void pend_issue(ldsp L, Pend& P, const f32x4& sc0, const f32x4& sc1, int j, int qloc, float tauA, float tauB) {
    unsigned mA = 0u, mB = 0u;
#pragma unroll
    for (int k = 0; k < 8; ++k) { const float x = (k >> 2) ? sc1[k & 3] : sc0[k & 3]; mA |= (x >= tauA) ? (1u << k) : 0u; mB |= (x >= tauB && !(x >= tauA)) ? (1u << k) : 0u; }
    const bool up = (j & 1) == 0;
    P.pa = __hip_atomic_fetch_add((DLAS unsigned*)(L + (up ? L_CNTA : L_CNTA1)) + qloc, (unsigned)__builtin_popcount(mA), __ATOMIC_RELAXED, __HIP_MEMORY_SCOPE_WORKGROUP);
    P.pb = __hip_atomic_fetch_add((DLAS unsigned*)(L + L_CNTB) + qloc, (unsigned)__builtin_popcount(mB), __ATOMIC_RELAXED, __HIP_MEMORY_SCOPE_WORKGROUP);
    P.mA = mA; P.mB = mB; P.j = j; P.s0 = sc0; P.s1 = sc1;
}
__device__ __forceinline__ void pend_finish(ldsp L, DGAS u32x2* pool, Pend& P, int qloc, int g) {
    const bool up = (P.j & 1) == 0;
    unsigned pa = P.pa, pb = P.pb;
    const unsigned kbase = (unsigned)(32 * P.j + 4 * g);
    {
        DLAS unsigned short* la = (DLAS unsigned short*)(L + L_LISTA) + qloc * TOPK;
        for (unsigned m = P.mA; m; m &= m - 1u) { const unsigned k = (unsigned)__builtin_ctz(m);
            if (pa < (unsigned)TOPK) la[up ? pa : (unsigned)(TOPK - 1) - pa] = (unsigned short)(kbase + 4u * (k & 4u) + (k & 3u)); ++pa; }
    }
    {
        DLAS float* lbs = (DLAS float*)(L + L_HIST) + qloc * CAP2; DLAS unsigned short* lbk = (DLAS unsigned short*)(L + L_LBK) + qloc * CAP2;
        for (unsigned m = P.mB; m; m &= m - 1u) { const unsigned k = (unsigned)__builtin_ctz(m);
            const f32x4 v = (k & 4u) ? P.s1 : P.s0; const float xs = (k & 2u) ? ((k & 1u) ? v[3] : v[2]) : ((k & 1u) ? v[1] : v[0]); const unsigned key = kbase + 4u * (k & 4u) + (k & 3u);
            if (pb < (unsigned)CAP2) { lbs[pb] = xs; lbk[pb] = (unsigned short)key; }
            else { const unsigned gp = __hip_atomic_fetch_add((DLAS unsigned*)(L + L_POOLC), 1u, __ATOMIC_RELAXED, __HIP_MEMORY_SCOPE_WORKGROUP); if (gp < (unsigned)POOLCAP) pool[gp] = (u32x2){__float_as_uint(xs), ((unsigned)qloc << 16) | key}; }
            ++pb; }
    }
    P.mA = 0u; P.mB = 0u;
}
template <bool PASS2>
__device__ __forceinline__ void score_tile(ldsp L, DGAS u32x2* pool, const bf16x8 (&kf)[2][2], int j, int qloc, int g, const bf16x8 (&qf)[8][2], const bf16x8 (&ql)[2], const float (&w)[8], int e0, float tauA, float tauB, __amdgpu_buffer_rsrc_t rsS, int so, int lane, Pend& P) {
    f32x4 sc0, sc1, a0, a1, b0, b1;
    tile_open(sc0, sc1, a0, a1, kf, ql, qf[0]);
    head_step<true>(b0, b1, sc0, sc1, a0, a1, w[0], kf, qf[1]);
    head_step<false>(a0, a1, sc0, sc1, b0, b1, w[1], kf, qf[2]);
    head_step<false>(b0, b1, sc0, sc1, a0, a1, w[2], kf, qf[3]);
    head_step<false>(a0, a1, sc0, sc1, b0, b1, w[3], kf, qf[4]);
    head_step<false>(b0, b1, sc0, sc1, a0, a1, w[4], kf, qf[5]);
    head_step<false>(a0, a1, sc0, sc1, b0, b1, w[5], kf, qf[6]);
    head_step<false>(b0, b1, sc0, sc1, a0, a1, w[6], kf, qf[7]);
    abs_fma8(sc0, sc1, b0, b1, w[7]);
    if (!PASS2) { if (so >= 0) { __builtin_amdgcn_raw_buffer_store_b128(__builtin_bit_cast(u32x4, sc0), rsS, lane * 16, so, 16); __builtin_amdgcn_raw_buffer_store_b128(__builtin_bit_cast(u32x4, sc1), rsS, 1024 + lane * 16, so, 16); } }
    if (PASS2) { pend_finish(L, pool, P, qloc, g); pend_issue(L, P, sc0, sc1, j, qloc, tauA, tauB); }
    else score_consume<false>(L, pool, sc0, sc1, j, qloc, g, e0, tauA, tauB);
}
template <bool PASS2>
__device__ __forceinline__ void score_pass(ldsp L, DGAS u32x2* pool, const DGAS bf16* KIb, int NT, int kh, int qloc, int n16, int g, const bf16x8 (&qf)[8][2], const bf16x8 (&ql)[2], const float (&w)[8], int e0, float tauA, float tauB, DGAS f32x4* stB, DGAS f32x4* stA, int lane) {
    const int nIt = (NT - kh + 1) >> 1;
    const int nS = stB ? (nIt < STASH_B + STASH_A ? nIt : STASH_B + STASH_A) : 0;
    const __amdgpu_buffer_rsrc_t rsB = __builtin_amdgcn_make_buffer_rsrc((void*)stB, (short)0, STASH_B * 2048, 0x00020000), rsA = __builtin_amdgcn_make_buffer_rsrc((void*)stA, (short)0, STASH_A * 2048, 0x00020000);
#define DSA_SRS(I) ((I) < STASH_B ? rsB : rsA)
#define DSA_SOF(I) ((I) < nS ? ((I) < STASH_B ? (I) * 2048 : ((I) - STASH_B) * 2048) : -1)
    const __amdgpu_buffer_rsrc_t rsK = __builtin_amdgcn_make_buffer_rsrc((void*)KIb, (short)0, 8192 * 64 * 2, 0x00020000); const int voff = (n16 * 64 + 8 * g) * 2 + kh * (32 * 64 * 2);
    bf16x8 k0[2][2], k1[2][2], k2[2][2];
    const f32x4 zp4 = {0.f, 0.f, 0.f, 0.f}; Pend P{0u, 0u, 0u, 0u, 0, zp4, zp4};
#define DSA_LOADK(KF, IT) do { const int it_ = (IT) < nIt ? (IT) : nIt - 1; const int so_ = it_ * (64 * 64 * 2); \
        _Pragma("unroll") for (int t = 0; t < 2; ++t) _Pragma("unroll") for (int ks = 0; ks < 2; ++ks) KF[t][ks] = __builtin_bit_cast(bf16x8, __builtin_amdgcn_raw_buffer_load_b128(rsK, voff + (t * 16 * 64 + 32 * ks) * 2, so_, 0)); asm volatile("" ::: "memory"); } while (0)
    int it = 0;
    if (PASS2) {
        if (nS > 0) {
#define DSA_LDG(X, BASE) do { _Pragma("unroll") for (int t = 0; t < 4; ++t) { const int i_ = (BASE) + t < nS ? (BASE) + t : nS - 1; \
                if (i_ < STASH_B) { X[t][0] = __builtin_bit_cast(f32x4, __builtin_amdgcn_raw_buffer_load_b128(rsB, lane * 16, i_ * 2048, 16)); X[t][1] = __builtin_bit_cast(f32x4, __builtin_amdgcn_raw_buffer_load_b128(rsB, 1024 + lane * 16, i_ * 2048, 16)); } \
                else { X[t][0] = __builtin_bit_cast(f32x4, __builtin_amdgcn_raw_buffer_load_b128(rsA, lane * 16, (i_ - STASH_B) * 2048, 16)); X[t][1] = __builtin_bit_cast(f32x4, __builtin_amdgcn_raw_buffer_load_b128(rsA, 1024 + lane * 16, (i_ - STASH_B) * 2048, 16)); } } } while (0)
#define DSA_CSG(X, BASE) do { _Pragma("unroll") for (int t = 0; t < 4; ++t) if ((BASE) + t < nS) { pend_finish(L, pool, P, qloc, g); pend_issue(L, P, X[t][0], X[t][1], kh + 2 * ((BASE) + t), qloc, tauA, tauB); } } while (0)
            f32x4 ga[4][2], gb[4][2];
            DSA_LDG(ga, 0);
            for (int b8 = 0; b8 < nS; b8 += 8) {
                DSA_LDG(gb, b8 + 4); DSA_CSG(ga, b8);
                DSA_LDG(ga, b8 + 8); DSA_CSG(gb, b8 + 4);
            }
#undef DSA_LDG
#undef DSA_CSG
            it = nS;
        }
    }
    DSA_LOADK(k0, it); DSA_LOADK(k1, it + 1);
    for (; it + 3 <= nIt; it += 3) {
        DSA_LOADK(k2, it + 2); score_tile<PASS2>(L, pool, k0, kh + 2 * it, qloc, g, qf, ql, w, e0, tauA, tauB, DSA_SRS(it), PASS2 ? -1 : DSA_SOF(it), lane, P);
        DSA_LOADK(k0, it + 3); score_tile<PASS2>(L, pool, k1, kh + 2 * it + 2, qloc, g, qf, ql, w, e0, tauA, tauB, DSA_SRS(it + 1), PASS2 ? -1 : DSA_SOF(it + 1), lane, P);
        DSA_LOADK(k1, it + 4); score_tile<PASS2>(L, pool, k2, kh + 2 * it + 4, qloc, g, qf, ql, w, e0, tauA, tauB, DSA_SRS(it + 2), PASS2 ? -1 : DSA_SOF(it + 2), lane, P);
    }
    if (it < nIt) {
        score_tile<PASS2>(L, pool, k0, kh + 2 * it, qloc, g, qf, ql, w, e0, tauA, tauB, DSA_SRS(it), PASS2 ? -1 : DSA_SOF(it), lane, P);
        if (it + 1 < nIt) score_tile<PASS2>(L, pool, k1, kh + 2 * it + 2, qloc, g, qf, ql, w, e0, tauA, tauB, DSA_SRS(it + 1), PASS2 ? -1 : DSA_SOF(it + 1), lane, P);
    }
    if (PASS2) pend_finish(L, pool, P, qloc, g);
#undef DSA_LOADK
#undef DSA_SRS
#undef DSA_SOF
}

struct Tensors { const DGAS bf16* QI; const DGAS bf16* KI; const DGAS float* WI; const DGAS bf16* QA; const DGAS bf16* KA; const DGAS bf16* VA; DGAS bf16* OA; const DGAS float* KMAX; };

__device__ __forceinline__ void unit(ldsp L, unsigned char* wsb, unsigned char* ob, int b, int c, int wave_in) {
    asm volatile("" : "+s"(wsb), "+s"(ob));
    const Tensors T{(const DGAS bf16*)(wsb + WS_QI), (const DGAS bf16*)(wsb + WS_KI), (const DGAS float*)(wsb + WS_WI), (const DGAS bf16*)(wsb + WS_QA), (const DGAS bf16*)(wsb + WS_KA), (const DGAS bf16*)(wsb + WS_VA), (DGAS bf16*)ob, (const DGAS float*)(wsb + WS_CUM + MiB)};
    int tid_; { int ln_; asm volatile("v_mbcnt_lo_u32_b32 %0, -1, 0\n\tv_mbcnt_hi_u32_b32 %0, -1, %0" : "=v"(ln_)); tid_ = wave_in * 64 + ln_; }
    const int tid = tid_, lane = tid & 63, wave = __builtin_amdgcn_readfirstlane(tid >> 6);
    const int N = 64 * (c + 1), t0 = 64 * c;
    DGAS u32x2* const pool = (DGAS u32x2*)(wsb + WS_H) + (size_t)blockIdx.x * POOLCAP;
    const bool stash_ok = gridDim.x <= 256;
    DGAS f32x4* const stB = stash_ok ? (DGAS f32x4*)(ob + 64 * MiB + ((size_t)blockIdx.x * 8 + wave) * (STASH_B * 2048)) : (DGAS f32x4*)nullptr;
    DGAS f32x4* const stA = (DGAS f32x4*)(wsb + WS_H + 16 * MiB + ((size_t)blockIdx.x * 8 + wave) * (STASH_A * 2048));
    const size_t rowb = (size_t)b * 8192;
#ifndef REP_DSA_IDX
#define REP_DSA_IDX 1
#endif
#ifndef REP_DSA_ATT
#define REP_DSA_ATT 1
#endif
    for (int rep_i = 0; rep_i < REP_DSA_IDX; ++rep_i) {
    for (int i = tid; i < 64 * 6; i += 512) ((DLAS unsigned*)(L + L_CNTA))[i] = 0u;
    if (tid == 0) *(DLAS unsigned*)(L + L_POOLC) = 0u;
    if (tid < 64) ((DLAS unsigned*)(L + L_CNTA1))[tid] = 0u;
    if (N > TOPK) { u32x4 z4u = {0u, 0u, 0u, 0u}; asm volatile("" : "+v"(z4u)); for (int i = tid; i < 64 * NBIN / 2 / 4; i += 512) ((DLAS u32x4*)(L + L_HIST))[i] = z4u; }
    __syncthreads();
    if (N > TOPK) {
        const int n16 = lane & 15, g = lane >> 4, qsub = wave & 3, kh = wave >> 2, qloc = 16 * qsub + n16;
        const size_t rowq = rowb + t0 + qloc;
        bf16x8 qf[8][2]; float w[8];
#pragma unroll
        for (int h = 0; h < 8; ++h)
#pragma unroll
            for (int ks = 0; ks < 2; ++ks) qf[h][ks] = *(const DGAS bf16x8*)(T.QI + rowq * 512 + h * 64 + 32 * ks + 8 * g);
        { const f32x4 w0 = *(const DGAS f32x4*)(T.WI + rowq * 8), w1 = *(const DGAS f32x4*)(T.WI + rowq * 8 + 4);
          w[0] = w0[0]; w[1] = w0[1]; w[2] = w0[2]; w[3] = w0[3]; w[4] = w1[0]; w[5] = w1[1]; w[6] = w1[2]; w[7] = w1[3]; }
        float U = 0.f;
#pragma unroll
        for (int h = 0; h < 8; ++h) { float n2 = 0.f;
#pragma unroll
            for (int ks = 0; ks < 2; ++ks)
#pragma unroll
                for (int e = 0; e < 8; ++e) { const float x = __uint_as_float(((unsigned)(unsigned short)qf[h][ks][e]) << 16); n2 = fmaf(x, x, n2); }
            n2 += lane_read(n2, lane ^ 16); n2 += lane_read(n2, lane ^ 32);
            U += fabsf(w[h]) * sqrtf(n2); }
        U *= sqrtf(T.KMAX[b]) * 1.01f;
        bf16x8 ql[2];
#pragma unroll
        for (int h = 0; h < 8; ++h) w[h] *= 0.5f;
#pragma unroll
        for (int ks = 0; ks < 2; ++ks) { float acc8[8];
#pragma unroll
            for (int e = 0; e < 8; ++e) { float a = 0.f;
#pragma unroll
                for (int h = 0; h < 8; ++h) a = fmaf(w[h], __uint_as_float(((unsigned)(unsigned short)qf[h][ks][e]) << 16), a);
                acc8[e] = a; }
            u32x4 pk; pk.x = attn_body::cvtpk_s(acc8[0], acc8[1]); pk.y = attn_body::cvtpk_s(acc8[2], acc8[3]); pk.z = attn_body::cvtpk_s(acc8[4], acc8[5]); pk.w = attn_body::cvtpk_s(acc8[6], acc8[7]);
            ql[ks] = __builtin_bit_cast(bf16x8, pk); }
        const int e0 = (int)((__float_as_uint(U) >> 19) & 0xFFFu) + 1 - 255;
        const int NT = N / 32;
        score_pass<false>(L, pool, T.KI + rowb * 64, NT, kh, qloc, n16, g, qf, ql, w, e0, 0.f, 0.f, stB, stA, lane);
        __syncthreads();
        { int lane_t = lane; asm volatile("" : "+v"(lane_t)); const int lane = lane_t;
        for (int qq = 0; qq < 8; ++qq) {
            const int q = 8 * wave + qq;
            const u32x4 hw = *((DLAS u32x4*)(L + L_HIST + q * (NBIN * 2)) + lane);
            const unsigned pc[4] = {hw.x & 0xffffu, hw.y & 0xffffu, hw.z & 0xffffu, hw.w & 0xffffu}, nc[4] = {hw.x >> 16, hw.y >> 16, hw.z >> 16, hw.w >> 16};
            const unsigned totP = (pc[0] + pc[1]) + (pc[2] + pc[3]), totN = (nc[0] + nc[1]) + (nc[2] + nc[3]);
            const unsigned preP = wave_incl_prefix(totP);
            const unsigned TP = (unsigned)__builtin_amdgcn_readlane((int)preP, 63);
            const unsigned sufP = TP - preP + totP;
            if (TP >= (unsigned)TOPK) {
                const unsigned above = sufP - totP;
                if (above < (unsigned)TOPK && sufP >= (unsigned)TOPK) {
                    unsigned run = above; int bsel = 256 + 4 * lane, found = 0;
#pragma unroll
                    for (int k = 3; k >= 0; --k) { if (!found) { if (run + pc[k] >= (unsigned)TOPK) { bsel = 256 + 4 * lane + k; found = 1; } else run += pc[k]; } }
                    ((DLAS int*)(L + L_THR))[q] = bsel; ((DLAS int*)(L + L_R))[q] = TOPK - (int)run;
                }
            } else {
                const unsigned need = (unsigned)TOPK - TP;
                const unsigned preN = wave_incl_prefix(totN);
                const unsigned below = preN - totN;
                if (below < need && preN >= need) {
                    unsigned run = below; int bsel = 255 - 4 * lane, found = 0;
#pragma unroll
                    for (int k = 0; k < 4; ++k) { if (!found) { if (run + nc[k] >= need) { bsel = 255 - (4 * lane + k); found = 1; } else run += nc[k]; } }
                    ((DLAS int*)(L + L_THR))[q] = bsel; ((DLAS int*)(L + L_R))[q] = (int)(need - run);
                }
            }
        }
        }
        __syncthreads();
        const int thr = ((DLAS int*)(L + L_THR))[qloc];
        __syncthreads();
        score_pass<true>(L, pool, T.KI + rowb * 64, NT, kh, qloc, n16, g, qf, ql, w, e0, bin_edge(thr + 1, e0), bin_edge(thr, e0), stB, stA, lane);
        __syncthreads();
        for (int qq = 0; qq < 8; ++qq) {
            const int q = 8 * wave + qq;
            const unsigned nBraw = ((DLAS unsigned*)(L + L_CNTB))[q]; const int nB = nBraw < (unsigned)CAP2 ? (int)nBraw : CAP2;
            const int R = ((DLAS int*)(L + L_R))[q]; const int nA0 = (int)((DLAS unsigned*)(L + L_CNTA))[q]; const int base = nA0 < TOPK - R ? nA0 : TOPK - R;
            const DLAS float* lbs = (const DLAS float*)(L + L_HIST) + q * CAP2; const DLAS unsigned short* lbk = (const DLAS unsigned short*)(L + L_LBK) + q * CAP2;
            DLAS unsigned short* la = (DLAS unsigned short*)(L + L_LISTA) + q * TOPK;
            const int thrq = ((DLAS int*)(L + L_THR))[q];
            if (nBraw <= (unsigned)CAP2 && thrq != 0 && thrq != 255 && thrq != 256 && thrq != 511) {
                const unsigned flip = thrq < 256 ? 0x7FFFFu : 0u;
                unsigned k0 = 0u, k1 = 0u, k2 = 0u, i0 = 0u, i1 = 0u, i2 = 0u;
                if (lane < nB) { i0 = lbk[lane]; k0 = (((__float_as_uint(lbs[lane]) ^ flip) & 0x7FFFFu) << 13) | (8191u - i0); }
                if (lane + 64 < nB) { i1 = lbk[lane + 64]; k1 = (((__float_as_uint(lbs[lane + 64]) ^ flip) & 0x7FFFFu) << 13) | (8191u - i1); }
                if (lane + 128 < nB) { i2 = lbk[lane + 128]; k2 = (((__float_as_uint(lbs[lane + 128]) ^ flip) & 0x7FFFFu) << 13) | (8191u - i2); }
                DLAS unsigned* kw = (DLAS unsigned*)(L + L_KW + wave * (CAP2 * 4));
                kw[lane] = k0; kw[lane + 64] = k1; kw[lane + 128] = k2;
                int rk0 = 0, rk1 = 0, rk2 = 0;
                const int n4 = (nB + 3) >> 2;
                if (nB <= 64) {
#pragma unroll 4
                    for (int j4 = 0; j4 < n4; ++j4) { const u32x4 kq = *((const DLAS u32x4*)kw + j4);
                        rk0 += (kq.x > k0 ? 1 : 0) + (kq.y > k0 ? 1 : 0) + (kq.z > k0 ? 1 : 0) + (kq.w > k0 ? 1 : 0); }
                } else {
#pragma unroll 2
                    for (int j4 = 0; j4 < n4; ++j4) { const u32x4 kq = *((const DLAS u32x4*)kw + j4);
                        rk0 += (kq.x > k0 ? 1 : 0) + (kq.y > k0 ? 1 : 0) + (kq.z > k0 ? 1 : 0) + (kq.w > k0 ? 1 : 0);
                        rk1 += (kq.x > k1 ? 1 : 0) + (kq.y > k1 ? 1 : 0) + (kq.z > k1 ? 1 : 0) + (kq.w > k1 ? 1 : 0);
                        rk2 += (kq.x > k2 ? 1 : 0) + (kq.y > k2 ? 1 : 0) + (kq.z > k2 ? 1 : 0) + (kq.w > k2 ? 1 : 0); }
                }
                if (lane < nB && rk0 < R) la[base + rk0] = (unsigned short)i0;
                if (lane + 64 < nB && rk1 < R) la[base + rk1] = (unsigned short)i1;
                if (lane + 128 < nB && rk2 < R) la[base + rk2] = (unsigned short)i2;
                if (lane == 0) ((DLAS int*)(L + L_NSEL))[q] = TOPK - R + (nB < R ? nB : R);
                if (nB < R) { const int nA1 = TOPK - R - base; for (int i = lane; i < nA1; i += 64) { const unsigned short kk = la[TOPK - nA1 + i]; la[base + nB + i] = kk; } }
            } else {
                float s0 = 0.f, s1 = 0.f, s2 = 0.f; unsigned i0 = 0u, i1 = 0u, i2 = 0u;
                if (lane < nB) { s0 = lbs[lane]; i0 = lbk[lane]; }
                if (lane + 64 < nB) { s1 = lbs[lane + 64]; i1 = lbk[lane + 64]; }
                if (lane + 128 < nB) { s2 = lbs[lane + 128]; i2 = lbk[lane + 128]; }
                int rk0 = 0, rk1 = 0, rk2 = 0;
                for (int j = 0; j < nB; ++j) { const float sj = lbs[j]; const unsigned ij = lbk[j];
                    rk0 += ahead(sj, ij, s0, i0) ? 1 : 0; rk1 += ahead(sj, ij, s1, i1) ? 1 : 0; rk2 += ahead(sj, ij, s2, i2) ? 1 : 0; }
                int ntot = nB;
                if (nBraw > (unsigned)CAP2) {
                    const unsigned pcr = *(const DLAS unsigned*)(L + L_POOLC); const int np = pcr < (unsigned)POOLCAP ? (int)pcr : POOLCAP;
                    for (int p = 0; p < np; ++p) { const unsigned long long e = __hip_atomic_load((DGAS unsigned long long*)(pool + p), __ATOMIC_RELAXED, __HIP_MEMORY_SCOPE_AGENT);
                        const unsigned tg = (unsigned)(e >> 32); if ((tg >> 16) != (unsigned)q) continue; const float sj = __uint_as_float((unsigned)e); const unsigned ij = tg & 0xffffu; ++ntot;
                        rk0 += ahead(sj, ij, s0, i0) ? 1 : 0; rk1 += ahead(sj, ij, s1, i1) ? 1 : 0; rk2 += ahead(sj, ij, s2, i2) ? 1 : 0; }
                    for (int p0 = 0; p0 < np; p0 += 64) {
                        const int p = p0 + lane; unsigned long long e = 0ull; if (p < np) e = __hip_atomic_load((DGAS unsigned long long*)(pool + p), __ATOMIC_RELAXED, __HIP_MEMORY_SCOPE_AGENT);
                        const unsigned tg = (unsigned)(e >> 32); const bool mine = (p < np) && ((tg >> 16) == (unsigned)q); const float si = __uint_as_float((unsigned)e); const unsigned ii = tg & 0xffffu;
                        int rk = 0;
                        for (int j = 0; j < nB; ++j) rk += ahead(lbs[j], lbk[j], si, ii) ? 1 : 0;
                        for (int j = 0; j < np; ++j) { const unsigned long long f = __hip_atomic_load((DGAS unsigned long long*)(pool + j), __ATOMIC_RELAXED, __HIP_MEMORY_SCOPE_AGENT);
                            const unsigned tf = (unsigned)(f >> 32); if ((tf >> 16) == (unsigned)q) rk += ahead(__uint_as_float((unsigned)f), tf & 0xffffu, si, ii) ? 1 : 0; }
                        if (mine && rk < R) la[base + rk] = (unsigned short)ii;
                    }
                }
                if (lane < nB && rk0 < R) la[base + rk0] = (unsigned short)i0;
                if (lane + 64 < nB && rk1 < R) la[base + rk1] = (unsigned short)i1;
                if (lane + 128 < nB && rk2 < R) la[base + rk2] = (unsigned short)i2;
                if (lane == 0) ((DLAS int*)(L + L_NSEL))[q] = TOPK - R + (ntot < R ? ntot : R);
                if (ntot < R) { const int nA1 = TOPK - R - base; for (int i = lane; i < nA1; i += 64) { const unsigned short kk = la[TOPK - nA1 + i]; la[base + ntot + i] = kk; } }
            }
        }
    } else {
        for (int i = tid; i < 64 * TOPK; i += 512) ((DLAS unsigned short*)(L + L_LISTA))[i] = (unsigned short)(i & (TOPK - 1));
        if (tid < 64) ((DLAS int*)(L + L_NSEL))[tid] = N;
    }
    __syncthreads();
    }
    {
        int lane_a = lane; asm volatile("" : "+v"(lane_a));
        const int lane = lane_a, n16 = lane & 15, g = lane >> 4, q4 = n16 >> 2, p4 = lane & 3;
        ldsp vst = L + L_HIST + wave * (64 * VST);
        const attn_body::lds_cptr vrd = (attn_body::lds_cptr)(vst + (4 * g + q4) * VST + 4 * p4 * 2);
        const DGAS bf16* KAb = T.KA + rowb * 64; const DGAS bf16* VAb = T.VA + rowb * 64;
        const int vsl = lane >> 3, vch = lane & 7;
#define DSA_REQ(R, LA, NSEL, J) do { const __amdgpu_buffer_rsrc_t rs_ = ((J) < 4) ? rsKA : rsVA; \
            const u32x4 ix_ = *(const DLAS u32x4*)((LA) + 64 * ((J) & 3) + 8 * vsl);        \
            const unsigned iw_[4] = {ix_.x, ix_.y, ix_.z, ix_.w}; \
            _Pragma("unroll") for (int i = 0; i < 8; ++i) { const unsigned key = ((i & 1) ? (iw_[i >> 1] >> 16) : iw_[i >> 1]) & 8191u; \
                R[i] = __builtin_amdgcn_raw_buffer_load_b128(rs_, (int)(key * 128u + (unsigned)vch * 16u), 0, 0); } } while (0)
#define DSA_PUT(R) do { _Pragma("unroll") for (int i = 0; i < 8; ++i) *(DLAS u32x4*)(vst + (8 * vsl + i) * VST + vch * 16) = R[i]; } while (0)
        const __amdgpu_buffer_rsrc_t rsKA = __builtin_amdgcn_make_buffer_rsrc((void*)KAb, (short)0, 8192 * 128, 0x00020000), rsVA = __builtin_amdgcn_make_buffer_rsrc((void*)VAb, (short)0, 8192 * 128, 0x00020000);
        const bf16x8 zf = {0, 0, 0, 0, 0, 0, 0, 0};
        u32x4 vr[2][8]; bf16x8 qn0 = zf, qn1 = zf;
        { const int q = 8 * wave; const int nsel = ((DLAS int*)(L + L_NSEL))[q]; const DLAS unsigned short* la = (const DLAS unsigned short*)(L + L_LISTA) + q * TOPK; const size_t row = rowb + t0 + q;
          DSA_REQ(vr[0], la, nsel, 0); DSA_REQ(vr[1], la, nsel, 1);
          if (n16 < 8) { qn0 = *(const DGAS bf16x8*)(T.QA + row * 512 + n16 * 64 + 8 * g); qn1 = *(const DGAS bf16x8*)(T.QA + row * 512 + n16 * 64 + 32 + 8 * g); } }
        for (int qq = 0; qq < 8 * REP_DSA_ATT; ++qq) {
            const int q = 8 * wave + (qq & 7); const size_t row = rowb + t0 + q;
            const int nsel = ((DLAS int*)(L + L_NSEL))[q];
            const DLAS unsigned short* la = (const DLAS unsigned short*)(L + L_LISTA) + q * TOPK;
            const int qx = 8 * wave + ((qq + 1 < 8 * REP_DSA_ATT) ? ((qq + 1) & 7) : (qq & 7));
            const int nseln = ((DLAS int*)(L + L_NSEL))[qx]; const DLAS unsigned short* lan = (const DLAS unsigned short*)(L + L_LISTA) + qx * TOPK; const size_t rown = rowb + t0 + qx;
            const bf16x8 qb0 = qn0, qb1 = qn1;
            f32x4 sa[16];
#pragma unroll
            for (int cst = 0; cst < 4; ++cst) {
                DSA_PUT(vr[cst & 1]);
                DSA_REQ(vr[cst & 1], la, nsel, cst + 2);
#pragma unroll
                for (int t4 = 0; t4 < 4; ++t4) {
                    const bf16x8 a0 = *(const DLAS bf16x8*)(vst + (16 * t4 + n16) * VST + 16 * g), a1 = *(const DLAS bf16x8*)(vst + (16 * t4 + n16) * VST + 64 + 16 * g);
                    f32x4 s = {0.f, 0.f, 0.f, 0.f};
                    s = __builtin_amdgcn_mfma_f32_16x16x32_bf16(a0, qb0, s, 0, 0, 0);
                    s = __builtin_amdgcn_mfma_f32_16x16x32_bf16(a1, qb1, s, 0, 0, 0);
                    sa[4 * cst + t4] = s;
                }
            }
            float m = -INFINITY;
#pragma unroll
            for (int tt = 0; tt < 16; ++tt)
#pragma unroll
                for (int i = 0; i < 4; ++i) { if (16 * tt + 4 * g + i >= nsel) sa[tt][i] = -INFINITY; m = fmaxf(m, sa[tt][i]); }
            m = fmaxf(m, lane_read(m, lane ^ 16)); m = fmaxf(m, lane_read(m, lane ^ 32));
            float ls = 0.f;
#pragma unroll
            for (int tt = 0; tt < 16; ++tt)
#pragma unroll
                for (int i = 0; i < 4; ++i) { const float p = __builtin_amdgcn_exp2f(sa[tt][i] - m); sa[tt][i] = p; ls += p; }
            ls += lane_read(ls, lane ^ 16); ls += lane_read(ls, lane ^ 32);
            if (g == 0) ((DLAS float*)(L + L_LSUM))[wave * 16 + n16] = ls;
            f32x4 o[4];
#pragma unroll
            for (int nb = 0; nb < 4; ++nb) o[nb] = (f32x4){0.f, 0.f, 0.f, 0.f};
#pragma unroll
            for (int cst = 0; cst < 4; ++cst) {
                DSA_PUT(vr[cst & 1]);
                if (cst < 2) DSA_REQ(vr[cst & 1], la, nsel, cst + 6);
                else { DSA_REQ(vr[cst & 1], lan, nseln, cst - 2);
                       if (cst == 2 && n16 < 8) { qn0 = *(const DGAS bf16x8*)(T.QA + rown * 512 + n16 * 64 + 8 * g); qn1 = *(const DGAS bf16x8*)(T.QA + rown * 512 + n16 * 64 + 32 + 8 * g); } }
#pragma unroll
                for (int s2 = 0; s2 < 2; ++s2) {
                    const int s = 2 * cst + s2;
                    u32x4 pw; pw.x = attn_body::cvtpk_s(sa[2 * s][0], sa[2 * s][1]); pw.y = attn_body::cvtpk_s(sa[2 * s][2], sa[2 * s][3]);
                    pw.z = attn_body::cvtpk_s(sa[2 * s + 1][0], sa[2 * s + 1][1]); pw.w = attn_body::cvtpk_s(sa[2 * s + 1][2], sa[2 * s + 1][3]);
                    const bf16x8 pa = __builtin_bit_cast(bf16x8, pw);
#pragma unroll
                    for (int nb = 0; nb < 4; ++nb) {
                        const s16x4 t1 = attn_body::vtr(vrd + (32 * s2) * VST + 32 * nb), t2 = attn_body::vtr(vrd + (32 * s2 + 16) * VST + 32 * nb);
                        const bf16x8 vb = {t1[0], t1[1], t1[2], t1[3], t2[0], t2[1], t2[2], t2[3]};
                        o[nb] = __builtin_amdgcn_mfma_f32_16x16x32_bf16(pa, vb, o[nb], 0, 0, 0);
                    }
                }
            }
            if (g < 2) {
                const f32x4 lv = *(const DLAS f32x4*)(L + L_LSUM + (wave * 16 + 4 * g) * 4);
#pragma unroll
                for (int i = 0; i < 4; ++i) { const float li = __builtin_amdgcn_rcpf(lv[i]);
#pragma unroll
                    for (int nb = 0; nb < 4; ++nb) T.OA[row * 1024 + (4 * g + i) * 64 + 16 * nb + n16] = (bf16)(attn_body::cvtpk_s(o[nb][i] * li, 0.f) & 0xffffu); }
            }
        }
    }
    __syncthreads();
}
#undef DSA_REQ
#undef DSA_PUT
#undef DLAS
#undef DGAS
}

constexpr int NWAVES = 8, NTHR = NWAVES * 64;
#define GAS __attribute__((address_space(1)))
#define LAS __attribute__((address_space(3)))
typedef unsigned short bf16;
typedef unsigned v4u __attribute__((ext_vector_type(4)));
typedef float f32x4 __attribute__((ext_vector_type(4)));
typedef short bf16x8 __attribute__((ext_vector_type(8)));
typedef GAS unsigned gu32;
#define RLX_AGENT __ATOMIC_RELAXED, __HIP_MEMORY_SCOPE_AGENT
#define LDS_WAIT() asm volatile("s_waitcnt lgkmcnt(0)" ::: "memory")
#define VM_WAIT() asm volatile("s_waitcnt vmcnt(0)" ::: "memory")
__device__ __forceinline__ unsigned f2bf(float f) { unsigned u = __builtin_bit_cast(unsigned, f); return (u + 0x7fffu + ((u >> 16) & 1u)) >> 16; }
__device__ __forceinline__ unsigned pk2(float lo, float hi) { return f2bf(lo) | (f2bf(hi) << 16); }

constexpr int RING_BYTES = 131072;
constexpr int LDSCTL_OFF = RING_BYTES, MISC_OFF = LDSCTL_OFF + 320;
constexpr int LDS_BYTES = 147456;
#define XB_TMO      128
#define XB_XCNT(j)  (256  + 64 * (j))
#define XB_XSUB(j)  (1280 + 64 * (j))
#define XB_XGEN(j)  (2304 + 64 * (j))
#define XB_TOP      3328
#define XB_TOPGEN   3392
#define XCD_BAR_WORDS 3456
#define XB_SPIN_CAP (1u << 18)

__device__ __forceinline__ unsigned xb_ld(unsigned* p)              { return __hip_atomic_load(p, __ATOMIC_RELAXED, __HIP_MEMORY_SCOPE_AGENT); }
__device__ __forceinline__ unsigned xb_add(unsigned* p, unsigned v) { return __hip_atomic_fetch_add(p, v, __ATOMIC_RELAXED, __HIP_MEMORY_SCOPE_AGENT); }
__device__ __forceinline__ unsigned xb_xcc_id() { return (unsigned)__builtin_amdgcn_s_getreg((3 << 11) | 20) & 0xFu; }
#define XB_SPIN(cond, bar) do { unsigned _sp = 0; while (cond) { __builtin_amdgcn_s_sleep(1); \
    if ((++_sp & 255u) == 0u) { if (xb_ld(&(bar)[XB_TMO])) break; if (_sp > XB_SPIN_CAP) { atomicAdd(&(bar)[XB_TMO], 1u); break; } } } } while (0)

struct XcdBarrier {
    unsigned* bar; unsigned x;
    volatile LAS unsigned* st;
};

__device__ __forceinline__ XcdBarrier xcd_barrier_post(unsigned* bar, volatile LAS unsigned* st, bool tid0) {
    XcdBarrier b; b.bar = bar; b.x = xb_xcc_id(); b.st = st;
    if (tid0) (void)xb_add(&bar[XB_XCNT(b.x)], 1u);
    return b;
}
__device__ __forceinline__ void xcd_barrier_complete(unsigned* bar, unsigned x, unsigned& nloc, unsigned& nx) {
    const unsigned G = gridDim.x * gridDim.y * gridDim.z;
    unsigned sum, cnt, mine, sp = 0u;
    for (;;) {
        sum = 0u; cnt = 0u; mine = 0u;
#pragma unroll
        for (unsigned j = 0; j < 16; ++j) { const unsigned c = xb_ld(&bar[XB_XCNT(j)]); sum += c; cnt += (c > 0u) ? 1u : 0u; mine = (j == x) ? c : mine; }
        if (sum == G) break;
        __builtin_amdgcn_s_sleep(1);
        if ((++sp & 255u) == 0u) { if (xb_ld(&bar[XB_TMO])) break; if (sp > XB_SPIN_CAP) { atomicAdd(&bar[XB_TMO], 1u); break; } }
    }
    nloc = mine > 0u ? mine : 1u; nx = cnt > 0u ? cnt : 1u;
}

__device__ __forceinline__ void xcd_barrier(const XcdBarrier& b, bool tid0) {
    asm volatile("s_waitcnt vmcnt(0)" ::: "memory");
    __syncthreads();
    if (tid0) {
        unsigned* bar = b.bar;
        __builtin_amdgcn_s_waitcnt(0);
        unsigned nloc = b.st[0], nx = b.st[1];
        if (nloc == 0u) { xcd_barrier_complete(bar, b.x, nloc, nx); b.st[0] = nloc; b.st[1] = nx; }
        const unsigned old = xb_add(&bar[XB_XSUB(b.x)], 1u);
        const unsigned gen = old / nloc;
        if (old + 1u == (gen + 1u) * nloc) {
            __builtin_amdgcn_fence(__ATOMIC_RELEASE, "agent");
            asm volatile("s_waitcnt vmcnt(0)" ::: "memory");
            const unsigned og = xb_add(&bar[XB_TOP], 1u);
            const unsigned tg = og / nx;
            if (og + 1u == (tg + 1u) * nx) xb_add(&bar[XB_TOPGEN], 1u);
            else XB_SPIN(xb_ld(&bar[XB_TOPGEN]) == tg, bar);
            __builtin_amdgcn_fence(__ATOMIC_ACQUIRE, "agent");
            xb_add(&bar[XB_XGEN(b.x)], 1u);
            asm volatile("s_waitcnt vmcnt(0)" ::: "memory");
        } else {
            XB_SPIN(xb_ld(&bar[XB_XGEN(b.x)]) == gen, bar);
            __builtin_amdgcn_fence(__ATOMIC_ACQUIRE, "agent");
            asm volatile("s_waitcnt vmcnt(0)" ::: "memory");
        }
    }
    __syncthreads();
}

__device__ __forceinline__ float wave_sum(float v, int lane) {
#pragma unroll
    for (int o = 1; o < 64; o <<= 1) v += lane_read(v, lane ^ o);
    return v;
}
__device__ __forceinline__ int ropeperm(int j) { return j < 4 ? j : j < 8 ? j + 4 : j < 12 ? j - 4 : j; }
template <int MAP> __device__ __forceinline__ int src_col(int n) {
    if (MAP == 0) return n;
    if (MAP == 2) { const int pn = n >> 8, w = n & 255; return w < 128 ? 128 * pn + w : DFF + 128 * pn + (w - 128); }
    const int t = n >> 8, w = n & 255;
    if (t < 2) return (n & ~63) + ropeperm(n & 63);
    if (t == 2) { if (w < 64) return 512 + ropeperm(w); if (w < 128) return 576 + (w - 64); if (w < 192) return 1152 + ropeperm(w - 128);
                  const int s = w - 192; return s < 8 ? 1216 + s : s < 16 ? 2760 + (s - 8) : -1; }
    if (t < 5) { const int hc = n - 768; return 640 + (hc & ~63) + ropeperm(hc & 63); }
    if (t < 7) return 1224 + (n - 1280);
    if (t < 9) return 1736 + (n - 1792);
    if (t < 11) return 2248 + (n - 2304);
    return 2768 + (n - 2816);
}
template <int MAP> __device__ __forceinline__ void transpose_item(const float* W, int K, int Nsrc, int Ndst, bf16* WT, LAS float* scr, int item, int lane, int ldk = 0, int kofs = 0) {
    if (ldk == 0) ldk = K;
    const int nblk = Ndst / 32, kb = item / nblk, nb = item % nblk, k0 = 64 * kb, n0 = 32 * nb;
    const int sc = src_col<MAP>(n0 + (lane & 31));
    float tv[32];
#pragma unroll
    for (int i = 0; i < 32; ++i) { const int kk = 2 * i + (lane >> 5); tv[i] = sc >= 0 ? ((const GAS float*)W)[(size_t)(k0 + kk) * Nsrc + sc] : 0.f; }
#pragma unroll
    for (int i = 0; i < 32; ++i) { const int kk = 2 * i + (lane >> 5); scr[kk * 33 + (lane & 31)] = tv[i]; }
    LDS_WAIT(); asm volatile("" ::: "memory");
    const int c = lane & 7;
#pragma unroll
    for (int j = 0; j < 4; ++j) { const int n = (lane >> 3) + 8 * j; const LAS float* s = scr + (8 * c) * 33 + n;
        v4u o; o.x = pk2(s[0 * 33], s[1 * 33]); o.y = pk2(s[2 * 33], s[3 * 33]); o.z = pk2(s[4 * 33], s[5 * 33]); o.w = pk2(s[6 * 33], s[7 * 33]);
        *(GAS v4u*)(WT + (size_t)(n0 + n) * ldk + kofs + k0 + 8 * c) = o; }
    LDS_WAIT(); asm volatile("" ::: "memory");
}
__device__ __forceinline__ void cos_sin_acc(float angf, float& co, float& si) {
    const double a = (double)angf, k = rint(a * 0.63661977236758134308), r = fma(-k, 6.123233995736766e-17, fma(-k, 1.5707963267948966, a)), r2 = r * r;
    double s = -1.0 / 39916800.0; s = fma(s, r2, 1.0 / 362880.0); s = fma(s, r2, -1.0 / 5040.0); s = fma(s, r2, 1.0 / 120.0); s = fma(s, r2, -1.0 / 6.0); s = fma(s * r2, r, r);
    double c = 1.0 / 479001600.0; c = fma(c, r2, -1.0 / 3628800.0); c = fma(c, r2, 1.0 / 40320.0); c = fma(c, r2, -1.0 / 720.0); c = fma(c, r2, 1.0 / 24.0); c = fma(c, r2, -0.5); c = fma(c, r2, 1.0);
    const int q = (int)((long long)k & 3);
    const double cc = (q == 0) ? c : (q == 1) ? -s : (q == 2) ? -c : s, ss = (q == 0) ? s : (q == 1) ? c : (q == 2) ? -s : -c;
    co = (float)cc; si = (float)ss;
}
__device__ __forceinline__ void load_vec16(const float* p, int lane, f32x4 (&v)[4]) {
#pragma unroll
    for (int j = 0; j < 4; ++j) v[j] = *((const GAS f32x4*)p + lane + 64 * j);
}
__device__ __forceinline__ void load_vec16b(const float* p, int lane, f32x4 (&v)[4]) {
#pragma unroll
    for (int j = 0; j < 2; ++j) { v[2 * j] = *(const GAS f32x4*)(p + 512 * j + 8 * lane); v[2 * j + 1] = *(const GAS f32x4*)(p + 512 * j + 8 * lane + 4); }
}
__device__ __forceinline__ void load_row16b(const bf16* row, int lane, f32x4 (&v)[4]) {
#pragma unroll
    for (int j = 0; j < 2; ++j) { const v4u w = *(const GAS v4u*)(row + 512 * j + 8 * lane);
        v[2 * j] = (f32x4){__uint_as_float(w.x << 16), __uint_as_float(w.x & 0xffff0000u), __uint_as_float(w.y << 16), __uint_as_float(w.y & 0xffff0000u)};
        v[2 * j + 1] = (f32x4){__uint_as_float(w.z << 16), __uint_as_float(w.z & 0xffff0000u), __uint_as_float(w.w << 16), __uint_as_float(w.w & 0xffff0000u)}; }
}
__device__ __forceinline__ void store_row16b(bf16* row, int lane, const f32x4 (&y)[4]) {
#pragma unroll
    for (int j = 0; j < 2; ++j) { v4u o; o.x = pk2(y[2 * j].x, y[2 * j].y); o.y = pk2(y[2 * j].z, y[2 * j].w); o.z = pk2(y[2 * j + 1].x, y[2 * j + 1].y); o.w = pk2(y[2 * j + 1].z, y[2 * j + 1].w);
        *(GAS v4u*)(row + 512 * j + 8 * lane) = o; }
}

#ifndef MK_ONE_LAUNCH
#define MK_ONE_LAUNCH 1
#endif
#ifndef REP_FOX
#define REP_FOX 1
#endif
#ifndef REP_DSA
#define REP_DSA 1
#endif
#ifndef REP_INPROJ
#define REP_INPROJ 1
#endif
#ifndef REP_P0
#define REP_P0 1
#endif
#ifndef REP_UP
#define REP_UP 1
#endif
#ifndef MK_STEP
#define MK_STEP 3
#endif
constexpr int NPL = 10, PH_FINAL = 1 + DEPTH * NPL, N_PHASES = PH_FINAL + 1;
struct Args { const float* in[17]; float* out; unsigned char* ws; int ph_lo, ph_hi, use_bar, pad; };
__global__ void __launch_bounds__(NTHR, 2) mk_fwd(Args args) {
    extern __shared__ __attribute__((aligned(16))) unsigned char lds[];
    LAS unsigned char* const L = (LAS unsigned char*)lds;
    volatile LAS unsigned* const MISC = (volatile LAS unsigned*)(L + MISC_OFF); (void)MISC;
#define PHASE_IDS() int tid; { int ws_ = wave_s, ln_; asm volatile("v_mbcnt_lo_u32_b32 %0, -1, 0\n\tv_mbcnt_hi_u32_b32 %0, -1, %0" : "=v"(ln_)); asm volatile("" : "+s"(ws_)); tid = ws_ * 64 + ln_; } int bx = blockIdx.x; asm volatile("" : "+s"(bx)); int G = (int)gridDim.x; asm volatile("" : "+s"(G)); \
    unsigned char* ws_l = args.ws; asm volatile("" : "+s"(ws_l)); unsigned char* const ws = ws_l; float* outp_l = args.out; asm volatile("" : "+s"(outp_l)); float* const outp = outp_l; \
    float* const MOD = (float*)(ws + WS_MOD); float* const CS = (float*)(ws + WS_CS); bf16* const H = (bf16*)(ws + WS_H); bf16* const XB = (bf16*)(ws + WS_XB); \
    const int lane = tid & 63, wave = __builtin_amdgcn_readfirstlane(tid >> 6), vcu = (G % 8 == 0) ? (bx % 8) * (G / 8) + bx / 8 : bx, gw = vcu * NWAVES + wave, NGW = G * NWAVES; \
    (void)lane; (void)wave; (void)vcu; (void)gw; (void)NGW; (void)MOD; (void)CS; (void)H; (void)XB; (void)outp
    const int wave_s = __builtin_amdgcn_readfirstlane((int)threadIdx.x >> 6);
    for (int u = wave_s * 64 + (int)__builtin_amdgcn_mbcnt_hi(~0u, __builtin_amdgcn_mbcnt_lo(~0u, 0u)); u < (LDS_BYTES - LDSCTL_OFF) / 4; u += NTHR) ((LAS unsigned*)(L + LDSCTL_OFF))[u] = 0u;
    __syncthreads();
#if MK_ONE_LAUNCH
    (void)xcd_barrier_post((unsigned*)((gu32*)(args.ws + WS_CTL) + CW_BAR), MISC + 8, wave_s == 0 && __builtin_amdgcn_mbcnt_hi(~0u, __builtin_amdgcn_mbcnt_lo(~0u, 0u)) == 0);
#define IN(k) true
#define GRID_BAR() do { unsigned char* wb_ = args.ws; asm volatile("" : "+s"(wb_)); XcdBarrier bar_; bar_.bar = (unsigned*)((gu32*)(wb_ + WS_CTL) + CW_BAR); bar_.x = xb_xcc_id(); bar_.st = (volatile LAS unsigned*)(L + MISC_OFF) + 8; int ln0_; asm volatile("v_mbcnt_lo_u32_b32 %0, -1, 0\n\tv_mbcnt_hi_u32_b32 %0, -1, %0" : "=v"(ln0_)); xcd_barrier(bar_, wave_s == 0 && ln0_ == 0); } while (0)
#else
    const int lo = args.ph_lo, hi = args.ph_hi;
#define IN(k) (lo <= (k) && (k) < hi)
#define GRID_BAR() do { } while (0)
#endif

#define KA_PTR() ({ const char __attribute__((address_space(4)))* kp_ = (const char __attribute__((address_space(4)))*)__builtin_amdgcn_kernarg_segment_ptr(); asm volatile("" : "+s"(kp_)); kp_; })
#define KIN(kp, k) (*(const float* const __attribute__((address_space(4)))*)((kp) + 8 * (k)))

    if (IN(0)) {
        const int l = 0; PHASE_IDS(); const float* const modl = MOD + (size_t)l * NB * 6144; (void)modl;
        for (int rep0 = 0; rep0 < REP_P0; ++rep0) {
        {
            LAS float* cl = (LAS float*)L;
            LAS float* red = (LAS float*)(L + 16384);
            const char __attribute__((address_space(4)))* kp = KA_PTR(); const float* cin = KIN(kp, 1); const float* modw = KIN(kp, 3); const float* modb = KIN(kp, 4);
            bool loaded = false;
            for (int un = bx; un < DEPTH * 96; un += G) {
                if (!loaded) { for (int i = tid; i < NB * DM; i += NTHR) cl[i] = ((const GAS float*)cin)[i]; loaded = true; }
                __syncthreads();
                const int l = un / 96, col = (un % 96) * 64 + (tid & 63), kg = tid >> 6;
                const float* W = modw + (size_t)l * DM * 6144 + col;
                float a0 = 0.f, a1 = 0.f, a2 = 0.f, a3 = 0.f;
                for (int k0 = kg * 128; k0 < kg * 128 + 128; k0 += 32) {
                    float wv[32];
#pragma unroll
                    for (int i = 0; i < 32; ++i) wv[i] = ((const GAS float*)W)[(size_t)(k0 + i) * 6144];
#pragma unroll
                    for (int i = 0; i < 32; ++i) { const float w = wv[i]; a0 += cl[k0 + i] * w; a1 += cl[DM + k0 + i] * w; a2 += cl[2 * DM + k0 + i] * w; a3 += cl[3 * DM + k0 + i] * w; }
                }
                red[(kg * 4 + 0) * 64 + (tid & 63)] = a0; red[(kg * 4 + 1) * 64 + (tid & 63)] = a1; red[(kg * 4 + 2) * 64 + (tid & 63)] = a2; red[(kg * 4 + 3) * 64 + (tid & 63)] = a3;
                __syncthreads();
                if (tid < 256) { const int b = tid >> 6, j = tid & 63; float s = 0.f;
#pragma unroll
                    for (int g = 0; g < 8; ++g) s += red[(g * 4 + b) * 64 + j];
                    const int cc = (un % 96) * 64 + j;
                    ((GAS float*)MOD)[((size_t)l * NB + b) * 6144 + cc] = s + ((const GAS float*)modb)[(size_t)l * 6144 + cc]; }
                __syncthreads();
            }
            __syncthreads();
        }
        {
            const char __attribute__((address_space(4)))* kp = KA_PTR(); const int* pos = (const int*)KIN(kp, 2);
            for (int i = (vcu * NTHR + tid); i < MTOK * 8; i += G * NTHR) {
                const int row = i >> 3, j = i & 7;
                const float invf = (j == 0) ? 1.0f : (j == 1) ? 0.19392274f : (j == 2) ? 0.03760603f : (j == 3) ? 0.0072926646f : (j == 4) ? 0.0014142136f : (j == 5) ? 0.0002742482f : (j == 6) ? 5.3182957e-05f : 1.0313385e-05f;
                const float ang = (float)((const GAS int*)pos)[row] * invf;
                float co, si; cos_sin_acc(ang, co, si);
                { typedef float f32x2g __attribute__((ext_vector_type(2))); *(GAS f32x2g*)(CS + (size_t)i * 2) = (f32x2g){co, si}; }
            }
        }
        {
            const char __attribute__((address_space(4)))* kp = KA_PTR();
            LAS float* scr = (LAS float*)(L + wave * 16384);
            constexpr int I_IN = (DM / 64) * (NIN / 32), I_A = (WSP / 64) * (DM / 32), I_O = (DM / 64) * (DM / 32), I_UP = (DM / 64) * (NUP / 32), I_D = (DFF / 64) * (DM / 32);
            constexpr int I_L = I_IN + 2 * I_A + I_O + I_UP + I_D;
            for (int it = gw; it < DEPTH * I_L; it += NGW) {
                const int l = it / I_L; int r = it % I_L;
                if (r < I_IN) { transpose_item<1>(KIN(kp, 7) + (size_t)l * DM * NIN_SRC, DM, NIN_SRC, NIN, (bf16*)(ws + WS_WIN + l * WIN_L), scr, r, lane); continue; } r -= I_IN;
                if (r < I_A) { transpose_item<0>(KIN(kp, 9) + (size_t)l * WSP * DM, WSP, DM, DM, (bf16*)(ws + WS_WA + l * 2 * WA_L), scr, r, lane, DM, 0); continue; } r -= I_A;
                if (r < I_A) { transpose_item<0>(KIN(kp, 10) + (size_t)l * WSP * DM, WSP, DM, DM, (bf16*)(ws + WS_WA + l * 2 * WA_L), scr, r, lane, DM, WSP); continue; } r -= I_A;
                if (r < I_O) { transpose_item<0>(KIN(kp, 11) + (size_t)l * DM * DM, DM, DM, DM, (bf16*)(ws + WS_WO + l * WO_L), scr, r, lane); continue; } r -= I_O;
                if (r < I_UP) { transpose_item<2>(KIN(kp, 12) + (size_t)l * DM * NUP, DM, NUP, NUP, (bf16*)(ws + WS_WUP + l * WUP_L), scr, r, lane); continue; } r -= I_UP;
                transpose_item<0>(KIN(kp, 15) + (size_t)l * DFF * DM, DFF, DM, DM, (bf16*)(ws + WS_WD + l * WD_L), scr, r, lane);
            }
        }
        if (REP_P0 > 1) __syncthreads();
        }
        GRID_BAR();
    }

    for (int l = 0; l < DEPTH; ++l) {
        const int pb = 1 + l * NPL;
#if MK_STEP < 2
        if (IN(pb + 5)) {
            PHASE_IDS(); const float* const modl = MOD + (size_t)l * NB * 6144; (void)modl;
            if (l == 0) { const float* x_in = KIN(KA_PTR(), 0); for (size_t i = (size_t)vcu * NTHR + tid; i < (size_t)MTOK * DM / 4; i += (size_t)G * NTHR) ((GAS f32x4*)outp)[i] = ((const GAS f32x4*)x_in)[i]; }
            GRID_BAR();
        }
#else
        if (IN(pb + 0)) {
            PHASE_IDS(); const float* const modl = MOD + (size_t)l * NB * 6144; (void)modl;
            const char __attribute__((address_space(4)))* kp = KA_PTR();
            if (bx == 0 && tid < NB) ((gu32*)(ws + WS_CUM + MiB))[tid] = 0u;
            const float* g = KIN(kp, 5) + (size_t)l * DM;
            constexpr int RPW = MTOK / (256 * NWAVES);
            if (l == 0) {
                const float* xs = KIN(kp, 0);
                for (int r0 = gw * RPW; r0 < MTOK; r0 += NGW * RPW) {
                    const int b = r0 / SEQ; const float* mb = modl + (size_t)b * 6144;
                    f32x4 gv[4], scv[4], shv[4]; load_vec16(g, lane, gv); load_vec16(mb + 1024, lane, scv); load_vec16(mb, lane, shv);
#pragma unroll
                    for (int j = 0; j < 4; ++j) gv[j] = gv[j] * (scv[j] + 1.0f);
                    for (int r = r0; r < r0 + RPW; ++r) {
                        f32x4 v[4]; load_vec16(xs + (size_t)r * DM, lane, v); float s = 0.f;
#pragma unroll
                        for (int j = 0; j < 4; ++j) s += (v[j].x * v[j].x + v[j].y * v[j].y) + (v[j].z * v[j].z + v[j].w * v[j].w);
                        const float rstd = rsqrtf(wave_sum(s, lane) * (1.f / DM) + EPS);
                        GAS unsigned long long* o8 = (GAS unsigned long long*)(H + (size_t)r * DM) + lane;
#pragma unroll
                        for (int j = 0; j < 4; ++j) { const f32x4 y = v[j] * rstd * gv[j] + shv[j]; o8[64 * j] = (unsigned long long)pk2(y.x, y.y) | ((unsigned long long)pk2(y.z, y.w) << 32); }
                    }
                }
            } else {
                for (int r0 = gw * RPW; r0 < MTOK; r0 += NGW * RPW) {
                    const int b = r0 / SEQ; const float* mb = modl + (size_t)b * 6144;
                    f32x4 gv[4], scv[4], shv[4]; load_vec16b(g, lane, gv); load_vec16b(mb + 1024, lane, scv); load_vec16b(mb, lane, shv);
#pragma unroll
                    for (int j = 0; j < 4; ++j) gv[j] = gv[j] * (scv[j] + 1.0f);
                    for (int r = r0; r < r0 + RPW; ++r) {
                        f32x4 v[4]; load_row16b(XB + (size_t)r * DM, lane, v); float s = 0.f;
#pragma unroll
                        for (int j = 0; j < 4; ++j) s += (v[j].x * v[j].x + v[j].y * v[j].y) + (v[j].z * v[j].z + v[j].w * v[j].w);
                        const float rstd = rsqrtf(wave_sum(s, lane) * (1.f / DM) + EPS);
                        f32x4 y[4];
#pragma unroll
                        for (int j = 0; j < 4; ++j) y[j] = v[j] * rstd * gv[j] + shv[j];
                        store_row16b(H + (size_t)r * DM, lane, y);
                    }
                }
            }
            GRID_BAR();
        }
        if (IN(pb + 1)) {
            PHASE_IDS(); const float* const modl = MOD + (size_t)l * NB * 6144; (void)modl;
            pg8::Gemm g{H, (const bf16*)(ws + WS_WIN + l * WIN_L), MTOK, NIN, DM}; pg8::StaticOrder S; S.init(MTOK, NIN, G, bx);
            pg8::EpiInProj E{ws, CS, KIN(KA_PTR(), 8) + (size_t)l * 8};
            for (int rep = 0; rep < REP_INPROJ; ++rep) pg8::gemm_phase<pg8::EpiInProj, pg8::StaticOrder, true, true>(L, g, S, E, wave_s);
            GRID_BAR();
        }
        if (IN(pb + 2)) {
            PHASE_IDS(); const float* const modl = MOD + (size_t)l * NB * 6144; (void)modl;
            const float* LOGF = (const float*)(ws + WS_LOGF); float* CUM = (float*)(ws + WS_CUM);
            {
                GAS float* NRM = (GAS float*)(ws + WS_CUM + MiB + 4096);
                for (int jb = gw; jb < 2048; jb += NGW) {
                    const int idx = jb & 1023, b = idx >> 8, h = (idx >> 5) & 7, qb = idx & 31;
                    const bf16* P = (const bf16*)(ws + ((jb >> 10) ? WS_KF : WS_QF)) + ((size_t)b * SEQ + 256 * qb + 4 * lane) * 512 + h * 64; float mx = 0.f;
#pragma unroll
                    for (int r = 0; r < 4; ++r) { float n2 = 0.f;
#pragma unroll
                        for (int c8 = 0; c8 < 8; ++c8) { const v4u wv = *(const GAS v4u*)(P + (size_t)r * 512 + 8 * c8); const unsigned ww[4] = {wv.x, wv.y, wv.z, wv.w};
#pragma unroll
                            for (int e = 0; e < 4; ++e) { const float a = __uint_as_float(ww[e] << 16), bb = __uint_as_float(ww[e] & 0xffff0000u); n2 = fmaf(a, a, n2); n2 = fmaf(bb, bb, n2); } }
                        mx = fmaxf(mx, n2); }
#pragma unroll
                    for (int o = 1; o < 64; o <<= 1) mx = fmaxf(mx, lane_read(mx, lane ^ o));
                    if (lane == 0) NRM[jb] = sqrtf(mx) * 1.0001f;
                }
            }
            LAS float* wtot = (LAS float*)L;
            {
                for (int s = bx; s < 256; s += G) {
                    const bf16* KI = (const bf16*)(ws + WS_KI) + ((size_t)s * 128 + (tid >> 2)) * 64 + (tid & 3) * 16; float n2 = 0.f;
#pragma unroll
                    for (int c8 = 0; c8 < 2; ++c8) { const v4u wv = *(const GAS v4u*)(KI + 8 * c8); const unsigned ww[4] = {wv.x, wv.y, wv.z, wv.w};
#pragma unroll
                        for (int e = 0; e < 4; ++e) { const float a = __uint_as_float(ww[e] << 16), bb = __uint_as_float(ww[e] & 0xffff0000u); n2 = fmaf(a, a, n2); n2 = fmaf(bb, bb, n2); } }
                    n2 += lane_read(n2, lane ^ 1); n2 += lane_read(n2, lane ^ 2);
#pragma unroll
                    for (int o = 4; o < 64; o <<= 1) n2 = fmaxf(n2, lane_read(n2, lane ^ o));
                    if (lane == 0) __hip_atomic_fetch_max((gu32*)(ws + WS_CUM + MiB) + (s >> 6), __float_as_uint(n2), __ATOMIC_RELAXED, __HIP_MEMORY_SCOPE_AGENT);
                }
            }
            for (int sq = bx; sq < NB * 8; sq += G) {
                const int b = sq >> 3, h = sq & 7; float v[16]; float run = 0.f;
#pragma unroll
                for (int i = 0; i < 16; ++i) { run += ((const GAS float*)LOGF)[((size_t)b * SEQ + tid * 16 + i) * 8 + h]; v[i] = run; }
                float inc = run;
#pragma unroll
                for (int o = 1; o < 64; o <<= 1) { const float t = lane_read(inc, (lane - o) & 63); if (lane >= o) inc += t; }
                if (lane == 63) wtot[wave] = inc;
                __syncthreads();
                float base = inc - run;
                for (int w = 0; w < wave; ++w) base += wtot[w];
                float* o = CUM + (size_t)sq * SEQ + tid * 16;
#pragma unroll
                for (int i = 0; i < 16; i += 4) *(GAS f32x4*)(o + i) = (f32x4){v[i] + base, v[i + 1] + base, v[i + 2] + base, v[i + 3] + base};
                __syncthreads();
            }
            GRID_BAR();
        }
        if (IN(pb + 3)) {
            PHASE_IDS(); const float* const modl = MOD + (size_t)l * NB * 6144; (void)modl;
            if (wave >= 4) __builtin_amdgcn_s_setprio(1);
            gu32* const qctr = (gu32*)(ws + WS_CTL) + 8192 + 64 * l;
            volatile LAS unsigned* const qslot = (volatile LAS unsigned*)(L + MISC_OFF) + 12;
            if (tid == 0) qslot[0] = __hip_atomic_fetch_add(qctr, 1u, __ATOMIC_RELAXED, __HIP_MEMORY_SCOPE_AGENT);
            for (int cur = 0;; cur ^= 1) {
                __syncthreads();
                const int u = (int)qslot[cur];
                if (u >= 1536) break;
                unsigned nxt = 0u; if (tid == 0) nxt = __hip_atomic_fetch_add(qctr, 1u, __ATOMIC_RELAXED, __HIP_MEMORY_SCOPE_AGENT);
                if (u < 512) {
#if MK_STEP >= 3
                    dsa::unit(L, ws, (unsigned char*)outp, u & 3, 127 - (u >> 2), wave_s);
#endif
                } else {
                    const int r = u - 512, qb = 31 - (r >> 5), bh = r & 31;
                    attn_body::attn_unit<8>(bh >> 3, bh & 7, qb, (const attn_body::bf16*)(ws + WS_QF), (const attn_body::bf16*)(ws + WS_KF), (const attn_body::bf16*)(ws + WS_VF), (attn_body::bf16*)outp + 512,
                                            (const float*)(ws + WS_CUM), (const float*)(ws + WS_CUM + MiB + 4096), (char*)lds, wave_s);
                }
                if (tid == 0) qslot[cur ^ 1] = nxt;
            }
            __builtin_amdgcn_s_setprio(0);
            GRID_BAR();
        }
        if (IN(pb + 4)) {
            PHASE_IDS(); const float* const modl = MOD + (size_t)l * NB * 6144; (void)modl;
            { pg8::Gemm g{(const bf16*)outp, (const bf16*)(ws + WS_WA + l * 2 * WA_L), MTOK, DM, DM}; pg8::StaticOrder S; S.init(MTOK, DM, G, bx);
              pg8::EpiMerge E{H, (const bf16*)(ws + WS_GATES)};
              pg8::gemm_phase<pg8::EpiMerge, pg8::StaticOrder, true, true>(L, g, S, E, wave_s); }
            GRID_BAR();
        }
        if (IN(pb + 5)) {
            PHASE_IDS(); const float* const modl = MOD + (size_t)l * NB * 6144; (void)modl;
            const void* xs = (l == 0) ? (const void*)KIN(KA_PTR(), 0) : (const void*)XB;
            pg8::Gemm g{H, (const bf16*)(ws + WS_WO + l * WO_L), MTOK, DM, DM}; pg8::StaticOrder S; S.init(MTOK, DM, G, bx);
            pg8::EpiResidB E{xs, XB, modl + 2048, l == 0 ? 1 : 0};
            pg8::gemm_phase<pg8::EpiResidB, pg8::StaticOrder, true, true>(L, g, S, E, wave_s);
            GRID_BAR();
        }
#endif
        if (IN(pb + 6)) {
            PHASE_IDS(); const float* const modl = MOD + (size_t)l * NB * 6144; (void)modl;
            const float* g = KIN(KA_PTR(), 6) + (size_t)l * DM;
            constexpr int RPW = MTOK / (256 * NWAVES);
            for (int r0 = gw * RPW; r0 < MTOK; r0 += NGW * RPW) {
                const int b = r0 / SEQ; const float* mb = modl + (size_t)b * 6144;
                f32x4 gv[4], scv[4], shv[4]; load_vec16b(g, lane, gv); load_vec16b(mb + 4096, lane, scv); load_vec16b(mb + 3072, lane, shv);
#pragma unroll
                for (int j = 0; j < 4; ++j) gv[j] = gv[j] * (scv[j] + 1.0f);
                for (int r = r0; r < r0 + RPW; ++r) {
                    f32x4 v[4]; load_row16b(XB + (size_t)r * DM, lane, v); float s = 0.f;
#pragma unroll
                    for (int j = 0; j < 4; ++j) s += (v[j].x * v[j].x + v[j].y * v[j].y) + (v[j].z * v[j].z + v[j].w * v[j].w);
                    const float rstd = rsqrtf(wave_sum(s, lane) * (1.f / DM) + EPS);
                    f32x4 y[4];
#pragma unroll
                    for (int j = 0; j < 4; ++j) y[j] = v[j] * rstd * gv[j] + shv[j];
                    store_row16b(H + (size_t)r * DM, lane, y);
                }
            }
            GRID_BAR();
        }
        if (IN(pb + 7)) {
            PHASE_IDS(); const float* const modl = MOD + (size_t)l * NB * 6144; (void)modl;
            pg8::Gemm g{H, (const bf16*)(ws + WS_WUP + l * WUP_L), MTOK, NUP, DM}; pg8::StaticOrder S; S.init(MTOK, NUP, G, bx);
            const char __attribute__((address_space(4)))* kp = KA_PTR();
            pg8::EpiUpConv E{(bf16*)(ws + WS_ACT), (float*)(ws + WS_UH), (float*)(ws + WS_UT), KIN(kp, 13) + (size_t)l * 3 * NUP, KIN(kp, 14) + (size_t)l * NUP};
            for (int rep = 0; rep < REP_UP; ++rep) pg8::gemm_phase<pg8::EpiUpConv, pg8::StaticOrder, true, true>(L, g, S, E, wave_s);
            GRID_BAR();
        }
        if (IN(pb + 8)) {
            PHASE_IDS(); const float* const modl = MOD + (size_t)l * NB * 6144; (void)modl;
            const float* UH = (const float*)(ws + WS_UH); const float* UT = (const float*)(ws + WS_UT);
            const char __attribute__((address_space(4)))* kp = KA_PTR(); const float* cw = KIN(kp, 13) + (size_t)l * 3 * NUP; const float* cb = KIN(kp, 14) + (size_t)l * NUP;
            bf16* ACT = (bf16*)(ws + WS_ACT);
            for (int it = vcu * NTHR + tid; it < 512 * 2 * (DFF / 4); it += G * NTHR) {
                const int c4 = it % (DFF / 4), rr = (it / (DFF / 4)) & 1, Gq = it / (2 * (DFF / 4));
                const int j = 4 * c4, pn = j >> 7, cl = j & 127, ua = 256 * pn + cl;
                const bool first = (Gq % (SEQ / 64)) == 0;
                const f32x4 z = {0.f, 0.f, 0.f, 0.f};
                f32x4 res;
                f32x4 cv[2];
#pragma unroll
                for (int hb = 0; hb < 2; ++hb) {
                    const int uc = ua + 128 * hb, ch = hb * DFF + j;
                    const f32x4 u0 = *(const GAS f32x4*)(UH + ((size_t)Gq * 2 + rr) * NUP + uc);
                    const f32x4 u1 = rr ? *(const GAS f32x4*)(UH + ((size_t)Gq * 2) * NUP + uc) : (first ? z : *(const GAS f32x4*)(UT + ((size_t)(Gq - 1) * 2 + 1) * NUP + uc));
                    const f32x4 u2 = first ? z : *(const GAS f32x4*)(UT + ((size_t)(Gq - 1) * 2 + (rr ? 1 : 0)) * NUP + uc);
                    cv[hb] = *(const GAS f32x4*)(cb + ch) + *(const GAS f32x4*)(cw + ch) * u2 + *(const GAS f32x4*)(cw + NUP + ch) * u1 + *(const GAS f32x4*)(cw + 2 * NUP + ch) * u0;
                }
#pragma unroll
                for (int i = 0; i < 4; ++i) res[i] = cv[0][i] * pg8::fast_sigmoid(cv[0][i]) * cv[1][i];
                *(GAS unsigned long long*)(ACT + (size_t)(Gq * 64 + rr) * DFF + j) = (unsigned long long)pk2(res[0], res[1]) | ((unsigned long long)pk2(res[2], res[3]) << 32);
            }
            GRID_BAR();
        }
        if (IN(pb + 9)) {
            PHASE_IDS(); const float* const modl = MOD + (size_t)l * NB * 6144; (void)modl;
            pg8::Gemm g{(const bf16*)(ws + WS_ACT), (const bf16*)(ws + WS_WD + l * WD_L), MTOK, DM, DFF}; pg8::StaticOrder S; S.init(MTOK, DM, G, bx);
            pg8::EpiResidB E{(const void*)XB, XB, modl + 5120, 0};
            pg8::gemm_phase<pg8::EpiResidB, pg8::StaticOrder, true, true>(L, g, S, E, wave_s);
            GRID_BAR();
        }
    }
    if (IN(PH_FINAL)) {
        const int l = 0; PHASE_IDS(); const float* const modl = MOD + (size_t)l * NB * 6144; (void)modl;
        f32x4 gv[4]; load_vec16b(KIN(KA_PTR(), 16), lane, gv);
        for (int r = gw; r < MTOK; r += NGW) {
            f32x4 v[4]; load_row16b(XB + (size_t)r * DM, lane, v); float s = 0.f;
#pragma unroll
            for (int j = 0; j < 4; ++j) s += (v[j].x * v[j].x + v[j].y * v[j].y) + (v[j].z * v[j].z + v[j].w * v[j].w);
            const float rstd = rsqrtf(wave_sum(s, lane) * (1.f / DM) + EPS);
#pragma unroll
            for (int j = 0; j < 2; ++j) { *(GAS f32x4*)(outp + (size_t)r * DM + 512 * j + 8 * lane) = v[2 * j] * rstd * gv[2 * j]; *(GAS f32x4*)(outp + (size_t)r * DM + 512 * j + 8 * lane + 4) = v[2 * j + 1] * rstd * gv[2 * j + 1]; }
        }
    }
#undef IN
#undef GRID_BAR
}

extern "C" void kernel_launch(void* const* d_in, const int* in_sizes, int n_in, void* d_out, int out_size, void* d_ws, size_t ws_size, hipStream_t stream) {
    static int grid = 0;
    if (grid == 0) {
        if (n_in != 17 || out_size != MTOK * DM || ws_size < WS_END) { fprintf(stderr, "kernel_launch: unexpected problem (n_in %d, out %d, ws %zu)\n", n_in, out_size, ws_size); grid = -1; return; }
        int dev = 0, cus = 0, per_cu = 0;
        if (hipGetDevice(&dev) != hipSuccess || hipDeviceGetAttribute(&cus, hipDeviceAttributeMultiprocessorCount, dev) != hipSuccess) { grid = -1; return; }
        if (hipFuncSetAttribute((const void*)mk_fwd, hipFuncAttributeMaxDynamicSharedMemorySize, LDS_BYTES) != hipSuccess) { fprintf(stderr, "kernel_launch: hipFuncSetAttribute failed\n"); grid = -1; return; }
        if (hipOccupancyMaxActiveBlocksPerMultiprocessor(&per_cu, (const void*)mk_fwd, NTHR, LDS_BYTES) != hipSuccess || per_cu < 1) { fprintf(stderr, "kernel_launch: occupancy query says %d\n", per_cu); (void)hipGetLastError(); grid = -1; return; }
        grid = cus;
    }
    if (grid < 0) return;
    (void)hipMemsetAsync((char*)d_ws + WS_CTL, 0, CTL_ZERO_BYTES, stream);
    Args a{};
    for (int i = 0; i < 17; ++i) a.in[i] = (const float*)d_in[i];
    a.out = (float*)d_out; a.ws = (unsigned char*)d_ws; a.pad = 0;
#if MK_ONE_LAUNCH
    a.ph_lo = 0; a.ph_hi = N_PHASES; a.use_bar = 1;
    hipLaunchKernelGGL(mk_fwd, dim3(grid), dim3(NTHR), LDS_BYTES, stream, a);
#else
    for (int p = 0; p < N_PHASES; ++p) { a.ph_lo = p; a.ph_hi = p + 1; a.use_bar = 0; hipLaunchKernelGGL(mk_fwd, dim3(grid), dim3(NTHR), LDS_BYTES, stream, a); }
#endif
}
```

```cpp
#include <hip/hip_runtime.h>
#include <cstdio>
#include <cstdint>

constexpr int DM = 1024, NB = 4, SEQ = 8192, MTOK = NB * SEQ, DEPTH = 2;
constexpr int NIN_SRC = 4816, NIN = 4864;
constexpr int DFF = 2816, NUP = 2 * DFF;
constexpr int WSP = 512;
constexpr float EPS = 1e-6f;
constexpr float LOG2E = 1.4426950408889634f;
constexpr float C2 = 0.125f * LOG2E;


__device__ __forceinline__ float lane_read(float v, int src_lane) { return __builtin_bit_cast(float, __builtin_amdgcn_ds_bpermute(src_lane << 2, __builtin_bit_cast(int, v))); }
__device__ __forceinline__ unsigned lane_read_u(unsigned v, int src_lane) { return (unsigned)__builtin_amdgcn_ds_bpermute(src_lane << 2, (int)v); }

constexpr size_t MiB = 1u << 20;
constexpr size_t WS_CTL = 0, CTL_ZERO_BYTES = 1 * MiB;
constexpr size_t WS_MOD = 1 * MiB;
constexpr size_t WS_CS = 2 * MiB;
constexpr size_t WS_WIN = 4 * MiB, WIN_L = (size_t)NIN * DM * 2;
constexpr size_t WS_WA = 23 * MiB, WA_L = (size_t)DM * WSP * 2;
constexpr size_t WS_WB = 25 * MiB;
constexpr size_t WS_WO = 27 * MiB, WO_L = (size_t)DM * DM * 2;
constexpr size_t WS_WUP = 31 * MiB, WUP_L = (size_t)NUP * DM * 2;
constexpr size_t WS_WD = 53 * MiB, WD_L = (size_t)DM * DFF * 2;
constexpr size_t WS_H = 64 * MiB;
constexpr size_t WS_QA = 128 * MiB, WS_QF = 160 * MiB, WS_QI = 192 * MiB, WS_KF = 224 * MiB, WS_VF = 256 * MiB;
constexpr int GLD = 2080;
constexpr size_t WS_GATES = 288 * MiB;
constexpr size_t WS_KA = 419 * MiB, WS_VA = 423 * MiB, WS_KI = 427 * MiB, WS_WI = 431 * MiB, WS_LOGF = 432 * MiB, WS_CUM = 433 * MiB;
constexpr size_t WS_XB = 436 * MiB;
constexpr size_t WS_ACT = 128 * MiB;
constexpr size_t WS_UH = 304 * MiB, WS_UT = 326 * MiB;
constexpr size_t WS_END = 500 * MiB;
static_assert(WS_GATES + (size_t)MTOK * GLD * 2 <= WS_KA && WS_CUM + 2 * MiB <= WS_XB, "projection map");
static_assert(WS_WIN + 2 * WIN_L <= WS_WA && WS_WUP + 2 * WUP_L <= WS_WD && WS_WD + 2 * WD_L <= WS_H, "weight map");
static_assert(WS_ACT + (size_t)MTOK * DFF * 2 <= WS_UH && WS_UH + (size_t)512 * 2 * NUP * 4 <= WS_UT && WS_UT + (size_t)512 * 2 * NUP * 4 <= WS_GATES + 128 * MiB, "ffn map");
constexpr int CW_TMO = 0, CW_CODE = 1, CW_BAR = 4096;


namespace pg8 {
#define PG8_LAS __attribute__((address_space(3)))
typedef unsigned short bf16_t;
typedef short bf16x8 __attribute__((ext_vector_type(8)));
typedef float f32x4 __attribute__((ext_vector_type(4)));
typedef unsigned u32x4 __attribute__((ext_vector_type(4)));
constexpr int BM = 256, BK = 64, HALF = 128, HTB = HALF * BK * 2  , STAGE_BYTES = 8 * HTB, NXCD = 8, WGM = 8;

__host__ __device__ __forceinline__ int lds_byte(int r, int c) { const int st = (r >> 4) * 2 + (c >> 5), rr = r & 15, cc = c & 31, ob = rr * 64 + cc * 2; return st * 1024 + (ob ^ (((ob >> 9) & 1) << 5)); }
__host__ __device__ __forceinline__ void stage_rc(int b, int& R, int& C) { const int st = b / 1024, sb = b % 1024, swz = sb ^ (((sb >> 9) & 1) << 5); R = (st >> 1) * 16 + swz / 64; C = (st & 1) * 32 + (swz % 64) / 2; }
__host__ __device__ __forceinline__ int perm32(int rho) { const int n = rho >> 4, i = rho & 15; return 8 * (i >> 2) + 4 * n + (i & 3); }

struct Unit { int pm, pn; };
struct Gemm { const bf16_t* A; const bf16_t* Bt; int M, N, K; };

struct StaticOrder {
    int nM, nN, nwg, G, c;
    __host__ __device__ void init(int M, int N, int G_, int c_) { nM = M / BM; nN = N / BM; nwg = nM * nN; G = G_; c = c_; }
    __host__ __device__ __forceinline__ bool next(int i, Unit& u) const {
        const long L = (long)i * G + c; if (L >= nwg) return false;
        int wgid = (int)L; { const int q = nwg / NXCD, r = nwg % NXCD, xcd = wgid % NXCD, off = wgid / NXCD; wgid = (xcd < r ? xcd * (q + 1) : r * (q + 1) + (xcd - r) * q) + off; }
        const int nig = WGM * nN, gid = wgid / nig, fm = gid * WGM, gsz = (nM - fm) < WGM ? (nM - fm) : WGM;
        u.pm = fm + ((wgid % nig) % gsz); u.pn = (wgid % nig) / gsz; return true;
    }
    __device__ __forceinline__ void a_ready(const Unit&) const {}
    __device__ __forceinline__ void done(const Unit&) const {}
};

typedef float f32x2_cv __attribute__((ext_vector_type(2))); typedef __bf16 bf16x2_cv __attribute__((ext_vector_type(2)));
__device__ __forceinline__ unsigned cvt_pk_bf16(float lo, float hi) { const f32x2_cv v = {lo, hi}; const bf16x2_cv b = __builtin_convertvector(v, bf16x2_cv); return __builtin_bit_cast(unsigned, b); }

typedef float f32x2 __attribute__((ext_vector_type(2)));
typedef unsigned u32x2 __attribute__((ext_vector_type(2)));
#define PG8_GAS __attribute__((address_space(1)))
__device__ __forceinline__ float fast_sigmoid(float z) { return __builtin_amdgcn_rcpf(1.f + __builtin_amdgcn_exp2f(-z * 1.4426950408889634f)); }
__device__ __forceinline__ u32x4 pack8(const f32x4& v0, const f32x4& v1) { u32x4 w; w.x = cvt_pk_bf16(v0[0], v0[1]); w.y = cvt_pk_bf16(v0[2], v0[3]); w.z = cvt_pk_bf16(v1[0], v1[1]); w.w = cvt_pk_bf16(v1[2], v1[3]); return w; }

struct EpiInProj {
    static constexpr bool PERM = true, AFTER_DRAIN = false, MIDK = false;
    unsigned char* ws; const float* CS; const float* fbias;
    enum { K_PLAIN = 0, K_ROPE = 1, K_SIG = 2, K_SMALL = 3, K_NONE = 4 };
    __device__ __forceinline__ void operator()(const f32x4 (&acc)[2][2][4][2], const Unit& u, int wr, int wc, int fr_, int fq_) const {
        int fr = fr_, fq = fq_; asm volatile("" : "+v"(fr), "+v"(fq));
        const int row0 = u.pm * BM + wr * 64 + fr, pn = u.pn;
#pragma unroll
        for (int bj = 0; bj < 2; ++bj) {
            const int cg = 128 * bj + 32 * wc;
            int kind = K_PLAIN; size_t off = 0; int ld = 512, dcol = 0; float sc = 1.f;
            if (pn < 2)       { off = WS_QA; dcol = 256 * pn + cg; kind = (cg & 32) ? K_PLAIN : K_ROPE; sc = C2; }
            else if (pn == 2) {
                ld = 64;
                if (cg < 64)       { off = WS_KA; dcol = cg; kind = (cg == 0) ? K_ROPE : K_PLAIN; }
                else if (cg < 128) { off = WS_VA; dcol = cg - 64; }
                else if (cg < 192) { off = WS_KI; dcol = cg - 128; kind = (cg == 128) ? K_ROPE : K_PLAIN; }
                else kind = (cg == 192) ? K_SMALL : K_NONE;
            }
            else if (pn < 5)  { off = WS_QI; dcol = 256 * (pn - 3) + cg; kind = (cg & 32) ? K_PLAIN : K_ROPE; }
            else if (pn < 7)  { off = WS_QF; dcol = 256 * (pn - 5) + cg; sc = C2; }
            else if (pn < 9)  { off = WS_KF; dcol = 256 * (pn - 7) + cg; }
            else if (pn < 11) { off = WS_VF; dcol = 256 * (pn - 9) + cg; }
            else              { off = WS_GATES; ld = GLD; dcol = 256 * (pn - 11) + cg; kind = K_SIG; }
            kind = __builtin_amdgcn_readfirstlane(kind);
            if (kind == K_NONE) continue;
            if (kind == K_SMALL) {
                PG8_GAS float* p = (PG8_GAS float*)(ws + (fq == 0 ? WS_WI : WS_LOGF)) + (size_t)row0 * 8;
                const f32x4 fb0 = *(const PG8_GAS f32x4*)(fbias), fb1 = *(const PG8_GAS f32x4*)(fbias + 4);
#pragma unroll
                for (int ai = 0; ai < 2; ++ai)
#pragma unroll
                    for (int m = 0; m < 4; ++m) {
                        const f32x4 v0 = acc[ai][bj][m][0], v1 = acc[ai][bj][m][1];
                        const f32x4 z0 = v0 + fb0, z1 = v1 + fb1; f32x4 l0, l1;
#pragma unroll
                        for (int i = 0; i < 4; ++i) { l0[i] = fminf(z0[i], 0.f) - log1pf(__expf(-fabsf(z0[i]))); l1[i] = fminf(z1[i], 0.f) - log1pf(__expf(-fabsf(z1[i]))); }
                        const float s8 = 0.35355339059327373f;
                        const f32x4 o0 = (fq == 0) ? v0 * s8 : l0, o1 = (fq == 0) ? v1 * s8 : l1;
                        if (fq < 2) { *(PG8_GAS f32x4*)p = o0; *(PG8_GAS f32x4*)(p + 4) = o1; }
                        p += ((m < 3) ? 16 : (HALF - 48)) * 8; asm volatile("" : "+v"(p));
                    }
                continue;
            }
            PG8_GAS bf16_t* p = (PG8_GAS bf16_t*)(ws + off) + (size_t)row0 * ld + dcol + 8 * fq;
            if (kind == K_ROPE) {
                const int f4 = 4 * (fq & 1);
                const PG8_GAS float* cp = (const PG8_GAS float*)CS + (size_t)row0 * 16 + 2 * f4;
                PG8_GAS bf16_t* ph = p - 8 * fq;
                f32x4 cs0 = *(const PG8_GAS f32x4*)cp, cs1 = *(const PG8_GAS f32x4*)(cp + 4);
#pragma unroll
                for (int ai = 0; ai < 2; ++ai)
#pragma unroll
                    for (int m = 0; m < 4; ++m) {
                        const int adv = (m < 3) ? 16 : (HALF - 48);
                        const bool lastrow = (ai == 1 && m == 3);
                        const PG8_GAS float* cpn = cp + (lastrow ? 0 : adv * 16);
                        const f32x4 ns0 = *(const PG8_GAS f32x4*)cpn, ns1 = *(const PG8_GAS f32x4*)(cpn + 4);
                        const f32x4 v0 = acc[ai][bj][m][0] * sc, v1 = acc[ai][bj][m][1] * sc;
                        f32x4 o1, o2;
                        o1[0] = v0[0] * cs0[0] - v1[0] * cs0[1]; o2[0] = v1[0] * cs0[0] + v0[0] * cs0[1];
                        o1[1] = v0[1] * cs0[2] - v1[1] * cs0[3]; o2[1] = v1[1] * cs0[2] + v0[1] * cs0[3];
                        o1[2] = v0[2] * cs1[0] - v1[2] * cs1[1]; o2[2] = v1[2] * cs1[0] + v0[2] * cs1[1];
                        o1[3] = v0[3] * cs1[2] - v1[3] * cs1[3]; o2[3] = v1[3] * cs1[2] + v0[3] * cs1[3];
                        u32x2 w1, w2; w1.x = cvt_pk_bf16(o1[0], o1[1]); w1.y = cvt_pk_bf16(o1[2], o1[3]); w2.x = cvt_pk_bf16(o2[0], o2[1]); w2.y = cvt_pk_bf16(o2[2], o2[3]);
                        if (fq < 2) { *(PG8_GAS u32x2*)(ph + f4) = w1; *(PG8_GAS u32x2*)(ph + 8 + f4) = w2; }
                        else *(PG8_GAS u32x4*)p = pack8(v0, v1);
                        p += (size_t)adv * ld; ph += (size_t)adv * ld; cp = cpn; cs0 = ns0; cs1 = ns1; asm volatile("" : "+v"(p), "+v"(ph), "+v"(cp));
                    }
            } else if (kind == K_SIG) {
#pragma unroll
                for (int ai = 0; ai < 2; ++ai)
#pragma unroll
                    for (int m = 0; m < 4; ++m) {
                        f32x4 v0 = acc[ai][bj][m][0], v1 = acc[ai][bj][m][1];
#pragma unroll
                        for (int i = 0; i < 4; ++i) { v0[i] = fast_sigmoid(v0[i]); v1[i] = fast_sigmoid(v1[i]); }
                        *(PG8_GAS u32x4*)p = pack8(v0, v1);
                        p += (size_t)((m < 3) ? 16 : (HALF - 48)) * ld; asm volatile("" : "+v"(p));
                    }
            } else {
#pragma unroll
                for (int ai = 0; ai < 2; ++ai)
#pragma unroll
                    for (int m = 0; m < 4; ++m) {
                        *(PG8_GAS u32x4*)p = pack8(acc[ai][bj][m][0] * sc, acc[ai][bj][m][1] * sc);
                        p += (size_t)((m < 3) ? 16 : (HALF - 48)) * ld; asm volatile("" : "+v"(p));
                    }
            }
        }
    }
};

template <int MODE> struct EpiGate {
    static constexpr bool PERM = true, AFTER_DRAIN = false, MIDK = false;
    bf16_t* O; const bf16_t* T; const bf16_t* G; int ldg;
    __device__ __forceinline__ void operator()(const f32x4 (&acc)[2][2][4][2], const Unit& u, int wr, int wc, int fr_, int fq_) const {
        int fr = fr_, fq = fq_; asm volatile("" : "+v"(fr), "+v"(fq));
        const int row0 = u.pm * BM + wr * 64 + fr, col0 = u.pn * BM + wc * 32 + 8 * fq;
        const PG8_GAS bf16_t* gp = (const PG8_GAS bf16_t*)G + (size_t)row0 * ldg + col0; const PG8_GAS bf16_t* tp = (const PG8_GAS bf16_t*)T + (size_t)row0 * DM + col0;
        PG8_GAS bf16_t* op = (PG8_GAS bf16_t*)O + (size_t)row0 * DM + col0;
        u32x4 gw[2], tw[2];
#pragma unroll
        for (int bj = 0; bj < 2; ++bj) { gw[bj] = *(const PG8_GAS u32x4*)(gp + bj * HALF); if (MODE == 1) tw[bj] = *(const PG8_GAS u32x4*)(tp + bj * HALF); }
#pragma unroll
        for (int ai = 0; ai < 2; ++ai)
#pragma unroll
            for (int m = 0; m < 4; ++m) {
                const int adv = (m < 3) ? 16 : (HALF - 48); const bool lastrow = (ai == 1 && m == 3);
                const PG8_GAS bf16_t* gpn = gp + (lastrow ? 0 : (size_t)adv * ldg); const PG8_GAS bf16_t* tpn = tp + (lastrow ? 0 : (size_t)adv * DM);
                u32x4 gn[2], tn[2];
#pragma unroll
                for (int bj = 0; bj < 2; ++bj) { gn[bj] = *(const PG8_GAS u32x4*)(gpn + bj * HALF); if (MODE == 1) tn[bj] = *(const PG8_GAS u32x4*)(tpn + bj * HALF); }
#pragma unroll
                for (int bj = 0; bj < 2; ++bj) {
                    f32x4 v0 = acc[ai][bj][m][0], v1 = acc[ai][bj][m][1];
                    v0[0] *= __uint_as_float(gw[bj].x << 16); v0[1] *= __uint_as_float(gw[bj].x & 0xffff0000u); v0[2] *= __uint_as_float(gw[bj].y << 16); v0[3] *= __uint_as_float(gw[bj].y & 0xffff0000u);
                    v1[0] *= __uint_as_float(gw[bj].z << 16); v1[1] *= __uint_as_float(gw[bj].z & 0xffff0000u); v1[2] *= __uint_as_float(gw[bj].w << 16); v1[3] *= __uint_as_float(gw[bj].w & 0xffff0000u);
                    if (MODE == 1) {
                        v0[0] += __uint_as_float(tw[bj].x << 16); v0[1] += __uint_as_float(tw[bj].x & 0xffff0000u); v0[2] += __uint_as_float(tw[bj].y << 16); v0[3] += __uint_as_float(tw[bj].y & 0xffff0000u);
                        v1[0] += __uint_as_float(tw[bj].z << 16); v1[1] += __uint_as_float(tw[bj].z & 0xffff0000u); v1[2] += __uint_as_float(tw[bj].w << 16); v1[3] += __uint_as_float(tw[bj].w & 0xffff0000u); }
                    *(PG8_GAS u32x4*)(op + bj * HALF) = pack8(v0, v1); }
                op += (size_t)adv * DM; gp = gpn; tp = tpn; gw[0] = gn[0]; gw[1] = gn[1]; if (MODE == 1) { tw[0] = tn[0]; tw[1] = tn[1]; }
                asm volatile("" : "+v"(op), "+v"(gp), "+v"(tp));
            }
    }
};


struct EpiMerge {
    static constexpr bool PERM = true, AFTER_DRAIN = false, MIDK = true;
    bf16_t* O; const bf16_t* G;
    static __device__ __forceinline__ constexpr int roff(int r) { return (r >> 2) * HALF + (r & 3) * 16; }
    __device__ __forceinline__ void mid(f32x4 (&acc)[2][2][4][2], const Unit& u, int wr, int wc, int fr_, int fq_) const {
        int fr = fr_, fq = fq_; asm volatile("" : "+v"(fr), "+v"(fq));
        const PG8_GAS bf16_t* gp = (const PG8_GAS bf16_t*)G + (size_t)(u.pm * BM + wr * 64 + fr) * GLD + u.pn * BM + wc * 32 + 8 * fq;
        u32x4 ga[4][2], gb[4][2];
#pragma unroll
        for (int r = 0; r < 4; ++r)
#pragma unroll
            for (int bj = 0; bj < 2; ++bj) { ga[r][bj] = *(const PG8_GAS u32x4*)(gp + (size_t)roff(r) * GLD + bj * HALF); gb[r][bj] = *(const PG8_GAS u32x4*)(gp + (size_t)roff(r) * GLD + 1024 + bj * HALF); }
#pragma unroll
        for (int r = 0; r < 8; ++r) {
            const int ai = r >> 2, m = r & 3, s = r & 3;
#pragma unroll
            for (int bj = 0; bj < 2; ++bj) {
                const unsigned gaw[4] = {ga[s][bj].x, ga[s][bj].y, ga[s][bj].z, ga[s][bj].w}, gbw[4] = {gb[s][bj].x, gb[s][bj].y, gb[s][bj].z, gb[s][bj].w};
#pragma unroll
                for (int i = 0; i < 4; ++i) {
                    const float r0 = __uint_as_float(gaw[i] << 16) * __builtin_amdgcn_rcpf(fmaxf(__uint_as_float(gbw[i] << 16), 1e-20f)), r1 = __uint_as_float(gaw[i] & 0xffff0000u) * __builtin_amdgcn_rcpf(fmaxf(__uint_as_float(gbw[i] & 0xffff0000u), 1e-20f));
                    acc[ai][bj][m][i >> 1][2 * (i & 1)] *= r0; acc[ai][bj][m][i >> 1][2 * (i & 1) + 1] *= r1; }
            }
            if (r < 4) {
#pragma unroll
                for (int bj = 0; bj < 2; ++bj) { ga[s][bj] = *(const PG8_GAS u32x4*)(gp + (size_t)roff(r + 4) * GLD + bj * HALF); gb[s][bj] = *(const PG8_GAS u32x4*)(gp + (size_t)roff(r + 4) * GLD + 1024 + bj * HALF); }
            }
        }
    }
    __device__ __forceinline__ void operator()(const f32x4 (&acc)[2][2][4][2], const Unit& u, int wr, int wc, int fr_, int fq_) const {
        int fr = fr_, fq = fq_; asm volatile("" : "+v"(fr), "+v"(fq));
        const int row0 = u.pm * BM + wr * 64 + fr, col0 = u.pn * BM + wc * 32 + 8 * fq;
        const PG8_GAS bf16_t* gp = (const PG8_GAS bf16_t*)G + (size_t)row0 * GLD + 1024 + col0; PG8_GAS bf16_t* op = (PG8_GAS bf16_t*)O + (size_t)row0 * DM + col0;
        u32x4 gw[8][2];
#pragma unroll
        for (int r = 0; r < 8; ++r)
#pragma unroll
            for (int bj = 0; bj < 2; ++bj) gw[r][bj] = *(const PG8_GAS u32x4*)(gp + (size_t)roff(r) * GLD + bj * HALF);
#pragma unroll
        for (int r = 0; r < 8; ++r) {
            const int ai = r >> 2, m = r & 3;
#pragma unroll
            for (int bj = 0; bj < 2; ++bj) {
                f32x4 v0 = acc[ai][bj][m][0], v1 = acc[ai][bj][m][1];
                v0[0] *= fmaxf(__uint_as_float(gw[r][bj].x << 16), 1e-20f); v0[1] *= fmaxf(__uint_as_float(gw[r][bj].x & 0xffff0000u), 1e-20f); v0[2] *= fmaxf(__uint_as_float(gw[r][bj].y << 16), 1e-20f); v0[3] *= fmaxf(__uint_as_float(gw[r][bj].y & 0xffff0000u), 1e-20f);
                v1[0] *= fmaxf(__uint_as_float(gw[r][bj].z << 16), 1e-20f); v1[1] *= fmaxf(__uint_as_float(gw[r][bj].z & 0xffff0000u), 1e-20f); v1[2] *= fmaxf(__uint_as_float(gw[r][bj].w << 16), 1e-20f); v1[3] *= fmaxf(__uint_as_float(gw[r][bj].w & 0xffff0000u), 1e-20f);
                *(PG8_GAS u32x4*)(op + (size_t)roff(r) * DM + bj * HALF) = pack8(v0, v1); }
        }
    }
};

struct EpiResid {
    static constexpr bool PERM = false, AFTER_DRAIN = false, MIDK = false;
    const float* SRC; float* OUT; const float* gate;
    __device__ __forceinline__ void operator()(const f32x4 (&acc)[2][2][4][2], const Unit& u, int wr, int wc, int fr_, int fq_) const {
        int fr = fr_, fq = fq_; asm volatile("" : "+v"(fr), "+v"(fq));
        const int row0 = u.pm * BM + wr * 64 + fr, col0 = u.pn * BM + wc * 32 + 4 * fq;
        const float* gb = gate + (size_t)(u.pm / (SEQ / BM)) * 6144 + col0;
        f32x4 g[2][2];
#pragma unroll
        for (int bj = 0; bj < 2; ++bj) { g[bj][0] = *(const PG8_GAS f32x4*)(gb + bj * HALF); g[bj][1] = *(const PG8_GAS f32x4*)(gb + bj * HALF + 16); }
        const PG8_GAS float* sp = (const PG8_GAS float*)SRC + (size_t)row0 * DM + col0; PG8_GAS float* op = (PG8_GAS float*)OUT + (size_t)row0 * DM + col0;
        f32x4 sv[2][2];
#pragma unroll
        for (int bj = 0; bj < 2; ++bj) { sv[bj][0] = *(const PG8_GAS f32x4*)(sp + bj * HALF); sv[bj][1] = *(const PG8_GAS f32x4*)(sp + bj * HALF + 16); }
#pragma unroll
        for (int ai = 0; ai < 2; ++ai)
#pragma unroll
            for (int m = 0; m < 4; ++m) {
                const int adv = (m < 3) ? 16 : (HALF - 48); const bool lastrow = (ai == 1 && m == 3);
                const PG8_GAS float* spn = sp + (lastrow ? 0 : (size_t)adv * DM);
                f32x4 sn[2][2];
#pragma unroll
                for (int bj = 0; bj < 2; ++bj) { sn[bj][0] = *(const PG8_GAS f32x4*)(spn + bj * HALF); sn[bj][1] = *(const PG8_GAS f32x4*)(spn + bj * HALF + 16); }
#pragma unroll
                for (int bj = 0; bj < 2; ++bj) {
                    *(PG8_GAS f32x4*)(op + bj * HALF) = sv[bj][0] + g[bj][0] * acc[ai][bj][m][0];
                    *(PG8_GAS f32x4*)(op + bj * HALF + 16) = sv[bj][1] + g[bj][1] * acc[ai][bj][m][1]; }
                op += (size_t)adv * DM; sp = spn;
#pragma unroll
                for (int bj = 0; bj < 2; ++bj) { sv[bj][0] = sn[bj][0]; sv[bj][1] = sn[bj][1]; }
                asm volatile("" : "+v"(op), "+v"(sp));
            }
    }
};

struct EpiResidB {
    static constexpr bool PERM = true, AFTER_DRAIN = false, MIDK = false;
    const void* SRC; bf16_t* OUT; const float* gate; int src_f32;
    __device__ __forceinline__ void operator()(const f32x4 (&acc)[2][2][4][2], const Unit& u, int wr, int wc, int fr_, int fq_) const {
        int fr = fr_, fq = fq_; asm volatile("" : "+v"(fr), "+v"(fq));
        const int row0 = u.pm * BM + wr * 64 + fr, col0 = u.pn * BM + wc * 32 + 8 * fq;
        const float* gb = gate + (size_t)(u.pm / (SEQ / BM)) * 6144 + col0;
        f32x4 g[2][2];
#pragma unroll
        for (int bj = 0; bj < 2; ++bj) { g[bj][0] = *(const PG8_GAS f32x4*)(gb + bj * HALF); g[bj][1] = *(const PG8_GAS f32x4*)(gb + bj * HALF + 4); }
        PG8_GAS bf16_t* op = (PG8_GAS bf16_t*)OUT + (size_t)row0 * DM + col0;
        if (src_f32) {
            const PG8_GAS float* sp = (const PG8_GAS float*)SRC + (size_t)row0 * DM + col0;
            f32x4 sv[2][2];
#pragma unroll
            for (int bj = 0; bj < 2; ++bj) { sv[bj][0] = *(const PG8_GAS f32x4*)(sp + bj * HALF); sv[bj][1] = *(const PG8_GAS f32x4*)(sp + bj * HALF + 4); }
#pragma unroll
            for (int ai = 0; ai < 2; ++ai)
#pragma unroll
                for (int m = 0; m < 4; ++m) {
                    const int adv = (m < 3) ? 16 : (HALF - 48); const bool lastrow = (ai == 1 && m == 3);
                    const PG8_GAS float* spn = sp + (lastrow ? 0 : (size_t)adv * DM);
                    f32x4 sn[2][2];
#pragma unroll
                    for (int bj = 0; bj < 2; ++bj) { sn[bj][0] = *(const PG8_GAS f32x4*)(spn + bj * HALF); sn[bj][1] = *(const PG8_GAS f32x4*)(spn + bj * HALF + 4); }
#pragma unroll
                    for (int bj = 0; bj < 2; ++bj) *(PG8_GAS u32x4*)(op + bj * HALF) = pack8(sv[bj][0] + g[bj][0] * acc[ai][bj][m][0], sv[bj][1] + g[bj][1] * acc[ai][bj][m][1]);
                    op += (size_t)adv * DM; sp = spn;
#pragma unroll
                    for (int bj = 0; bj < 2; ++bj) { sv[bj][0] = sn[bj][0]; sv[bj][1] = sn[bj][1]; }
                    asm volatile("" : "+v"(op), "+v"(sp));
                }
        } else {
            const PG8_GAS bf16_t* sp = (const PG8_GAS bf16_t*)SRC + (size_t)row0 * DM + col0;
            u32x4 sv[2];
#pragma unroll
            for (int bj = 0; bj < 2; ++bj) sv[bj] = *(const PG8_GAS u32x4*)(sp + bj * HALF);
#pragma unroll
            for (int ai = 0; ai < 2; ++ai)
#pragma unroll
                for (int m = 0; m < 4; ++m) {
                    const int adv = (m < 3) ? 16 : (HALF - 48); const bool lastrow = (ai == 1 && m == 3);
                    const PG8_GAS bf16_t* spn = sp + (lastrow ? 0 : (size_t)adv * DM);
                    u32x4 sn[2];
#pragma unroll
                    for (int bj = 0; bj < 2; ++bj) sn[bj] = *(const PG8_GAS u32x4*)(spn + bj * HALF);
#pragma unroll
                    for (int bj = 0; bj < 2; ++bj) {
                        const f32x4 s0 = {__uint_as_float(sv[bj].x << 16), __uint_as_float(sv[bj].x & 0xffff0000u), __uint_as_float(sv[bj].y << 16), __uint_as_float(sv[bj].y & 0xffff0000u)};
                        const f32x4 s1 = {__uint_as_float(sv[bj].z << 16), __uint_as_float(sv[bj].z & 0xffff0000u), __uint_as_float(sv[bj].w << 16), __uint_as_float(sv[bj].w & 0xffff0000u)};
                        *(PG8_GAS u32x4*)(op + bj * HALF) = pack8(s0 + g[bj][0] * acc[ai][bj][m][0], s1 + g[bj][1] * acc[ai][bj][m][1]); }
                    op += (size_t)adv * DM; sp = spn; sv[0] = sn[0]; sv[1] = sn[1];
                    asm volatile("" : "+v"(op), "+v"(sp));
                }
        }
    }
};

__device__ __forceinline__ float dpp_shr1(float old, float src) { return __builtin_bit_cast(float, __builtin_amdgcn_update_dpp(__builtin_bit_cast(int, old), __builtin_bit_cast(int, src), 0x111, 0xf, 0xf, false)); }
__device__ __forceinline__ float dpp_shr2(float old, float src) { return __builtin_bit_cast(float, __builtin_amdgcn_update_dpp(__builtin_bit_cast(int, old), __builtin_bit_cast(int, src), 0x112, 0xf, 0xf, false)); }
__device__ __forceinline__ float dpp_ror1(float src) { return __builtin_bit_cast(float, __builtin_amdgcn_update_dpp(0, __builtin_bit_cast(int, src), 0x121, 0xf, 0xf, false)); }
__device__ __forceinline__ float dpp_ror2(float src) { return __builtin_bit_cast(float, __builtin_amdgcn_update_dpp(0, __builtin_bit_cast(int, src), 0x122, 0xf, 0xf, false)); }
struct EpiUpConv {
    static constexpr bool PERM = true, AFTER_DRAIN = false, MIDK = false;
    bf16_t* ACT; float* UH; float* UT; const float* cw; const float* cb;
    __device__ __forceinline__ void operator()(const f32x4 (&acc)[2][2][4][2], const Unit& u, int wr, int wc, int fr_, int fq_) const {
        int fr = fr_, fq = fq_; asm volatile("" : "+v"(fr), "+v"(fq));
        const int row0 = u.pm * BM + wr * 64 + fr, cl = wc * 32 + 8 * fq;
        const int jc = u.pn * HALF + cl;
#pragma unroll
        for (int n = 0; n < 2; ++n) {
            const float* cwp = cw + jc + 4 * n; asm volatile("" : "+v"(cwp));
            const f32x4 wa0 = *(const PG8_GAS f32x4*)(cwp), wa1 = *(const PG8_GAS f32x4*)(cwp + NUP), wa2 = *(const PG8_GAS f32x4*)(cwp + 2 * NUP), ba = *(const PG8_GAS f32x4*)(cb + jc + 4 * n);
            const f32x4 wb0 = *(const PG8_GAS f32x4*)(cwp + DFF), wb1 = *(const PG8_GAS f32x4*)(cwp + NUP + DFF), wb2 = *(const PG8_GAS f32x4*)(cwp + 2 * NUP + DFF), bb = *(const PG8_GAS f32x4*)(cb + DFF + jc + 4 * n);
            bf16_t* ap = ACT + (size_t)row0 * DFF + jc + 4 * n;
#pragma unroll
            for (int ai = 0; ai < 2; ++ai) {
#pragma unroll
                for (int m = 0; m < 4; ++m) {
                    const f32x4 a = acc[ai][0][m][n], b = acc[ai][1][m][n];
                    const f32x4 z4 = {0.f, 0.f, 0.f, 0.f};
                    const f32x4 ap_ = (m > 0) ? acc[ai][0][m > 0 ? m - 1 : 0][n] : z4, bp_ = (m > 0) ? acc[ai][1][m > 0 ? m - 1 : 0][n] : z4;
                    f32x4 res;
#pragma unroll
                    for (int i = 0; i < 4; ++i) {
                        const float a1 = dpp_shr1(dpp_ror1(ap_[i]), a[i]), a2 = dpp_shr2(dpp_ror2(ap_[i]), a[i]), b1 = dpp_shr1(dpp_ror1(bp_[i]), b[i]), b2 = dpp_shr2(dpp_ror2(bp_[i]), b[i]);
                        const float ca = ba[i] + wa0[i] * a2 + wa1[i] * a1 + wa2[i] * a[i];
                        const float cbv = bb[i] + wb0[i] * b2 + wb1[i] * b1 + wb2[i] * b[i];
                        res[i] = ca * fast_sigmoid(ca) * cbv;
                    }
                    if (!(m == 0 && fr < 2)) { u32x2 w; w.x = cvt_pk_bf16(res[0], res[1]); w.y = cvt_pk_bf16(res[2], res[3]); *(PG8_GAS u32x2*)ap = w; }
                    ap += (m < 3) ? 16 * DFF : (HALF - 48) * DFF; asm volatile("" : "+v"(ap));
                    __builtin_amdgcn_sched_barrier(0);
                }
            }
        }
#pragma unroll
        for (int ai = 0; ai < 2; ++ai) {
            const int G = (u.pm * BM + ai * HALF + wr * 64) >> 6;
            if (fr < 2) { float* p = UH + ((size_t)G * 2 + fr) * NUP + u.pn * BM + cl; asm volatile("" : "+v"(p));
#pragma unroll
                for (int bj = 0; bj < 2; ++bj) { *(PG8_GAS f32x4*)(p + bj * HALF) = acc[ai][bj][0][0]; *(PG8_GAS f32x4*)(p + bj * HALF + 4) = acc[ai][bj][0][1]; } }
            if (fr >= 14) { float* p = UT + ((size_t)G * 2 + (fr - 14)) * NUP + u.pn * BM + cl; asm volatile("" : "+v"(p));
#pragma unroll
                for (int bj = 0; bj < 2; ++bj) { *(PG8_GAS f32x4*)(p + bj * HALF) = acc[ai][bj][3][0]; *(PG8_GAS f32x4*)(p + bj * HALF + 4) = acc[ai][bj][3][1]; } }
            __builtin_amdgcn_sched_barrier(0);
        }
    }
};
template <class Epi, class Sched, bool ALIGN_EPI = false, bool SP2 = false>
__device__ __forceinline__ void gemm_phase(PG8_LAS unsigned char* lds, const Gemm g, const Sched& S, const Epi& E, int wave_in) {
    int tid_; { int ln_; asm volatile("v_mbcnt_lo_u32_b32 %0, -1, 0\n\tv_mbcnt_hi_u32_b32 %0, -1, %0" : "=v"(ln_)); tid_ = wave_in * 64 + ln_; }
    const int tid = tid_, wid = __builtin_amdgcn_readfirstlane(tid >> 6), lane = tid & 63, wr = wid >> 2, wc = wid & 3, fr = lane & 15, fq = lane >> 4;
    const int K = g.K, nt = K / BK;
    unsigned voffA[2], voffB[2];
#pragma unroll
    for (int i = 0; i < 2; ++i) { int R, C; stage_rc(tid * 16 + i * 8192, R, C); const int Rb = Epi::PERM ? ((R & ~31) + perm32(R & 31)) : R;
        voffA[i] = (unsigned)(R * K + C) * 2u; voffB[i] = (unsigned)(Rb * K + C) * 2u; }
    const size_t kstep = (size_t)(BK * 2);
    const size_t hstep = (size_t)HALF * K * 2;
    const size_t tstep = 2 * hstep;
    const unsigned ldsw = (unsigned)wid * 1024u;
    const int aoff = lds_byte(wr * 64 + fr, fq * 8), boff = lds_byte(wc * 32 + fr, fq * 8);
#define PG8_SA(b, h) (((b) * 2 + (h)) * HTB)
#define PG8_SB(b, h) ((4 + (b) * 2 + (h)) * HTB)
#define PG8_STAGE(bufoff, gbase, voff) do { _Pragma("unroll") for (int _i = 0; _i < 2; ++_i) \
        __builtin_amdgcn_global_load_lds((const unsigned*)((const char*)(gbase) + (voff)[_i]), (PG8_LAS unsigned*)(lds + (bufoff) + ldsw + _i * 8192), 16, 0, 0); } while (0)
#define PG8_LDA(dst, b, h) do { _Pragma("unroll") for (int m = 0; m < 4; ++m) _Pragma("unroll") for (int k = 0; k < 2; ++k) dst[m][k] = *(const PG8_LAS bf16x8*)(lds + PG8_SA(b, h) + aoff + m * 2048 + k * 1024); } while (0)
#define PG8_LDB(dst, b, h) do { _Pragma("unroll") for (int n = 0; n < 2; ++n) _Pragma("unroll") for (int k = 0; k < 2; ++k) dst[n][k] = *(const PG8_LAS bf16x8*)(lds + PG8_SB(b, h) + boff + n * 2048 + k * 1024); } while (0)
#define PG8_MMA(ai, bj, At, Bt) do { __builtin_amdgcn_s_setprio(1); _Pragma("unroll") for (int m = 0; m < 4; ++m) _Pragma("unroll") for (int n = 0; n < 2; ++n) _Pragma("unroll") for (int k = 0; k < 2; ++k) \
        acc[ai][bj][m][n] = __builtin_amdgcn_mfma_f32_16x16x32_bf16(Bt[n][k], At[m][k], acc[ai][bj][m][n], 0, 0, 0); __builtin_amdgcn_s_setprio(0); } while (0)
#define PG8_WAIT_V(n) asm volatile("s_waitcnt vmcnt(" #n ")" ::: "memory")
#define PG8_WAIT_L(n) asm volatile("s_waitcnt lgkmcnt(" #n ")" ::: "memory")
#define PG8_BAR __builtin_amdgcn_s_barrier()
#define PG8_SCHED __builtin_amdgcn_sched_barrier(0)
    Unit cur, nxt; int ui = 0;
    if (!S.next(0, cur)) return;
    f32x4 acc[2][2][4][2];
#pragma unroll
    for (int a = 0; a < 2; ++a)
#pragma unroll
        for (int b = 0; b < 2; ++b)
#pragma unroll
            for (int m = 0; m < 4; ++m)
#pragma unroll
                for (int n = 0; n < 2; ++n) acc[a][b][m][n] = (f32x4){0.f, 0.f, 0.f, 0.f};
    bf16x8 At[4][2], B0[2][2], B1[2][2];
    const char* cA = (const char*)g.A + (size_t)cur.pm * tstep; const char* cB = (const char*)g.Bt + (size_t)cur.pn * tstep;
    S.a_ready(cur);
    if constexpr (SP2) {
        PG8_STAGE(PG8_SB(0, 0), cB, voffB); PG8_STAGE(PG8_SB(0, 1), cB + hstep, voffB); PG8_STAGE(PG8_SA(0, 0), cA, voffA); PG8_STAGE(PG8_SA(0, 1), cA + hstep, voffA);
        if (wr == 1) PG8_BAR;
        PG8_WAIT_V(2); PG8_BAR;
        PG8_STAGE(PG8_SB(1, 0), cB + kstep, voffB); PG8_STAGE(PG8_SA(1, 0), cA + kstep, voffA); PG8_STAGE(PG8_SB(1, 1), cB + hstep + kstep, voffB);
        PG8_WAIT_V(6); PG8_BAR;
    } else {
        PG8_STAGE(PG8_SB(0, 0), cB, voffB); PG8_STAGE(PG8_SA(0, 0), cA, voffA); PG8_STAGE(PG8_SB(0, 1), cB + hstep, voffB); PG8_STAGE(PG8_SA(0, 1), cA + hstep, voffA);
        if (wr == 1) PG8_BAR;
        PG8_WAIT_V(4); PG8_BAR;
        PG8_STAGE(PG8_SB(1, 0), cB + kstep, voffB); PG8_STAGE(PG8_SA(1, 0), cA + kstep, voffA); PG8_STAGE(PG8_SB(1, 1), cB + hstep + kstep, voffB);
        PG8_WAIT_V(6); PG8_BAR;
    }
    for (;;) {
        const bool has_next = S.next(ui + 1, nxt);
        const char* nA = has_next ? (const char*)g.A + (size_t)nxt.pm * tstep : cA; const char* nB = has_next ? (const char*)g.Bt + (size_t)nxt.pn * tstep : cB;
        for (int t = 0; t < nt; t += 2) {
            if constexpr (Epi::MIDK) { if (t == (nt >> 1)) E.mid(acc, cur, wr, wc, fr, fq); }
            const bool last = (t == nt - 2);
            const char* a1 = cA + (size_t)(t + 1) * kstep;
            const char* a2 = last ? nA : cA + (size_t)(t + 2) * kstep; const char* b2 = last ? nB : cB + (size_t)(t + 2) * kstep;
            const char* a3 = a2 + kstep; const char* b3 = b2 + kstep;
            if (last && has_next) S.a_ready(nxt);
            if constexpr (SP2) {
            PG8_LDB(B0, 0, 0); PG8_LDB(B1, 0, 1); PG8_SCHED; PG8_LDA(At, 0, 0); PG8_STAGE(PG8_SA(1, 1), a1 + hstep, voffA);
            PG8_WAIT_V(8); PG8_WAIT_L(0); PG8_BAR; PG8_MMA(0, 0, At, B0); PG8_MMA(0, 1, At, B1); PG8_BAR; PG8_SCHED;
            PG8_LDA(At, 0, 1); PG8_STAGE(PG8_SB(0, 0), b2, voffB); PG8_STAGE(PG8_SB(0, 1), b2 + hstep, voffB); PG8_STAGE(PG8_SA(0, 0), a2, voffA);
            PG8_WAIT_V(8); PG8_WAIT_L(0); PG8_BAR; PG8_MMA(1, 0, At, B0); PG8_MMA(1, 1, At, B1); PG8_BAR; PG8_SCHED;
            PG8_LDB(B0, 1, 0); PG8_LDB(B1, 1, 1); PG8_SCHED; PG8_LDA(At, 1, 0); PG8_STAGE(PG8_SA(0, 1), a2 + hstep, voffA);
            PG8_WAIT_V(8); PG8_WAIT_L(0); PG8_BAR; PG8_MMA(0, 0, At, B0); PG8_MMA(0, 1, At, B1); PG8_BAR; PG8_SCHED;
            PG8_LDA(At, 1, 1); PG8_STAGE(PG8_SB(1, 0), b3, voffB); PG8_STAGE(PG8_SB(1, 1), b3 + hstep, voffB); PG8_STAGE(PG8_SA(1, 0), a3, voffA);
            PG8_WAIT_V(8); PG8_WAIT_L(0); PG8_BAR; PG8_MMA(1, 0, At, B0); PG8_MMA(1, 1, At, B1); PG8_BAR; PG8_SCHED;
            } else {
            PG8_LDB(B0, 0, 0); PG8_SCHED; PG8_LDA(At, 0, 0); PG8_STAGE(PG8_SA(1, 1), a1 + hstep, voffA);
            PG8_WAIT_L(8); PG8_BAR; PG8_WAIT_L(0); PG8_MMA(0, 0, At, B0); PG8_BAR; PG8_SCHED;
            PG8_LDB(B1, 0, 1); PG8_STAGE(PG8_SB(0, 0), b2, voffB);
            PG8_BAR; PG8_WAIT_L(0); PG8_MMA(0, 1, At, B1); PG8_BAR;
            PG8_LDA(At, 0, 1); PG8_STAGE(PG8_SA(0, 0), a2, voffA);
            PG8_BAR; PG8_WAIT_L(0); PG8_MMA(1, 0, At, B0); PG8_BAR; PG8_SCHED;
            PG8_STAGE(PG8_SB(0, 1), b2 + hstep, voffB);
            PG8_WAIT_V(6); PG8_BAR; PG8_MMA(1, 1, At, B1); PG8_BAR;
            PG8_LDB(B0, 1, 0); PG8_SCHED; PG8_LDA(At, 1, 0); PG8_STAGE(PG8_SA(0, 1), a2 + hstep, voffA);
            PG8_WAIT_L(8); PG8_BAR; PG8_WAIT_L(0); PG8_MMA(0, 0, At, B0); PG8_BAR; PG8_SCHED;
            PG8_LDB(B1, 1, 1); PG8_STAGE(PG8_SB(1, 0), b3, voffB);
            PG8_BAR; PG8_WAIT_L(0); PG8_MMA(0, 1, At, B1); PG8_BAR;
            PG8_LDA(At, 1, 1); PG8_STAGE(PG8_SA(1, 0), a3, voffA);
            PG8_BAR; PG8_WAIT_L(0); PG8_MMA(1, 0, At, B0); PG8_BAR; PG8_SCHED;
            PG8_STAGE(PG8_SB(1, 1), b3 + hstep, voffB);
            PG8_WAIT_V(6); PG8_BAR; PG8_MMA(1, 1, At, B1); PG8_BAR;
            }
        }
        if constexpr (ALIGN_EPI) { if (wr == 0) PG8_BAR; }
        if constexpr (!Epi::AFTER_DRAIN) { E(acc, cur, wr, wc, fr, fq); S.done(cur); }
        if (!has_next) break;
#pragma unroll
        for (int a = 0; a < 2; ++a)
#pragma unroll
            for (int b = 0; b < 2; ++b)
#pragma unroll
                for (int m = 0; m < 4; ++m)
#pragma unroll
                    for (int n = 0; n < 2; ++n) acc[a][b][m][n] = (f32x4){0.f, 0.f, 0.f, 0.f};
        cur = nxt; cA = nA; cB = nB; ++ui;
        if constexpr (ALIGN_EPI) { if (wr == 1) PG8_BAR; }
    }
    PG8_WAIT_V(0);
    if constexpr (!ALIGN_EPI) { if (wr == 0) PG8_BAR; }
    PG8_BAR;
    if constexpr (Epi::AFTER_DRAIN) { E.fused(acc, cur, wr, wc, fr, fq, lds, wid, lane); S.done(cur); }
#undef PG8_SA
#undef PG8_SB
#undef PG8_STAGE
#undef PG8_LDA
#undef PG8_LDB
#undef PG8_MMA
#undef PG8_WAIT_V
#undef PG8_WAIT_L
#undef PG8_BAR
#undef PG8_SCHED
}
}
#include <hip/hip_bf16.h>
#include <cmath>
namespace attn_body {
using bf16=__hip_bfloat16;
using bf16x8=__attribute__((ext_vector_type(8)))short;
using s16x4=__attribute__((ext_vector_type(4)))short;
using f32x16=__attribute__((ext_vector_type(16)))float;
using u32x4=__attribute__((ext_vector_type(4)))unsigned;
constexpr int BATCH=4,NHEAD=8,SEQ=8192,D=64,DM=NHEAD*D;
constexpr int ODM=1024; constexpr int NW=8,QBLK=32,QB=QBLK*NW,KVBLK=64,NQB=SEQ/QB;
constexpr int ATTN_PITCH=DM, ATTN_UNIT_ROWS=QB;
__device__ __forceinline__ int crow(int r,int hi){return (r&3)+8*(r>>2)+4*hi;}
#define SBAR() __builtin_amdgcn_sched_barrier(0)
__device__ __forceinline__ void cmask(f32x16&p0,f32x16&p1,int jb,int qrel,int hi){
  const float NEG=-INFINITY; int kb=64*jb+4*hi;
  #pragma unroll
  for(int r=0;r<16;++r){int kv=kb+(r&3)+8*(r>>2); if(kv>qrel)p0[r]=NEG; if(kv+32>qrel)p1[r]=NEG;}
}

constexpr int NSLOT=3, SLOTB=8192;
constexpr int LDS_K=0, LDS_V=NSLOT*SLOTB, LDS_WS=2*NSLOT*SLOTB, LDS_OST=LDS_WS+NW*64*4, LDS_BYTES=LDS_OST+NW*4096;
constexpr float C2=0.125f*1.4426950408889634f; constexpr int LDS_KB=LDS_BYTES;
__device__ __forceinline__ void glds16(const void*gsrc,unsigned lds_dst){unsigned keep;
  asm volatile("s_mov_b32 %0, m0\n\ts_mov_b32 m0, %2\n\ts_nop 0\n\tglobal_load_lds_dwordx4 %1, off\n\ts_mov_b32 m0, %0":"=&s"(keep):"v"(gsrc),"s"(lds_dst):"memory");}
__device__ __forceinline__ float max3f(float a,float b,float c){float r;asm("v_max3_f32 %0, %1, %2, %3":"=v"(r):"v"(a),"v"(b),"v"(c));return r;}
__device__ __forceinline__ float max2f(float a,float b){float r;asm("v_max_f32_e32 %0, %1, %2":"=v"(r):"v"(a),"v"(b));return r;}
__device__ __forceinline__ float fadd_s(float a,float b){float r;asm("v_add_f32_e32 %0, %1, %2":"=v"(r):"v"(a),"v"(b));return r;}
__device__ __forceinline__ float fsub_s(float a,float b){float r;asm("v_sub_f32_e32 %0, %1, %2":"=v"(r):"v"(a),"v"(b));return r;}
typedef float f32x2_t __attribute__((ext_vector_type(2))); typedef __bf16 bf16x2_t __attribute__((ext_vector_type(2)));
__device__ __forceinline__ unsigned cvtpk_s(float lo,float hi){f32x2_t v={lo,hi};bf16x2_t b=__builtin_convertvector(v,bf16x2_t);return __builtin_bit_cast(unsigned,b);}
#define WAIT_BAR(N) asm volatile("s_waitcnt vmcnt(" #N ") lgkmcnt(0)\n\ts_barrier":::"memory")

__device__ __forceinline__ void qkt(f32x16&p0,f32x16&p1,const char*Kslot,const bf16x8*qr,const f32x16&negm,int r32,int hi){
  const char*kb=Kslot+hi*1024+r32*16;
  #pragma unroll
  for(int d0=0;d0<4;++d0){
    const bf16x8 b0=*reinterpret_cast<const bf16x8*>(kb+d0*2048);
    const bf16x8 b1=*reinterpret_cast<const bf16x8*>(kb+d0*2048+512);
    if(d0==0){p0=__builtin_amdgcn_mfma_f32_32x32x16_bf16(b0,qr[0],negm,0,0,0);p1=__builtin_amdgcn_mfma_f32_32x32x16_bf16(b1,qr[0],negm,0,0,0);}
    else{p0=__builtin_amdgcn_mfma_f32_32x32x16_bf16(b0,qr[d0],p0,0,0,0);p1=__builtin_amdgcn_mfma_f32_32x32x16_bf16(b1,qr[d0],p1,0,0,0);}}
}
__device__ __forceinline__ bf16x8 bias_frag(float v,int hi){
  const unsigned h=cvtpk_s(v,0.f)&0xffffu; const float r1=v-__uint_as_float(h<<16);
  const unsigned m=cvtpk_s(r1,0.f)&0xffffu; const float r2=r1-__uint_as_float(m<<16);
  const unsigned l=cvtpk_s(r2,0.f)&0xffffu;
  u32x4 w; w.x=hi?0u:(h|(m<<16)); w.y=hi?0u:l; w.z=0u; w.w=0u; return __builtin_bit_cast(bf16x8,w);
}
typedef __attribute__((address_space(3))) const char* lds_cptr;
typedef short v4i16_t __attribute__((ext_vector_type(4)));
__device__ __forceinline__ void kload8(bf16x8*kf,lds_cptr kp){
  kf[0]=*(const __attribute__((address_space(3))) bf16x8*)(kp);      kf[1]=*(const __attribute__((address_space(3))) bf16x8*)(kp+512);
  kf[2]=*(const __attribute__((address_space(3))) bf16x8*)(kp+2048); kf[3]=*(const __attribute__((address_space(3))) bf16x8*)(kp+2560);
  kf[4]=*(const __attribute__((address_space(3))) bf16x8*)(kp+4096); kf[5]=*(const __attribute__((address_space(3))) bf16x8*)(kp+4608);
  kf[6]=*(const __attribute__((address_space(3))) bf16x8*)(kp+6144); kf[7]=*(const __attribute__((address_space(3))) bf16x8*)(kp+6656);
}
__device__ __forceinline__ void kload2(bf16x8*kf,lds_cptr kp,int j){ kf[2*j]=*(const __attribute__((address_space(3))) bf16x8*)(kp+j*2048); kf[2*j+1]=*(const __attribute__((address_space(3))) bf16x8*)(kp+j*2048+512); }
__device__ __forceinline__ s16x4 vtr(lds_cptr p){ return __builtin_bit_cast(s16x4,__builtin_amdgcn_ds_read_tr16_b64_v4i16((__attribute__((address_space(3))) v4i16_t*)p)); }
__device__ __forceinline__ float rowmax(const f32x16&p0,const f32x16&p1){
  float a=max3f(p0[0],p0[1],p1[0]),b=max3f(p0[2],p0[3],p1[1]);a=max3f(a,p1[2],p1[3]);
  #pragma unroll
  for(int r=4;r<16;r+=4){a=max3f(a,p0[r],p0[r+1]);b=max3f(b,p0[r+2],p0[r+3]);a=max3f(a,p1[r],p1[r+1]);b=max3f(b,p1[r+2],p1[r+3]);}
  const float m=max2f(a,b);
  auto rr=__builtin_amdgcn_permlane32_swap(__float_as_uint(m),__float_as_uint(m),false,false);
  return max2f(__uint_as_float(rr[0]),__uint_as_float(rr[1]));
}
__device__ __forceinline__ void pv(f32x16*o,int vb,bf16x8 pa0,bf16x8 pa1,bf16x8 pa2,bf16x8 pa3){
  #pragma unroll
  for(int d0=0;d0<2;++d0){s16x4 lo[4],hi[4];
    #pragma unroll
    for(int ks=0;ks<4;++ks){
      asm volatile("ds_read_b64_tr_b16 %0,%1 offset:%c2":"=&v"(lo[ks]):"v"(vb),"i"(d0*4096+ks*1024):"memory");
      asm volatile("ds_read_b64_tr_b16 %0,%1 offset:%c2":"=&v"(hi[ks]):"v"(vb),"i"(d0*4096+ks*1024+512):"memory");}
    asm volatile("s_waitcnt lgkmcnt(0)":::"memory");SBAR();
    #define PK(k) (bf16x8){lo[k][0],lo[k][1],lo[k][2],lo[k][3],hi[k][0],hi[k][1],hi[k][2],hi[k][3]}
    o[d0]=__builtin_amdgcn_mfma_f32_32x32x16_bf16(pa0,PK(0),o[d0],0,0,0);
    o[d0]=__builtin_amdgcn_mfma_f32_32x32x16_bf16(pa1,PK(1),o[d0],0,0,0);
    o[d0]=__builtin_amdgcn_mfma_f32_32x32x16_bf16(pa2,PK(2),o[d0],0,0,0);
    o[d0]=__builtin_amdgcn_mfma_f32_32x32x16_bf16(pa3,PK(3),o[d0],0,0,0);
    #undef PK
  }
}

#ifndef ATTN_STORE16
#define ATTN_STORE16(p,v) (*(u32x4*)(p)=(v))
#endif
template<int THRL> __device__ __forceinline__ void attn_unit(int b,int h,int qb,const bf16*Q,const bf16*__restrict__ K,const bf16*__restrict__ V,bf16*O,const float*__restrict__ CUM,const float*NRM,char*shm,int wave_in){
  int tid_; { int ln_; asm volatile("v_mbcnt_lo_u32_b32 %0, -1, 0\n\tv_mbcnt_hi_u32_b32 %0, -1, %0" : "=v"(ln_)); tid_ = wave_in * 64 + ln_; }
  const int tid=tid_,lane=tid&63,r32=lane&31,hi=lane>>5; const int wid=__builtin_amdgcn_readfirstlane(tid>>6);
  const long rowbase=(long)b*SEQ; const int q0=qb*QB;
  const __attribute__((address_space(1))) float*cu=(const __attribute__((address_space(1))) float*)(CUM+((long)b*NHEAD+h)*SEQ); const float c0=cu[q0];
  int t0;
  { const __attribute__((address_space(1))) float*nrm=(const __attribute__((address_space(1))) float*)NRM; const int bh32=(b*NHEAD+h)*32;
    float kn=(lane<=qb)?nrm[1024+bh32+lane]:0.f;
    #pragma unroll
    for(int o=1;o<64;o<<=1)kn=__builtin_fmaxf(kn,lane_read(kn,lane^o));
    const float thr=-(2.f*nrm[bh32+qb]*kn+49.f);
    int cnt=0; for(int i=lane;i<(q0+QB)/KVBLK;i+=64)cnt+=((c0-cu[KVBLK*i+KVBLK-1])*1.4426950408889634f<thr)?1:0;
    #pragma unroll
    for(int o=1;o<64;o<<=1)cnt+=(int)lane_read_u((unsigned)cnt,lane^o);
    cnt&=~1; const int lim=(q0+QB)/KVBLK-4; t0=__builtin_amdgcn_readfirstlane(cnt<lim?cnt:lim); }
  const bf16*Qw=Q+(rowbase+q0+wid*QBLK)*DM+h*D;
  const bf16*Kh=K+(rowbase+(long)t0*KVBLK)*DM+h*D,*Vh=V+(rowbase+(long)t0*KVBLK)*DM+h*D;
  const unsigned lds0=(unsigned)(uintptr_t)shm;
  float*wsf=(float*)(shm+LDS_WS)+wid*64;
  const bf16*ksrc=Kh+(long)lane*DM+wid*8;
  const bf16*vsrc=Vh+(long)(16*(wid&3)+(lane>>2))*DM+(wid>>2)*32+(lane&3)*8;
  const unsigned kdst=lds0+LDS_K+wid*1024, vdst=lds0+LDS_V+wid*1024;
  #define DMA_K(t,slot) glds16(ksrc+(long)(t)*KVBLK*DM,(unsigned)__builtin_amdgcn_readfirstlane(kdst+(slot)))
  #define DMA_V(t,slot) glds16(vsrc+(long)(t)*KVBLK*DM,(unsigned)__builtin_amdgcn_readfirstlane(vdst+(slot)))
  const int vb0=(int)(lds0+LDS_V)+((lane>>4)&1)*32+(lane&3)*8+(4*hi+((lane&15)>>2))*64;
  const char*Kbase=shm+LDS_K; bf16x8 kf[8];
  const lds_cptr shm3=(lds_cptr)shm; const lds_cptr kp0=shm3+LDS_K+hi*1024+r32*16; const lds_cptr vp0=shm3+LDS_V+((lane>>4)&1)*32+(lane&3)*8+(4*hi+((lane&15)>>2))*64;
  const int NT=(q0+QB)/KVBLK-t0;
  float*kbl=(float*)(shm+LDS_KB);
  { const int sk=t0*KVBLK;
    for(int s=tid;s<q0+QB-sk;s+=NW*64)kbl[s]=(c0-cu[s+sk])*1.4426950408889634f;
    asm volatile("s_waitcnt vmcnt(0)":::"memory"); }
  const bf16x8 ones=__builtin_bit_cast(bf16x8,(u32x4){hi?0u:0x3f803f80u,hi?0u:0x00003f80u,0u,0u});
  DMA_K(0,0);DMA_V(0,0);DMA_K(1,SLOTB);
  bf16x8 qr[4];
  #pragma unroll
  for(int d0=0;d0<4;++d0)qr[d0]=*reinterpret_cast<const bf16x8*>(&Qw[(long)r32*DM+d0*16+hi*8]);
  float mhat=0.f,l_reg=0.f;f32x16 o[2];o[0]=f32x16{};o[1]=f32x16{};f32x16 negm=f32x16{};asm volatile("":"+v"(negm));
  const int qrel=wid*QBLK+r32;
  #define CMASK(P0,P1,t) do{int jb_=(t)-(NT-4); if(jb_>=0)cmask(P0,P1,jb_,qrel,hi);}while(0)
  bool resc=false;
  #define START(P0,P1) do{ const float rm=rowmax(P0,P1); resc=false; \
    { const float dl=__builtin_fmaxf(rm,0.f); mhat=fadd_s(mhat,dl); \
      _Pragma("unroll") for(int r=0;r<16;++r){P0[r]=fsub_s(P0[r],dl);P1[r]=fsub_s(P1[r],dl);} \
      _Pragma("unroll") for(int r=0;r<16;++r)negm[r]=-mhat; asm volatile("":"+v"(negm)); } \
    _Pragma("unroll") for(int r=0;r<16;++r)P0[r]=__builtin_amdgcn_exp2f(P0[r]); }while(0)
  #define RESC() do{ if(resc){ asm volatile("s_waitcnt lgkmcnt(0)":::"memory"); \
      _Pragma("unroll") for(int d_=0;d_<2;++d_) _Pragma("unroll") for(int r=0;r<16;++r)o[d_][r]*=wsf[crow(r,hi)]; } }while(0)
  f32x16 pA0,pA1,pB0,pB1;
  int sl_prev=0,sl_cur=0,sl_next=SLOTB;
  #define ROT() do{sl_prev=sl_cur;sl_cur=sl_next;sl_next=(sl_next==(NSLOT-1)*SLOTB)?0:sl_next+SLOTB;}while(0)
  DMA_K(2,2*SLOTB);
  WAIT_BAR(3);
  qkt(pA0,pA1,Kbase,qr,negm,r32,hi);
  pA0=__builtin_amdgcn_mfma_f32_32x32x16_bf16(bias_frag(kbl[r32],hi),ones,pA0,0,0,0);pA1=__builtin_amdgcn_mfma_f32_32x32x16_bf16(bias_frag(kbl[32+r32],hi),ones,pA1,0,0,0);
  asm volatile("s_nop 15\n\ts_nop 7":"+v"(pA0),"+v"(pA1));CMASK(pA0,pA1,0);
  START(pA0,pA1);
  _Pragma("unroll") for(int r=0;r<16;++r)pA1[r]=__builtin_amdgcn_exp2f(pA1[r]);
  WAIT_BAR(0);
  DMA_K(3,0);DMA_V(1,SLOTB);
  ROT();
  kload8(kf,kp0+sl_cur);
  WAIT_BAR(2);
  s16x4 vlo[8],vhi[8]; u32x4 pw0,pw1,pw2,pw3;
  #define PKW(P,B) cvtpk_s(P[B],P[B+1])
  #define PAF(k) __builtin_bit_cast(bf16x8,pw##k)
  #define VFR(i) (bf16x8){vlo[i][0],vlo[i][1],vlo[i][2],vlo[i][3],vhi[i][0],vhi[i][1],vhi[i][2],vhi[i][3]}
  #define PIN(x) asm volatile("":"+v"(x))
  #define MX3(a,b,c) __builtin_fmaxf(__builtin_fmaxf((a),(b)),(c))
  #define GAPA(MF,A0,A1,A2,A3,W0,W1,PW) do{ MF; sacc+=A0; sacc+=A1; sacc+=A2; sacc+=A3; PIN(sacc); W0; W1; PIN(PW); SBAR(); }while(0)
  #define EX(v) __builtin_amdgcn_exp2f(v)
  #define GAPB(MF,X,B) do{ MF; X[B]=EX(X[B]); X[B+1]=EX(X[B+1]); X[B+2]=EX(X[B+2]); X[B+3]=EX(X[B+3]); PIN(X); SBAR(); }while(0)
  #define VRD(i) do{ vlo[i]=vtr(vp_+(((i)>>2)*4096+((i)&3)*1024)); vhi[i]=vtr(vp_+(((i)>>2)*4096+((i)&3)*1024+512)); }while(0)
  #define KRD(G,j) do{ if(G){ kload2(kf,kp0+sl_next,j); SBAR(); } }while(0)
  #define STEP(C0,C1,P0,P1,t,GK,GV,GL) do{ SBAR(); \
    const lds_cptr vp_=vp0+sl_prev; \
    const bf16x8 kbf0_=bias_frag(kbl[(t)*KVBLK+r32],hi), kbf1_=bias_frag(kbl[(t)*KVBLK+32+r32],hi); \
    VRD(0); SBAR(); float sacc=(P0[0]+P0[1]); \
    GAPA(C0=__builtin_amdgcn_mfma_f32_32x32x16_bf16(kf[0],qr[0],negm,0,0,0), P0[2],P0[3],P0[4],P0[5],     pw0[0]=PKW(P0,0), pw0[1]=PKW(P0,2), pw0); \
    VRD(4); SBAR(); GAPA(C1=__builtin_amdgcn_mfma_f32_32x32x16_bf16(kf[1],qr[0],negm,0,0,0), P0[6],P0[7],P0[8],P0[9],     pw0[2]=PKW(P0,4), pw0[3]=PKW(P0,6), pw0); \
    VRD(1); SBAR(); GAPA(C0=__builtin_amdgcn_mfma_f32_32x32x16_bf16(kf[2],qr[1],C0,0,0,0),   P0[10],P0[11],P0[12],P0[13], pw1[0]=PKW(P0,8), pw1[1]=PKW(P0,10), pw1); \
    VRD(5); SBAR(); GAPA(C1=__builtin_amdgcn_mfma_f32_32x32x16_bf16(kf[3],qr[1],C1,0,0,0),   P0[14],P0[15],P1[0],P1[1],   pw1[2]=PKW(P0,12),pw1[3]=PKW(P0,14), pw1); \
    VRD(2); SBAR(); GAPA(C0=__builtin_amdgcn_mfma_f32_32x32x16_bf16(kf[4],qr[2],C0,0,0,0),   P1[2],P1[3],P1[4],P1[5],     pw2[0]=PKW(P1,0), pw2[1]=PKW(P1,2), pw2); \
    VRD(6); SBAR(); GAPA(C1=__builtin_amdgcn_mfma_f32_32x32x16_bf16(kf[5],qr[2],C1,0,0,0),   P1[6],P1[7],P1[8],P1[9],     pw2[2]=PKW(P1,4), pw2[3]=PKW(P1,6), pw2); \
    VRD(3); SBAR(); GAPA(C0=__builtin_amdgcn_mfma_f32_32x32x16_bf16(kf[6],qr[3],C0,0,0,0),   P1[10],P1[11],P1[12],P1[13], pw3[0]=PKW(P1,8), pw3[1]=PKW(P1,10), pw3); \
    VRD(7); SBAR(); GAPA(C1=__builtin_amdgcn_mfma_f32_32x32x16_bf16(kf[7],qr[3],C1,0,0,0),   P1[14],P1[15],0.f,0.f,       pw3[2]=PKW(P1,12),pw3[3]=PKW(P1,14), pw3); \
    C0=__builtin_amdgcn_mfma_f32_32x32x16_bf16(kbf0_,ones,C0,0,0,0); C1=__builtin_amdgcn_mfma_f32_32x32x16_bf16(kbf1_,ones,C1,0,0,0); \
    l_reg+=sacc; \
    if(GK){DMA_K((t)+3,sl_cur);} if(GV){DMA_V((t)+1,sl_next);} \
    CMASK(C0,C1,t); \
    { float a=MX3(C0[0],C0[1],C1[0]),b=MX3(C0[2],C0[3],C1[1]); a=MX3(a,C1[2],C1[3]); \
      _Pragma("unroll") for(int r=4;r<16;r+=4){a=MX3(a,C0[r],C0[r+1]);b=MX3(b,C0[r+2],C0[r+3]);a=MX3(a,C1[r],C1[r+1]);b=MX3(b,C1[r+2],C1[r+3]);} \
      float rm=__builtin_fmaxf(a,b); { auto rr=__builtin_amdgcn_permlane32_swap(__float_as_uint(rm),__float_as_uint(rm),false,false); rm=__builtin_fmaxf(__uint_as_float(rr[0]),__uint_as_float(rr[1])); } \
      resc=false; \
      if(__builtin_expect(__any(rm>(float)THRL),0)){ const float dl=__builtin_fmaxf(rm,0.f); mhat+=dl; \
        _Pragma("unroll") for(int r=0;r<16;++r){C0[r]-=dl;C1[r]-=dl;} \
        _Pragma("unroll") for(int r=0;r<16;++r)negm[r]=-mhat; asm volatile("":"+v"(negm)); \
        const float f=__builtin_amdgcn_exp2f(-dl); l_reg*=f; if(hi==0)wsf[r32]=f; resc=true; } } \
    SBAR(); \
    GAPB(o[0]=__builtin_amdgcn_mfma_f32_32x32x16_bf16(PAF(0),VFR(0),o[0],0,0,0), C0,0); \
    GAPB(o[1]=__builtin_amdgcn_mfma_f32_32x32x16_bf16(PAF(0),VFR(4),o[1],0,0,0), C0,4); \
    KRD(GL,0); GAPB(o[0]=__builtin_amdgcn_mfma_f32_32x32x16_bf16(PAF(1),VFR(1),o[0],0,0,0), C0,8); \
    KRD(GL,1); GAPB(o[1]=__builtin_amdgcn_mfma_f32_32x32x16_bf16(PAF(1),VFR(5),o[1],0,0,0), C0,12); \
    KRD(GL,2); GAPB(o[0]=__builtin_amdgcn_mfma_f32_32x32x16_bf16(PAF(2),VFR(2),o[0],0,0,0), C1,0); \
    KRD(GL,3); GAPB(o[1]=__builtin_amdgcn_mfma_f32_32x32x16_bf16(PAF(2),VFR(6),o[1],0,0,0), C1,4); \
    GAPB(o[0]=__builtin_amdgcn_mfma_f32_32x32x16_bf16(PAF(3),VFR(3),o[0],0,0,0), C1,8); \
    GAPB(o[1]=__builtin_amdgcn_mfma_f32_32x32x16_bf16(PAF(3),VFR(7),o[1],0,0,0), C1,12); \
    }while(0)
  int t=1;
  #undef CMASK
  #define CMASK(P0,P1,t) do{}while(0)
  for(;t+5<NT;t+=2){
    STEP(pB0,pB1,pA0,pA1,t,true,true,true);     WAIT_BAR(2); RESC(); ROT();
    STEP(pA0,pA1,pB0,pB1,t+1,true,true,true);   WAIT_BAR(2); RESC(); ROT();
  }
  #undef CMASK
  #define CMASK(P0,P1,t) do{int jb_=(t)-(NT-4); if(jb_>=0)cmask(P0,P1,jb_,qrel,hi);}while(0)
  #define ENDW(tt) do{ if((tt)+3<NT){WAIT_BAR(2);} else if((tt)+2<NT){WAIT_BAR(1);} else {WAIT_BAR(0);} }while(0)
  for(;t+1<NT;t+=2){
    STEP(pB0,pB1,pA0,pA1,t,(t+3<NT),(t+1<NT),(t+1<NT));       ENDW(t);   RESC(); ROT();
    STEP(pA0,pA1,pB0,pB1,t+1,(t+4<NT),(t+2<NT),(t+2<NT));     ENDW(t+1); RESC(); ROT();
  }
  STEP(pB0,pB1,pA0,pA1,NT-1,false,false,false); RESC();
  { float sacc=pB0[0]+pB0[1]; _Pragma("unroll") for(int r=2;r<16;++r)sacc+=pB0[r]; _Pragma("unroll") for(int r=0;r<16;++r)sacc+=pB1[r]; l_reg+=sacc;
    pw0=(u32x4){PKW(pB0,0),PKW(pB0,2),PKW(pB0,4),PKW(pB0,6)};pw1=(u32x4){PKW(pB0,8),PKW(pB0,10),PKW(pB0,12),PKW(pB0,14)};pw2=(u32x4){PKW(pB1,0),PKW(pB1,2),PKW(pB1,4),PKW(pB1,6)};pw3=(u32x4){PKW(pB1,8),PKW(pB1,10),PKW(pB1,12),PKW(pB1,14)};
    SBAR(); pv(o,vb0+sl_cur,PAF(0),PAF(1),PAF(2),PAF(3)); }
  #undef PKW
  #undef PAF
  #undef VFR
  #undef PIN
  #undef MX3
  #undef GAPA
  #undef GAPB
  #undef EX
  #undef VRD
  #undef KRD
  #undef STEP
  #undef ENDW
  {auto rr=__builtin_amdgcn_permlane32_swap(__float_as_uint(l_reg),__float_as_uint(l_reg),false,false);l_reg=__uint_as_float(rr[0])+__uint_as_float(rr[1]);}
  if(hi==0)wsf[32+r32]=l_reg;asm volatile("s_waitcnt lgkmcnt(0)":::"memory");
  float rli[16];
  #pragma unroll
  for(int r=0;r<16;++r)rli[r]=__builtin_amdgcn_rcpf(wsf[32+crow(r,hi)]);
  bf16*Ow=O+(rowbase+q0+wid*QBLK)*ODM+h*D;
  { bf16*stg=(bf16*)(shm+LDS_OST)+wid*2048;
    #pragma unroll
    for(int r=0;r<16;++r){const int orow=crow(r,hi);
      #pragma unroll
      for(int d0=0;d0<2;++d0)stg[orow*64+d0*32+r32]=__float2bfloat16(o[d0][r]*rli[r]);}
    asm volatile("s_waitcnt lgkmcnt(0)":::"memory");
    #pragma unroll
    for(int i=0;i<4;++i){const int row=i*8+(lane>>3),ch=lane&7; const u32x4 v=*(const u32x4*)(stg+row*64+ch*8); ATTN_STORE16(Ow+(long)row*ODM+ch*8,v);} }
  asm volatile("s_waitcnt lgkmcnt(0)\n\ts_barrier":::"memory");
  #undef DMA_K
  #undef DMA_V
  #undef CMASK
  #undef START
  #undef RESC
  #undef ROT
}
constexpr int ATTN_LDS_BYTES=LDS_BYTES+SEQ*4;
struct AttnTensors { const bf16* Q; const bf16* K; const bf16* V; bf16* O; const float* CUM; const float* NRM; };
struct AttnUnit { int bh; int qb; };
struct StaticOrder {
  int vcu;
  __device__ __forceinline__ explicit StaticOrder(int grid,int block):vcu((block%8)*(grid/8)+block/8){}
  __device__ __forceinline__ bool next(int i,AttnUnit&u)const{ if(i>=4)return false; const int s=vcu&7; u.bh=vcu>>3; u.qb=(i==0)?s:(i==1)?15-s:(i==2)?16+s:31-s; return true; }
  __device__ __forceinline__ void a_ready(const AttnUnit&)const{}
  __device__ __forceinline__ void done(const AttnUnit&)const{}
};
template<class Sched,int THRL=8> __device__ __forceinline__ void attn_phase(char*lds,const AttnTensors&T,const Sched&S,int wave_in){
  AttnUnit u;
  for(int i=0;S.next(i,u);++i){ S.a_ready(u); attn_unit<THRL>(u.bh/NHEAD,u.bh%NHEAD,u.qb,T.Q,T.K,T.V,T.O,T.CUM,T.NRM,lds,wave_in); S.done(u); }
}
#undef SBAR
#undef WAIT_BAR
}
namespace dsa {
typedef __attribute__((address_space(3))) unsigned char* ldsp;
typedef float f32x16 __attribute__((ext_vector_type(16)));
typedef float f32x4 __attribute__((ext_vector_type(4)));
typedef short bf16x8 __attribute__((ext_vector_type(8)));
typedef short s16x4 __attribute__((ext_vector_type(4)));
typedef unsigned u32x4 __attribute__((ext_vector_type(4)));
typedef unsigned u32x2 __attribute__((ext_vector_type(2)));
typedef unsigned short bf16;
#define DLAS __attribute__((address_space(3)))
#define DGAS __attribute__((address_space(1)))
constexpr int NBIN = 512, CAP2 = 192, TOPK = 256;
constexpr int L_LBK = 64 * CAP2 * 4;
constexpr int L_HIST = 0;
constexpr int L_LISTA = 73728;
constexpr int L_CNTA = L_LISTA + 32768, L_CNTB = L_CNTA + 256, L_THR = L_CNTB + 256, L_R = L_THR + 256, L_NSEL = L_R + 256, L_LSUM = L_NSEL + 256, L_POOLC = L_LSUM + 512, L_CNTA1 = L_POOLC + 16, L_KW = L_CNTA1 + 256, L_END = L_KW + 8 * CAP2 * 4;
constexpr int STASH_B = 16, STASH_A = 12;
constexpr int POOLCAP = 8192;
constexpr int VST = 144;
static_assert(8 * 64 * VST <= L_LISTA && 64 * CAP2 * 6 <= L_LISTA && 64 * NBIN * 2 <= L_LISTA && L_END <= 131072, "dsa LDS map");

__device__ __forceinline__ unsigned wave_incl_prefix(unsigned x) {
    x += (unsigned)__builtin_amdgcn_update_dpp(0, (int)x, 0x111, 0xf, 0xf, true);
    x += (unsigned)__builtin_amdgcn_update_dpp(0, (int)x, 0x112, 0xf, 0xf, true);
    x += (unsigned)__builtin_amdgcn_update_dpp(0, (int)x, 0x114, 0xf, 0xf, true);
    x += (unsigned)__builtin_amdgcn_update_dpp(0, (int)x, 0x118, 0xf, 0xf, true);
    x += (unsigned)__builtin_amdgcn_update_dpp(0, (int)x, 0x142, 0xa, 0xf, false);
    x += (unsigned)__builtin_amdgcn_update_dpp(0, (int)x, 0x143, 0xc, 0xf, false);
    return x;
}
__device__ __forceinline__ int score_bin(float s, int e0) {
    const unsigned u = __float_as_uint(s);
    int rel = (int)((u >> 19) & 0xFFFu) - e0; rel = rel < 0 ? 0 : (rel > 255 ? 255 : rel);
    return ((int)u < 0) ? 255 - rel : 256 + rel;
}
__device__ __forceinline__ float fmac_s(float a, float b, float acc) { asm("v_fmac_f32_e32 %0, %1, %2" : "+v"(acc) : "v"(a), "v"(b)); return acc; }
__device__ __forceinline__ float bin_edge(int b, int e0) {
    if (b >= 257) { const int r = b - 256; if (r > 255) return INFINITY; int E = e0 + r; if (E <= 0) return 0.f; if (E > 0xFF0) E = 0xFF0; return __uint_as_float((unsigned)E << 19); }
    if (b == 256) return 0.f;
    const int rp = 255 - b; if (rp >= 255) return -INFINITY;
    const int E = e0 + rp + 1; if (E <= 0) return 0.f; if (E > 0xFF0) return -3.402823466e38f;
    return __uint_as_float(0x80000000u | (((unsigned)E << 19) - 1u));
}
#define DSA_MF "v_mfma_f32_16x16x32_bf16 "
__device__ __forceinline__ void tile_open(f32x4& sc0, f32x4& sc1, f32x4& a0, f32x4& a1, const bf16x8 (&kf)[2][2], const bf16x8 (&ql)[2], const bf16x8 (&q0)[2]) {
    asm volatile(DSA_MF "%0, %4, %8, 0\n\t" DSA_MF "%1, %6, %8, 0\n\t" DSA_MF "%0, %5, %9, %0\n\t" DSA_MF "%1, %7, %9, %1\n\t"
                 DSA_MF "%2, %4, %10, 0\n\t" DSA_MF "%3, %6, %10, 0\n\t" DSA_MF "%2, %5, %11, %2\n\t" DSA_MF "%3, %7, %11, %3"
                 : "=&v"(sc0), "=&v"(sc1), "=&v"(a0), "=&v"(a1)
                 : "v"(kf[0][0]), "v"(kf[0][1]), "v"(kf[1][0]), "v"(kf[1][1]), "v"(ql[0]), "v"(ql[1]), "v"(q0[0]), "v"(q0[1]));
}
template <bool FIRST>
__device__ __forceinline__ void head_step(f32x4& b0, f32x4& b1, f32x4& sc0, f32x4& sc1, const f32x4& a0, const f32x4& a1, float wh, const bf16x8 (&kf)[2][2], const bf16x8 (&qn)[2]) {
#define DSA_HS(NOP) asm volatile(DSA_MF "%0, %19, %23, 0\n\t" DSA_MF "%1, %21, %23, 0\n\t" NOP \
                 "v_fma_f32 %2, |%10|, %18, %2\n\tv_fma_f32 %3, |%11|, %18, %3\n\t" DSA_MF "%0, %20, %24, %0\n\t" \
                 "v_fma_f32 %4, |%12|, %18, %4\n\tv_fma_f32 %5, |%13|, %18, %5\n\t" DSA_MF "%1, %22, %24, %1\n\t" \
                 "v_fma_f32 %6, |%14|, %18, %6\n\tv_fma_f32 %7, |%15|, %18, %7\n\tv_fma_f32 %8, |%16|, %18, %8\n\tv_fma_f32 %9, |%17|, %18, %9" \
                 : "=&v"(b0), "=&v"(b1), "+v"(sc0[0]), "+v"(sc0[1]), "+v"(sc0[2]), "+v"(sc0[3]), "+v"(sc1[0]), "+v"(sc1[1]), "+v"(sc1[2]), "+v"(sc1[3]) \
                 : "v"(a0[0]), "v"(a0[1]), "v"(a0[2]), "v"(a0[3]), "v"(a1[0]), "v"(a1[1]), "v"(a1[2]), "v"(a1[3]), "v"(wh), \
                   "v"(kf[0][0]), "v"(kf[0][1]), "v"(kf[1][0]), "v"(kf[1][1]), "v"(qn[0]), "v"(qn[1]))
    if (FIRST) DSA_HS("s_nop 3\n\t"); else DSA_HS("");
#undef DSA_HS
}
__device__ __forceinline__ void abs_fma8(f32x4& s0, f32x4& s1, const f32x4& a0, const f32x4& a1, float wh) {
    asm volatile("s_nop 1\n\tv_fma_f32 %0, |%8|, %16, %0\n\tv_fma_f32 %1, |%9|, %16, %1\n\tv_fma_f32 %2, |%10|, %16, %2\n\tv_fma_f32 %3, |%11|, %16, %3\n\t"
                 "v_fma_f32 %4, |%12|, %16, %4\n\tv_fma_f32 %5, |%13|, %16, %5\n\tv_fma_f32 %6, |%14|, %16, %6\n\tv_fma_f32 %7, |%15|, %16, %7"
                 : "+v"(s0[0]), "+v"(s0[1]), "+v"(s0[2]), "+v"(s0[3]), "+v"(s1[0]), "+v"(s1[1]), "+v"(s1[2]), "+v"(s1[3])
                 : "v"(a0[0]), "v"(a0[1]), "v"(a0[2]), "v"(a0[3]), "v"(a1[0]), "v"(a1[1]), "v"(a1[2]), "v"(a1[3]), "v"(wh));
}
__device__ __forceinline__ float relu_i(float x) { const int b = __builtin_bit_cast(int, x); return __builtin_bit_cast(float, b > 0 ? b : 0); }
__device__ __forceinline__ bool ahead(float sj, unsigned ij, float si, unsigned ii) { return sj > si || (sj == si && ij < ii); }

template <bool PASS2>
__device__ __forceinline__ void score_consume(ldsp L, DGAS u32x2* pool, const f32x4& sc0, const f32x4& sc1, int j, int qloc, int g, int e0, float tauA, float tauB) {
    if (!PASS2) {
#pragma unroll
        for (int k = 0; k < 8; ++k) { const unsigned u = __float_as_uint((k >> 2) ? sc1[k & 3] : sc0[k & 3]);
            int rel = (int)((u >> 19) & 0xFFFu) - e0; rel = rel < 0 ? 0 : (rel > 255 ? 255 : rel);
            __hip_atomic_fetch_add((DLAS unsigned*)(L + L_HIST + qloc * (NBIN * 2)) + rel, (int)u < 0 ? 0x10000u : 1u, __ATOMIC_RELAXED, __HIP_MEMORY_SCOPE_WORKGROUP); }
    }
}
struct Pend { unsigned mA, mB, pa, pb; int j; f32x4 s0, s1; };
__device__ __forceinline__ void pend_issue(ldsp L, Pend& P, const f32x4& sc0, const f32x4& sc1, int j, int qloc, float tauA, float tauB) {
    unsigned mA = 0u, mB = 0u;
#pragma unroll
    for (int k = 0; k < 8; ++k) { const float x = (k >> 2) ? sc1[k & 3] : sc0[k & 3]; mA |= (x >= tauA) ? (1u << k) : 0u; mB |= (x >= tauB && !(x >= tauA)) ? (1u << k) : 0u; }
    const bool up = (j & 1) == 0;
    P.pa = __hip_atomic_fetch_add((DLAS unsigned*)(L + (up ? L_CNTA : L_CNTA1)) + qloc, (unsigned)__builtin_popcount(mA), __ATOMIC_RELAXED, __HIP_MEMORY_SCOPE_WORKGROUP);
    P.pb = __hip_atomic_fetch_add((DLAS unsigned*)(L + L_CNTB) + qloc, (unsigned)__builtin_popcount(mB), __ATOMIC_RELAXED, __HIP_MEMORY_SCOPE_WORKGROUP);
    P.mA = mA; P.mB = mB; P.j = j; P.s0 = sc0; P.s1 = sc1;
}
__device__ __forceinline__ void pend_finish(ldsp L, DGAS u32x2* pool, Pend& P, int qloc, int g) {
    const bool up = (P.j & 1) == 0;
    unsigned pa = P.pa, pb = P.pb;
    const unsigned kbase = (unsigned)(32 * P.j + 4 * g);
    {
        DLAS unsigned short* la = (DLAS unsigned short*)(L + L_LISTA) + qloc * TOPK;
        for (unsigned m = P.mA; m; m &= m - 1u) { const unsigned k = (unsigned)__builtin_ctz(m);
            if (pa < (unsigned)TOPK) la[up ? pa : (unsigned)(TOPK - 1) - pa] = (unsigned short)(kbase + 4u * (k & 4u) + (k & 3u)); ++pa; }
    }
    {
        DLAS float* lbs = (DLAS float*)(L + L_HIST) + qloc * CAP2; DLAS unsigned short* lbk = (DLAS unsigned short*)(L + L_LBK) + qloc * CAP2;
        for (unsigned m = P.mB; m; m &= m - 1u) { const unsigned k = (unsigned)__builtin_ctz(m);
            const f32x4 v = (k & 4u) ? P.s1 : P.s0; const float xs = (k & 2u) ? ((k & 1u) ? v[3] : v[2]) : ((k & 1u) ? v[1] : v[0]); const unsigned key = kbase + 4u * (k & 4u) + (k & 3u);
            if (pb < (unsigned)CAP2) { lbs[pb] = xs; lbk[pb] = (unsigned short)key; }
            else { const unsigned gp = __hip_atomic_fetch_add((DLAS unsigned*)(L + L_POOLC), 1u, __ATOMIC_RELAXED, __HIP_MEMORY_SCOPE_WORKGROUP); if (gp < (unsigned)POOLCAP) pool[gp] = (u32x2){__float_as_uint(xs), ((unsigned)qloc << 16) | key}; }
            ++pb; }
    }
    P.mA = 0u; P.mB = 0u;
}
template <bool PASS2>
__device__ __forceinline__ void score_tile(ldsp L, DGAS u32x2* pool, const bf16x8 (&kf)[2][2], int j, int qloc, int g, const bf16x8 (&qf)[8][2], const bf16x8 (&ql)[2], const float (&w)[8], int e0, float tauA, float tauB, __amdgpu_buffer_rsrc_t rsS, int so, int lane, Pend& P) {
    f32x4 sc0, sc1, a0, a1, b0, b1;
    tile_open(sc0, sc1, a0, a1, kf, ql, qf[0]);
    head_step<true>(b0, b1, sc0, sc1, a0, a1, w[0], kf, qf[1]);
    head_step<false>(a0, a1, sc0, sc1, b0, b1, w[1], kf, qf[2]);
    head_step<false>(b0, b1, sc0, sc1, a0, a1, w[2], kf, qf[3]);
    head_step<false>(a0, a1, sc0, sc1, b0, b1, w[3], kf, qf[4]);
    head_step<false>(b0, b1, sc0, sc1, a0, a1, w[4], kf, qf[5]);
    head_step<false>(a0, a1, sc0, sc1, b0, b1, w[5], kf, qf[6]);
    head_step<false>(b0, b1, sc0, sc1, a0, a1, w[6], kf, qf[7]);
    abs_fma8(sc0, sc1, b0, b1, w[7]);
    if (!PASS2) { if (so >= 0) { __builtin_amdgcn_raw_buffer_store_b128(__builtin_bit_cast(u32x4, sc0), rsS, lane * 16, so, 16); __builtin_amdgcn_raw_buffer_store_b128(__builtin_bit_cast(u32x4, sc1), rsS, 1024 + lane * 16, so, 16); } }
    if (PASS2) { pend_finish(L, pool, P, qloc, g); pend_issue(L, P, sc0, sc1, j, qloc, tauA, tauB); }
    else score_consume<false>(L, pool, sc0, sc1, j, qloc, g, e0, tauA, tauB);
}
template <bool PASS2>
__device__ __forceinline__ void score_pass(ldsp L, DGAS u32x2* pool, const DGAS bf16* KIb, int NT, int kh, int qloc, int n16, int g, const bf16x8 (&qf)[8][2], const bf16x8 (&ql)[2], const float (&w)[8], int e0, float tauA, float tauB, DGAS f32x4* stB, DGAS f32x4* stA, int lane) {
    const int nIt = (NT - kh + 1) >> 1;
    const int nS = stB ? (nIt < STASH_B + STASH_A ? nIt : STASH_B + STASH_A) : 0;
    const __amdgpu_buffer_rsrc_t rsB = __builtin_amdgcn_make_buffer_rsrc((void*)stB, (short)0, STASH_B * 2048, 0x00020000), rsA = __builtin_amdgcn_make_buffer_rsrc((void*)stA, (short)0, STASH_A * 2048, 0x00020000);
#define DSA_SRS(I) ((I) < STASH_B ? rsB : rsA)
#define DSA_SOF(I) ((I) < nS ? ((I) < STASH_B ? (I) * 2048 : ((I) - STASH_B) * 2048) : -1)
    const __amdgpu_buffer_rsrc_t rsK = __builtin_amdgcn_make_buffer_rsrc((void*)KIb, (short)0, 8192 * 64 * 2, 0x00020000); const int voff = (n16 * 64 + 8 * g) * 2 + kh * (32 * 64 * 2);
    bf16x8 k0[2][2], k1[2][2], k2[2][2];
    const f32x4 zp4 = {0.f, 0.f, 0.f, 0.f}; Pend P{0u, 0u, 0u, 0u, 0, zp4, zp4};
#define DSA_LOADK(KF, IT) do { const int it_ = (IT) < nIt ? (IT) : nIt - 1; const int so_ = it_ * (64 * 64 * 2); \
        _Pragma("unroll") for (int t = 0; t < 2; ++t) _Pragma("unroll") for (int ks = 0; ks < 2; ++ks) KF[t][ks] = __builtin_bit_cast(bf16x8, __builtin_amdgcn_raw_buffer_load_b128(rsK, voff + (t * 16 * 64 + 32 * ks) * 2, so_, 0)); asm volatile("" ::: "memory"); } while (0)
    int it = 0;
    if (PASS2) {
        if (nS > 0) {
#define DSA_LDG(X, BASE) do { _Pragma("unroll") for (int t = 0; t < 4; ++t) { const int i_ = (BASE) + t < nS ? (BASE) + t : nS - 1; \
                if (i_ < STASH_B) { X[t][0] = __builtin_bit_cast(f32x4, __builtin_amdgcn_raw_buffer_load_b128(rsB, lane * 16, i_ * 2048, 16)); X[t][1] = __builtin_bit_cast(f32x4, __builtin_amdgcn_raw_buffer_load_b128(rsB, 1024 + lane * 16, i_ * 2048, 16)); } \
                else { X[t][0] = __builtin_bit_cast(f32x4, __builtin_amdgcn_raw_buffer_load_b128(rsA, lane * 16, (i_ - STASH_B) * 2048, 16)); X[t][1] = __builtin_bit_cast(f32x4, __builtin_amdgcn_raw_buffer_load_b128(rsA, 1024 + lane * 16, (i_ - STASH_B) * 2048, 16)); } } } while (0)
#define DSA_CSG(X, BASE) do { _Pragma("unroll") for (int t = 0; t < 4; ++t) if ((BASE) + t < nS) { pend_finish(L, pool, P, qloc, g); pend_issue(L, P, X[t][0], X[t][1], kh + 2 * ((BASE) + t), qloc, tauA, tauB); } } while (0)
            f32x4 ga[4][2], gb[4][2];
            DSA_LDG(ga, 0);
            for (int b8 = 0; b8 < nS; b8 += 8) {
                DSA_LDG(gb, b8 + 4); DSA_CSG(ga, b8);
                DSA_LDG(ga, b8 + 8); DSA_CSG(gb, b8 + 4);
            }
#undef DSA_LDG
#undef DSA_CSG
            it = nS;
        }
    }
    DSA_LOADK(k0, it); DSA_LOADK(k1, it + 1);
    for (; it + 3 <= nIt; it += 3) {
        DSA_LOADK(k2, it + 2); score_tile<PASS2>(L, pool, k0, kh + 2 * it, qloc, g, qf, ql, w, e0, tauA, tauB, DSA_SRS(it), PASS2 ? -1 : DSA_SOF(it), lane, P);
        DSA_LOADK(k0, it + 3); score_tile<PASS2>(L, pool, k1, kh + 2 * it + 2, qloc, g, qf, ql, w, e0, tauA, tauB, DSA_SRS(it + 1), PASS2 ? -1 : DSA_SOF(it + 1), lane, P);
        DSA_LOADK(k1, it + 4); score_tile<PASS2>(L, pool, k2, kh + 2 * it + 4, qloc, g, qf, ql, w, e0, tauA, tauB, DSA_SRS(it + 2), PASS2 ? -1 : DSA_SOF(it + 2), lane, P);
    }
    if (it < nIt) {
        score_tile<PASS2>(L, pool, k0, kh + 2 * it, qloc, g, qf, ql, w, e0, tauA, tauB, DSA_SRS(it), PASS2 ? -1 : DSA_SOF(it), lane, P);
        if (it + 1 < nIt) score_tile<PASS2>(L, pool, k1, kh + 2 * it + 2, qloc, g, qf, ql, w, e0, tauA, tauB, DSA_SRS(it + 1), PASS2 ? -1 : DSA_SOF(it + 1), lane, P);
    }
    if (PASS2) pend_finish(L, pool, P, qloc, g);
#undef DSA_LOADK
#undef DSA_SRS
#undef DSA_SOF
}

struct Tensors { const DGAS bf16* QI; const DGAS bf16* KI; const DGAS float* WI; const DGAS bf16* QA; const DGAS bf16* KA; const DGAS bf16* VA; DGAS bf16* OA; const DGAS float* KMAX; };

__device__ __forceinline__ void unit(ldsp L, unsigned char* wsb, unsigned char* ob, int b, int c, int wave_in) {
    asm volatile("" : "+s"(wsb), "+s"(ob));
    const Tensors T{(const DGAS bf16*)(wsb + WS_QI), (const DGAS bf16*)(wsb + WS_KI), (const DGAS float*)(wsb + WS_WI), (const DGAS bf16*)(wsb + WS_QA), (const DGAS bf16*)(wsb + WS_KA), (const DGAS bf16*)(wsb + WS_VA), (DGAS bf16*)ob, (const DGAS float*)(wsb + WS_CUM + MiB)};
    int tid_; { int ln_; asm volatile("v_mbcnt_lo_u32_b32 %0, -1, 0\n\tv_mbcnt_hi_u32_b32 %0, -1, %0" : "=v"(ln_)); tid_ = wave_in * 64 + ln_; }
    const int tid = tid_, lane = tid & 63, wave = __builtin_amdgcn_readfirstlane(tid >> 6);
    const int N = 64 * (c + 1), t0 = 64 * c;
    DGAS u32x2* const pool = (DGAS u32x2*)(wsb + WS_H) + (size_t)blockIdx.x * POOLCAP;
    const bool stash_ok = gridDim.x <= 256;
    DGAS f32x4* const stB = stash_ok ? (DGAS f32x4*)(ob + 64 * MiB + ((size_t)blockIdx.x * 8 + wave) * (STASH_B * 2048)) : (DGAS f32x4*)nullptr;
    DGAS f32x4* const stA = (DGAS f32x4*)(wsb + WS_H + 16 * MiB + ((size_t)blockIdx.x * 8 + wave) * (STASH_A * 2048));
    const size_t rowb = (size_t)b * 8192;
#ifndef REP_DSA_IDX
#define REP_DSA_IDX 1
#endif
#ifndef REP_DSA_ATT
#define REP_DSA_ATT 1
#endif
    for (int rep_i = 0; rep_i < REP_DSA_IDX; ++rep_i) {
    for (int i = tid; i < 64 * 6; i += 512) ((DLAS unsigned*)(L + L_CNTA))[i] = 0u;
    if (tid == 0) *(DLAS unsigned*)(L + L_POOLC) = 0u;
    if (tid < 64) ((DLAS unsigned*)(L + L_CNTA1))[tid] = 0u;
    if (N > TOPK) { u32x4 z4u = {0u, 0u, 0u, 0u}; asm volatile("" : "+v"(z4u)); for (int i = tid; i < 64 * NBIN / 2 / 4; i += 512) ((DLAS u32x4*)(L + L_HIST))[i] = z4u; }
    __syncthreads();
    if (N > TOPK) {
        const int n16 = lane & 15, g = lane >> 4, qsub = wave & 3, kh = wave >> 2, qloc = 16 * qsub + n16;
        const size_t rowq = rowb + t0 + qloc;
        bf16x8 qf[8][2]; float w[8];
#pragma unroll
        for (int h = 0; h < 8; ++h)
#pragma unroll
            for (int ks = 0; ks < 2; ++ks) qf[h][ks] = *(const DGAS bf16x8*)(T.QI + rowq * 512 + h * 64 + 32 * ks + 8 * g);
        { const f32x4 w0 = *(const DGAS f32x4*)(T.WI + rowq * 8), w1 = *(const DGAS f32x4*)(T.WI + rowq * 8 + 4);
          w[0] = w0[0]; w[1] = w0[1]; w[2] = w0[2]; w[3] = w0[3]; w[4] = w1[0]; w[5] = w1[1]; w[6] = w1[2]; w[7] = w1[3]; }
        float U = 0.f;
#pragma unroll
        for (int h = 0; h < 8; ++h) { float n2 = 0.f;
#pragma unroll
            for (int ks = 0; ks < 2; ++ks)
#pragma unroll
                for (int e = 0; e < 8; ++e) { const float x = __uint_as_float(((unsigned)(unsigned short)qf[h][ks][e]) << 16); n2 = fmaf(x, x, n2); }
            n2 += lane_read(n2, lane ^ 16); n2 += lane_read(n2, lane ^ 32);
            U += fabsf(w[h]) * sqrtf(n2); }
        U *= sqrtf(T.KMAX[b]) * 1.01f;
        bf16x8 ql[2];
#pragma unroll
        for (int h = 0; h < 8; ++h) w[h] *= 0.5f;
#pragma unroll
        for (int ks = 0; ks < 2; ++ks) { float acc8[8];
#pragma unroll
            for (int e = 0; e < 8; ++e) { float a = 0.f;
#pragma unroll
                for (int h = 0; h < 8; ++h) a = fmaf(w[h], __uint_as_float(((unsigned)(unsigned short)qf[h][ks][e]) << 16), a);
                acc8[e] = a; }
            u32x4 pk; pk.x = attn_body::cvtpk_s(acc8[0], acc8[1]); pk.y = attn_body::cvtpk_s(acc8[2], acc8[3]); pk.z = attn_body::cvtpk_s(acc8[4], acc8[5]); pk.w = attn_body::cvtpk_s(acc8[6], acc8[7]);
            ql[ks] = __builtin_bit_cast(bf16x8, pk); }
        const int e0 = (int)((__float_as_uint(U) >> 19) & 0xFFFu) + 1 - 255;
        const int NT = N / 32;
        score_pass<false>(L, pool, T.KI + rowb * 64, NT, kh, qloc, n16, g, qf, ql, w, e0, 0.f, 0.f, stB, stA, lane);
        __syncthreads();
        { int lane_t = lane; asm volatile("" : "+v"(lane_t)); const int lane = lane_t;
        for (int qq = 0; qq < 8; ++qq) {
            const int q = 8 * wave + qq;
            const u32x4 hw = *((DLAS u32x4*)(L + L_HIST + q * (NBIN * 2)) + lane);
            const unsigned pc[4] = {hw.x & 0xffffu, hw.y & 0xffffu, hw.z & 0xffffu, hw.w & 0xffffu}, nc[4] = {hw.x >> 16, hw.y >> 16, hw.z >> 16, hw.w >> 16};
            const unsigned totP = (pc[0] + pc[1]) + (pc[2] + pc[3]), totN = (nc[0] + nc[1]) + (nc[2] + nc[3]);
            const unsigned preP = wave_incl_prefix(totP);
            const unsigned TP = (unsigned)__builtin_amdgcn_readlane((int)preP, 63);
            const unsigned sufP = TP - preP + totP;
            if (TP >= (unsigned)TOPK) {
                const unsigned above = sufP - totP;
                if (above < (unsigned)TOPK && sufP >= (unsigned)TOPK) {
                    unsigned run = above; int bsel = 256 + 4 * lane, found = 0;
#pragma unroll
                    for (int k = 3; k >= 0; --k) { if (!found) { if (run + pc[k] >= (unsigned)TOPK) { bsel = 256 + 4 * lane + k; found = 1; } else run += pc[k]; } }
                    ((DLAS int*)(L + L_THR))[q] = bsel; ((DLAS int*)(L + L_R))[q] = TOPK - (int)run;
                }
            } else {
                const unsigned need = (unsigned)TOPK - TP;
                const unsigned preN = wave_incl_prefix(totN);
                const unsigned below = preN - totN;
                if (below < need && preN >= need) {
                    unsigned run = below; int bsel = 255 - 4 * lane, found = 0;
#pragma unroll
                    for (int k = 0; k < 4; ++k) { if (!found) { if (run + nc[k] >= need) { bsel = 255 - (4 * lane + k); found = 1; } else run += nc[k]; } }
                    ((DLAS int*)(L + L_THR))[q] = bsel; ((DLAS int*)(L + L_R))[q] = (int)(need - run);
                }
            }
        }
        }
        __syncthreads();
        const int thr = ((DLAS int*)(L + L_THR))[qloc];
        __syncthreads();
        score_pass<true>(L, pool, T.KI + rowb * 64, NT, kh, qloc, n16, g, qf, ql, w, e0, bin_edge(thr + 1, e0), bin_edge(thr, e0), stB, stA, lane);
        __syncthreads();
        for (int qq = 0; qq < 8; ++qq) {
            const int q = 8 * wave + qq;
            const unsigned nBraw = ((DLAS unsigned*)(L + L_CNTB))[q]; const int nB = nBraw < (unsigned)CAP2 ? (int)nBraw : CAP2;
            const int R = ((DLAS int*)(L + L_R))[q]; const int nA0 = (int)((DLAS unsigned*)(L + L_CNTA))[q]; const int base = nA0 < TOPK - R ? nA0 : TOPK - R;
            const DLAS float* lbs = (const DLAS float*)(L + L_HIST) + q * CAP2; const DLAS unsigned short* lbk = (const DLAS unsigned short*)(L + L_LBK) + q * CAP2;
            DLAS unsigned short* la = (DLAS unsigned short*)(L + L_LISTA) + q * TOPK;
            const int thrq = ((DLAS int*)(L + L_THR))[q];
            if (nBraw <= (unsigned)CAP2 && thrq != 0 && thrq != 255 && thrq != 256 && thrq != 511) {
                const unsigned flip = thrq < 256 ? 0x7FFFFu : 0u;
                unsigned k0 = 0u, k1 = 0u, k2 = 0u, i0 = 0u, i1 = 0u, i2 = 0u;
                if (lane < nB) { i0 = lbk[lane]; k0 = (((__float_as_uint(lbs[lane]) ^ flip) & 0x7FFFFu) << 13) | (8191u - i0); }
                if (lane + 64 < nB) { i1 = lbk[lane + 64]; k1 = (((__float_as_uint(lbs[lane + 64]) ^ flip) & 0x7FFFFu) << 13) | (8191u - i1); }
                if (lane + 128 < nB) { i2 = lbk[lane + 128]; k2 = (((__float_as_uint(lbs[lane + 128]) ^ flip) & 0x7FFFFu) << 13) | (8191u - i2); }
                DLAS unsigned* kw = (DLAS unsigned*)(L + L_KW + wave * (CAP2 * 4));
                kw[lane] = k0; kw[lane + 64] = k1; kw[lane + 128] = k2;
                int rk0 = 0, rk1 = 0, rk2 = 0;
                const int n4 = (nB + 3) >> 2;
                if (nB <= 64) {
#pragma unroll 4
                    for (int j4 = 0; j4 < n4; ++j4) { const u32x4 kq = *((const DLAS u32x4*)kw + j4);
                        rk0 += (kq.x > k0 ? 1 : 0) + (kq.y > k0 ? 1 : 0) + (kq.z > k0 ? 1 : 0) + (kq.w > k0 ? 1 : 0); }
                } else {
#pragma unroll 2
                    for (int j4 = 0; j4 < n4; ++j4) { const u32x4 kq = *((const DLAS u32x4*)kw + j4);
                        rk0 += (kq.x > k0 ? 1 : 0) + (kq.y > k0 ? 1 : 0) + (kq.z > k0 ? 1 : 0) + (kq.w > k0 ? 1 : 0);
                        rk1 += (kq.x > k1 ? 1 : 0) + (kq.y > k1 ? 1 : 0) + (kq.z > k1 ? 1 : 0) + (kq.w > k1 ? 1 : 0);
                        rk2 += (kq.x > k2 ? 1 : 0) + (kq.y > k2 ? 1 : 0) + (kq.z > k2 ? 1 : 0) + (kq.w > k2 ? 1 : 0); }
                }
                if (lane < nB && rk0 < R) la[base + rk0] = (unsigned short)i0;
                if (lane + 64 < nB && rk1 < R) la[base + rk1] = (unsigned short)i1;
                if (lane + 128 < nB && rk2 < R) la[base + rk2] = (unsigned short)i2;
                if (lane == 0) ((DLAS int*)(L + L_NSEL))[q] = TOPK - R + (nB < R ? nB : R);
                if (nB < R) { const int nA1 = TOPK - R - base; for (int i = lane; i < nA1; i += 64) { const unsigned short kk = la[TOPK - nA1 + i]; la[base + nB + i] = kk; } }
            } else {
                float s0 = 0.f, s1 = 0.f, s2 = 0.f; unsigned i0 = 0u, i1 = 0u, i2 = 0u;
                if (lane < nB) { s0 = lbs[lane]; i0 = lbk[lane]; }
                if (lane + 64 < nB) { s1 = lbs[lane + 64]; i1 = lbk[lane + 64]; }
                if (lane + 128 < nB) { s2 = lbs[lane + 128]; i2 = lbk[lane + 128]; }
                int rk0 = 0, rk1 = 0, rk2 = 0;
                for (int j = 0; j < nB; ++j) { const float sj = lbs[j]; const unsigned ij = lbk[j];
                    rk0 += ahead(sj, ij, s0, i0) ? 1 : 0; rk1 += ahead(sj, ij, s1, i1) ? 1 : 0; rk2 += ahead(sj, ij, s2, i2) ? 1 : 0; }
                int ntot = nB;
                if (nBraw > (unsigned)CAP2) {
                    const unsigned pcr = *(const DLAS unsigned*)(L + L_POOLC); const int np = pcr < (unsigned)POOLCAP ? (int)pcr : POOLCAP;
                    for (int p = 0; p < np; ++p) { const unsigned long long e = __hip_atomic_load((DGAS unsigned long long*)(pool + p), __ATOMIC_RELAXED, __HIP_MEMORY_SCOPE_AGENT);
                        const unsigned tg = (unsigned)(e >> 32); if ((tg >> 16) != (unsigned)q) continue; const float sj = __uint_as_float((unsigned)e); const unsigned ij = tg & 0xffffu; ++ntot;
                        rk0 += ahead(sj, ij, s0, i0) ? 1 : 0; rk1 += ahead(sj, ij, s1, i1) ? 1 : 0; rk2 += ahead(sj, ij, s2, i2) ? 1 : 0; }
                    for (int p0 = 0; p0 < np; p0 += 64) {
                        const int p = p0 + lane; unsigned long long e = 0ull; if (p < np) e = __hip_atomic_load((DGAS unsigned long long*)(pool + p), __ATOMIC_RELAXED, __HIP_MEMORY_SCOPE_AGENT);
                        const unsigned tg = (unsigned)(e >> 32); const bool mine = (p < np) && ((tg >> 16) == (unsigned)q); const float si = __uint_as_float((unsigned)e); const unsigned ii = tg & 0xffffu;
                        int rk = 0;
                        for (int j = 0; j < nB; ++j) rk += ahead(lbs[j], lbk[j], si, ii) ? 1 : 0;
                        for (int j = 0; j < np; ++j) { const unsigned long long f = __hip_atomic_load((DGAS unsigned long long*)(pool + j), __ATOMIC_RELAXED, __HIP_MEMORY_SCOPE_AGENT);
                            const unsigned tf = (unsigned)(f >> 32); if ((tf >> 16) == (unsigned)q) rk += ahead(__uint_as_float((unsigned)f), tf & 0xffffu, si, ii) ? 1 : 0; }
                        if (mine && rk < R) la[base + rk] = (unsigned short)ii;
                    }
                }
                if (lane < nB && rk0 < R) la[base + rk0] = (unsigned short)i0;
                if (lane + 64 < nB && rk1 < R) la[base + rk1] = (unsigned short)i1;
                if (lane + 128 < nB && rk2 < R) la[base + rk2] = (unsigned short)i2;
                if (lane == 0) ((DLAS int*)(L + L_NSEL))[q] = TOPK - R + (ntot < R ? ntot : R);
                if (ntot < R) { const int nA1 = TOPK - R - base; for (int i = lane; i < nA1; i += 64) { const unsigned short kk = la[TOPK - nA1 + i]; la[base + ntot + i] = kk; } }
            }
        }
    } else {
        for (int i = tid; i < 64 * TOPK; i += 512) ((DLAS unsigned short*)(L + L_LISTA))[i] = (unsigned short)(i & (TOPK - 1));
        if (tid < 64) ((DLAS int*)(L + L_NSEL))[tid] = N;
    }
    __syncthreads();
    }
    {
        int lane_a = lane; asm volatile("" : "+v"(lane_a));
        const int lane = lane_a, n16 = lane & 15, g = lane >> 4, q4 = n16 >> 2, p4 = lane & 3;
        ldsp vst = L + L_HIST + wave * (64 * VST);
        const attn_body::lds_cptr vrd = (attn_body::lds_cptr)(vst + (4 * g + q4) * VST + 4 * p4 * 2);
        const DGAS bf16* KAb = T.KA + rowb * 64; const DGAS bf16* VAb = T.VA + rowb * 64;
        const int vsl = lane >> 3, vch = lane & 7;
#define DSA_REQ(R, LA, NSEL, J) do { const __amdgpu_buffer_rsrc_t rs_ = ((J) < 4) ? rsKA : rsVA; \
            const u32x4 ix_ = *(const DLAS u32x4*)((LA) + 64 * ((J) & 3) + 8 * vsl);        \
            const unsigned iw_[4] = {ix_.x, ix_.y, ix_.z, ix_.w}; \
            _Pragma("unroll") for (int i = 0; i < 8; ++i) { const unsigned key = ((i & 1) ? (iw_[i >> 1] >> 16) : iw_[i >> 1]) & 8191u; \
                R[i] = __builtin_amdgcn_raw_buffer_load_b128(rs_, (int)(key * 128u + (unsigned)vch * 16u), 0, 0); } } while (0)
#define DSA_PUT(R) do { _Pragma("unroll") for (int i = 0; i < 8; ++i) *(DLAS u32x4*)(vst + (8 * vsl + i) * VST + vch * 16) = R[i]; } while (0)
        const __amdgpu_buffer_rsrc_t rsKA = __builtin_amdgcn_make_buffer_rsrc((void*)KAb, (short)0, 8192 * 128, 0x00020000), rsVA = __builtin_amdgcn_make_buffer_rsrc((void*)VAb, (short)0, 8192 * 128, 0x00020000);
        const bf16x8 zf = {0, 0, 0, 0, 0, 0, 0, 0};
        u32x4 vr[2][8]; bf16x8 qn0 = zf, qn1 = zf;
        { const int q = 8 * wave; const int nsel = ((DLAS int*)(L + L_NSEL))[q]; const DLAS unsigned short* la = (const DLAS unsigned short*)(L + L_LISTA) + q * TOPK; const size_t row = rowb + t0 + q;
          DSA_REQ(vr[0], la, nsel, 0); DSA_REQ(vr[1], la, nsel, 1);
          if (n16 < 8) { qn0 = *(const DGAS bf16x8*)(T.QA + row * 512 + n16 * 64 + 8 * g); qn1 = *(const DGAS bf16x8*)(T.QA + row * 512 + n16 * 64 + 32 + 8 * g); } }
        for (int qq = 0; qq < 8 * REP_DSA_ATT; ++qq) {
            const int q = 8 * wave + (qq & 7); const size_t row = rowb + t0 + q;
            const int nsel = ((DLAS int*)(L + L_NSEL))[q];
            const DLAS unsigned short* la = (const DLAS unsigned short*)(L + L_LISTA) + q * TOPK;
            const int qx = 8 * wave + ((qq + 1 < 8 * REP_DSA_ATT) ? ((qq + 1) & 7) : (qq & 7));
            const int nseln = ((DLAS int*)(L + L_NSEL))[qx]; const DLAS unsigned short* lan = (const DLAS unsigned short*)(L + L_LISTA) + qx * TOPK; const size_t rown = rowb + t0 + qx;
            const bf16x8 qb0 = qn0, qb1 = qn1;
            f32x4 sa[16];
#pragma unroll
            for (int cst = 0; cst < 4; ++cst) {
                DSA_PUT(vr[cst & 1]);
                DSA_REQ(vr[cst & 1], la, nsel, cst + 2);
#pragma unroll
                for (int t4 = 0; t4 < 4; ++t4) {
                    const bf16x8 a0 = *(const DLAS bf16x8*)(vst + (16 * t4 + n16) * VST + 16 * g), a1 = *(const DLAS bf16x8*)(vst + (16 * t4 + n16) * VST + 64 + 16 * g);
                    f32x4 s = {0.f, 0.f, 0.f, 0.f};
                    s = __builtin_amdgcn_mfma_f32_16x16x32_bf16(a0, qb0, s, 0, 0, 0);
                    s = __builtin_amdgcn_mfma_f32_16x16x32_bf16(a1, qb1, s, 0, 0, 0);
                    sa[4 * cst + t4] = s;
                }
            }
            float m = -INFINITY;
#pragma unroll
            for (int tt = 0; tt < 16; ++tt)
#pragma unroll
                for (int i = 0; i < 4; ++i) { if (16 * tt + 4 * g + i >= nsel) sa[tt][i] = -INFINITY; m = fmaxf(m, sa[tt][i]); }
            m = fmaxf(m, lane_read(m, lane ^ 16)); m = fmaxf(m, lane_read(m, lane ^ 32));
            float ls = 0.f;
#pragma unroll
            for (int tt = 0; tt < 16; ++tt)
#pragma unroll
                for (int i = 0; i < 4; ++i) { const float p = __builtin_amdgcn_exp2f(sa[tt][i] - m); sa[tt][i] = p; ls += p; }
            ls += lane_read(ls, lane ^ 16); ls += lane_read(ls, lane ^ 32);
            if (g == 0) ((DLAS float*)(L + L_LSUM))[wave * 16 + n16] = ls;
            f32x4 o[4];
#pragma unroll
            for (int nb = 0; nb < 4; ++nb) o[nb] = (f32x4){0.f, 0.f, 0.f, 0.f};
#pragma unroll
            for (int cst = 0; cst < 4; ++cst) {
                DSA_PUT(vr[cst & 1]);
                if (cst < 2) DSA_REQ(vr[cst & 1], la, nsel, cst + 6);
                else { DSA_REQ(vr[cst & 1], lan, nseln, cst - 2);
                       if (cst == 2 && n16 < 8) { qn0 = *(const DGAS bf16x8*)(T.QA + rown * 512 + n16 * 64 + 8 * g); qn1 = *(const DGAS bf16x8*)(T.QA + rown * 512 + n16 * 64 + 32 + 8 * g); } }
#pragma unroll
                for (int s2 = 0; s2 < 2; ++s2) {
                    const int s = 2 * cst + s2;
                    u32x4 pw; pw.x = attn_body::cvtpk_s(sa[2 * s][0], sa[2 * s][1]); pw.y = attn_body::cvtpk_s(sa[2 * s][2], sa[2 * s][3]);
                    pw.z = attn_body::cvtpk_s(sa[2 * s + 1][0], sa[2 * s + 1][1]); pw.w = attn_body::cvtpk_s(sa[2 * s + 1][2], sa[2 * s + 1][3]);
                    const bf16x8 pa = __builtin_bit_cast(bf16x8, pw);
#pragma unroll
                    for (int nb = 0; nb < 4; ++nb) {
                        const s16x4 t1 = attn_body::vtr(vrd + (32 * s2) * VST + 32 * nb), t2 = attn_body::vtr(vrd + (32 * s2 + 16) * VST + 32 * nb);
                        const bf16x8 vb = {t1[0], t1[1], t1[2], t1[3], t2[0], t2[1], t2[2], t2[3]};
                        o[nb] = __builtin_amdgcn_mfma_f32_16x16x32_bf16(pa, vb, o[nb], 0, 0, 0);
                    }
                }
            }
            if (g < 2) {
                const f32x4 lv = *(const DLAS f32x4*)(L + L_LSUM + (wave * 16 + 4 * g) * 4);
#pragma unroll
                for (int i = 0; i < 4; ++i) { const float li = __builtin_amdgcn_rcpf(lv[i]);
#pragma unroll
                    for (int nb = 0; nb < 4; ++nb) T.OA[row * 1024 + (4 * g + i) * 64 + 16 * nb + n16] = (bf16)(attn_body::cvtpk_s(o[nb][i] * li, 0.f) & 0xffffu); }
            }
        }
    }
    __syncthreads();
}
#undef DSA_REQ
#undef DSA_PUT
#undef DLAS
#undef DGAS
}

constexpr int NWAVES = 8, NTHR = NWAVES * 64;
#define GAS __attribute__((address_space(1)))
#define LAS __attribute__((address_space(3)))
typedef unsigned short bf16;
typedef unsigned v4u __attribute__((ext_vector_type(4)));
typedef float f32x4 __attribute__((ext_vector_type(4)));
typedef short bf16x8 __attribute__((ext_vector_type(8)));
typedef GAS unsigned gu32;
#define RLX_AGENT __ATOMIC_RELAXED, __HIP_MEMORY_SCOPE_AGENT
#define LDS_WAIT() asm volatile("s_waitcnt lgkmcnt(0)" ::: "memory")
#define VM_WAIT() asm volatile("s_waitcnt vmcnt(0)" ::: "memory")
__device__ __forceinline__ unsigned f2bf(float f) { unsigned u = __builtin_bit_cast(unsigned, f); return (u + 0x7fffu + ((u >> 16) & 1u)) >> 16; }
__device__ __forceinline__ unsigned pk2(float lo, float hi) { return f2bf(lo) | (f2bf(hi) << 16); }

constexpr int RING_BYTES = 131072;
constexpr int LDSCTL_OFF = RING_BYTES, MISC_OFF = LDSCTL_OFF + 320;
constexpr int LDS_BYTES = 147456;
#define XB_TMO      128
#define XB_XCNT(j)  (256  + 64 * (j))
#define XB_XSUB(j)  (1280 + 64 * (j))
#define XB_XGEN(j)  (2304 + 64 * (j))
#define XB_TOP      3328
#define XB_TOPGEN   3392
#define XCD_BAR_WORDS 3456
#define XB_SPIN_CAP (1u << 18)

__device__ __forceinline__ unsigned xb_ld(unsigned* p)              { return __hip_atomic_load(p, __ATOMIC_RELAXED, __HIP_MEMORY_SCOPE_AGENT); }
__device__ __forceinline__ unsigned xb_add(unsigned* p, unsigned v) { return __hip_atomic_fetch_add(p, v, __ATOMIC_RELAXED, __HIP_MEMORY_SCOPE_AGENT); }
__device__ __forceinline__ unsigned xb_xcc_id() { return (unsigned)__builtin_amdgcn_s_getreg((3 << 11) | 20) & 0xFu; }
#define XB_SPIN(cond, bar) do { unsigned _sp = 0; while (cond) { __builtin_amdgcn_s_sleep(1); \
    if ((++_sp & 255u) == 0u) { if (xb_ld(&(bar)[XB_TMO])) break; if (_sp > XB_SPIN_CAP) { atomicAdd(&(bar)[XB_TMO], 1u); break; } } } } while (0)

struct XcdBarrier {
    unsigned* bar; unsigned x;
    volatile LAS unsigned* st;
};

__device__ __forceinline__ XcdBarrier xcd_barrier_post(unsigned* bar, volatile LAS unsigned* st, bool tid0) {
    XcdBarrier b; b.bar = bar; b.x = xb_xcc_id(); b.st = st;
    if (tid0) (void)xb_add(&bar[XB_XCNT(b.x)], 1u);
    return b;
}
__device__ __forceinline__ void xcd_barrier_complete(unsigned* bar, unsigned x, unsigned& nloc, unsigned& nx) {
    const unsigned G = gridDim.x * gridDim.y * gridDim.z;
    unsigned sum, cnt, mine, sp = 0u;
    for (;;) {
        sum = 0u; cnt = 0u; mine = 0u;
#pragma unroll
        for (unsigned j = 0; j < 16; ++j) { const unsigned c = xb_ld(&bar[XB_XCNT(j)]); sum += c; cnt += (c > 0u) ? 1u : 0u; mine = (j == x) ? c : mine; }
        if (sum == G) break;
        __builtin_amdgcn_s_sleep(1);
        if ((++sp & 255u) == 0u) { if (xb_ld(&bar[XB_TMO])) break; if (sp > XB_SPIN_CAP) { atomicAdd(&bar[XB_TMO], 1u); break; } }
    }
    nloc = mine > 0u ? mine : 1u; nx = cnt > 0u ? cnt : 1u;
}

__device__ __forceinline__ void xcd_barrier(const XcdBarrier& b, bool tid0) {
    asm volatile("s_waitcnt vmcnt(0)" ::: "memory");
    __syncthreads();
    if (tid0) {
        unsigned* bar = b.bar;
        __builtin_amdgcn_s_waitcnt(0);
        unsigned nloc = b.st[0], nx = b.st[1];
        if (nloc == 0u) { xcd_barrier_complete(bar, b.x, nloc, nx); b.st[0] = nloc; b.st[1] = nx; }
        const unsigned old = xb_add(&bar[XB_XSUB(b.x)], 1u);
        const unsigned gen = old / nloc;
        if (old + 1u == (gen + 1u) * nloc) {
            __builtin_amdgcn_fence(__ATOMIC_RELEASE, "agent");
            asm volatile("s_waitcnt vmcnt(0)" ::: "memory");
            const unsigned og = xb_add(&bar[XB_TOP], 1u);
            const unsigned tg = og / nx;
            if (og + 1u == (tg + 1u) * nx) xb_add(&bar[XB_TOPGEN], 1u);
            else XB_SPIN(xb_ld(&bar[XB_TOPGEN]) == tg, bar);
            __builtin_amdgcn_fence(__ATOMIC_ACQUIRE, "agent");
            xb_add(&bar[XB_XGEN(b.x)], 1u);
            asm volatile("s_waitcnt vmcnt(0)" ::: "memory");
        } else {
            XB_SPIN(xb_ld(&bar[XB_XGEN(b.x)]) == gen, bar);
            __builtin_amdgcn_fence(__ATOMIC_ACQUIRE, "agent");
            asm volatile("s_waitcnt vmcnt(0)" ::: "memory");
        }
    }
    __syncthreads();
}

__device__ __forceinline__ float wave_sum(float v, int lane) {
#pragma unroll
    for (int o = 1; o < 64; o <<= 1) v += lane_read(v, lane ^ o);
    return v;
}
__device__ __forceinline__ int ropeperm(int j) { return j < 4 ? j : j < 8 ? j + 4 : j < 12 ? j - 4 : j; }
template <int MAP> __device__ __forceinline__ int src_col(int n) {
    if (MAP == 0) return n;
    if (MAP == 2) { const int pn = n >> 8, w = n & 255; return w < 128 ? 128 * pn + w : DFF + 128 * pn + (w - 128); }
    const int t = n >> 8, w = n & 255;
    if (t < 2) return (n & ~63) + ropeperm(n & 63);
    if (t == 2) { if (w < 64) return 512 + ropeperm(w); if (w < 128) return 576 + (w - 64); if (w < 192) return 1152 + ropeperm(w - 128);
                  const int s = w - 192; return s < 8 ? 1216 + s : s < 16 ? 2760 + (s - 8) : -1; }
    if (t < 5) { const int hc = n - 768; return 640 + (hc & ~63) + ropeperm(hc & 63); }
    if (t < 7) return 1224 + (n - 1280);
    if (t < 9) return 1736 + (n - 1792);
    if (t < 11) return 2248 + (n - 2304);
    return 2768 + (n - 2816);
}
template <int MAP> __device__ __forceinline__ void transpose_item(const float* W, int K, int Nsrc, int Ndst, bf16* WT, LAS float* scr, int item, int lane, int ldk = 0, int kofs = 0) {
    if (ldk == 0) ldk = K;
    const int nblk = Ndst / 32, kb = item / nblk, nb = item % nblk, k0 = 64 * kb, n0 = 32 * nb;
    const int sc = src_col<MAP>(n0 + (lane & 31));
    float tv[32];
#pragma unroll
    for (int i = 0; i < 32; ++i) { const int kk = 2 * i + (lane >> 5); tv[i] = sc >= 0 ? ((const GAS float*)W)[(size_t)(k0 + kk) * Nsrc + sc] : 0.f; }
#pragma unroll
    for (int i = 0; i < 32; ++i) { const int kk = 2 * i + (lane >> 5); scr[kk * 33 + (lane & 31)] = tv[i]; }
    LDS_WAIT(); asm volatile("" ::: "memory");
    const int c = lane & 7;
#pragma unroll
    for (int j = 0; j < 4; ++j) { const int n = (lane >> 3) + 8 * j; const LAS float* s = scr + (8 * c) * 33 + n;
        v4u o; o.x = pk2(s[0 * 33], s[1 * 33]); o.y = pk2(s[2 * 33], s[3 * 33]); o.z = pk2(s[4 * 33], s[5 * 33]); o.w = pk2(s[6 * 33], s[7 * 33]);
        *(GAS v4u*)(WT + (size_t)(n0 + n) * ldk + kofs + k0 + 8 * c) = o; }
    LDS_WAIT(); asm volatile("" ::: "memory");
}
__device__ __forceinline__ void cos_sin_acc(float angf, float& co, float& si) {
    const double a = (double)angf, k = rint(a * 0.63661977236758134308), r = fma(-k, 6.123233995736766e-17, fma(-k, 1.5707963267948966, a)), r2 = r * r;
    double s = -1.0 / 39916800.0; s = fma(s, r2, 1.0 / 362880.0); s = fma(s, r2, -1.0 / 5040.0); s = fma(s, r2, 1.0 / 120.0); s = fma(s, r2, -1.0 / 6.0); s = fma(s * r2, r, r);
    double c = 1.0 / 479001600.0; c = fma(c, r2, -1.0 / 3628800.0); c = fma(c, r2, 1.0 / 40320.0); c = fma(c, r2, -1.0 / 720.0); c = fma(c, r2, 1.0 / 24.0); c = fma(c, r2, -0.5); c = fma(c, r2, 1.0);
    const int q = (int)((long long)k & 3);
    const double cc = (q == 0) ? c : (q == 1) ? -s : (q == 2) ? -c : s, ss = (q == 0) ? s : (q == 1) ? c : (q == 2) ? -s : -c;
    co = (float)cc; si = (float)ss;
}
__device__ __forceinline__ void load_vec16(const float* p, int lane, f32x4 (&v)[4]) {
#pragma unroll
    for (int j = 0; j < 4; ++j) v[j] = *((const GAS f32x4*)p + lane + 64 * j);
}
__device__ __forceinline__ void load_vec16b(const float* p, int lane, f32x4 (&v)[4]) {
#pragma unroll
    for (int j = 0; j < 2; ++j) { v[2 * j] = *(const GAS f32x4*)(p + 512 * j + 8 * lane); v[2 * j + 1] = *(const GAS f32x4*)(p + 512 * j + 8 * lane + 4); }
}
__device__ __forceinline__ void load_row16b(const bf16* row, int lane, f32x4 (&v)[4]) {
#pragma unroll
    for (int j = 0; j < 2; ++j) { const v4u w = *(const GAS v4u*)(row + 512 * j + 8 * lane);
        v[2 * j] = (f32x4){__uint_as_float(w.x << 16), __uint_as_float(w.x & 0xffff0000u), __uint_as_float(w.y << 16), __uint_as_float(w.y & 0xffff0000u)};
        v[2 * j + 1] = (f32x4){__uint_as_float(w.z << 16), __uint_as_float(w.z & 0xffff0000u), __uint_as_float(w.w << 16), __uint_as_float(w.w & 0xffff0000u)}; }
}
__device__ __forceinline__ void store_row16b(bf16* row, int lane, const f32x4 (&y)[4]) {
#pragma unroll
    for (int j = 0; j < 2; ++j) { v4u o; o.x = pk2(y[2 * j].x, y[2 * j].y); o.y = pk2(y[2 * j].z, y[2 * j].w); o.z = pk2(y[2 * j + 1].x, y[2 * j + 1].y); o.w = pk2(y[2 * j + 1].z, y[2 * j + 1].w);
        *(GAS v4u*)(row + 512 * j + 8 * lane) = o; }
}

#ifndef MK_ONE_LAUNCH
#define MK_ONE_LAUNCH 1
#endif
#ifndef REP_FOX
#define REP_FOX 1
#endif
#ifndef REP_DSA
#define REP_DSA 1
#endif
#ifndef REP_INPROJ
#define REP_INPROJ 1
#endif
#ifndef REP_P0
#define REP_P0 1
#endif
#ifndef REP_UP
#define REP_UP 1
#endif
#ifndef MK_STEP
#define MK_STEP 3
#endif
constexpr int NPL = 10, PH_FINAL = 1 + DEPTH * NPL, N_PHASES = PH_FINAL + 1;
struct Args { const float* in[17]; float* out; unsigned char* ws; int ph_lo, ph_hi, use_bar, pad; };
__global__ void __launch_bounds__(NTHR, 2) mk_fwd(Args args) {
    extern __shared__ __attribute__((aligned(16))) unsigned char lds[];
    LAS unsigned char* const L = (LAS unsigned char*)lds;
    volatile LAS unsigned* const MISC = (volatile LAS unsigned*)(L + MISC_OFF); (void)MISC;
#define PHASE_IDS() int tid; { int ws_ = wave_s, ln_; asm volatile("v_mbcnt_lo_u32_b32 %0, -1, 0\n\tv_mbcnt_hi_u32_b32 %0, -1, %0" : "=v"(ln_)); asm volatile("" : "+s"(ws_)); tid = ws_ * 64 + ln_; } int bx = blockIdx.x; asm volatile("" : "+s"(bx)); int G = (int)gridDim.x; asm volatile("" : "+s"(G)); \
    unsigned char* ws_l = args.ws; asm volatile("" : "+s"(ws_l)); unsigned char* const ws = ws_l; float* outp_l = args.out; asm volatile("" : "+s"(outp_l)); float* const outp = outp_l; \
    float* const MOD = (float*)(ws + WS_MOD); float* const CS = (float*)(ws + WS_CS); bf16* const H = (bf16*)(ws + WS_H); bf16* const XB = (bf16*)(ws + WS_XB); \
    const int lane = tid & 63, wave = __builtin_amdgcn_readfirstlane(tid >> 6), vcu = (G % 8 == 0) ? (bx % 8) * (G / 8) + bx / 8 : bx, gw = vcu * NWAVES + wave, NGW = G * NWAVES; \
    (void)lane; (void)wave; (void)vcu; (void)gw; (void)NGW; (void)MOD; (void)CS; (void)H; (void)XB; (void)outp
    const int wave_s = __builtin_amdgcn_readfirstlane((int)threadIdx.x >> 6);
    for (int u = wave_s * 64 + (int)__builtin_amdgcn_mbcnt_hi(~0u, __builtin_amdgcn_mbcnt_lo(~0u, 0u)); u < (LDS_BYTES - LDSCTL_OFF) / 4; u += NTHR) ((LAS unsigned*)(L + LDSCTL_OFF))[u] = 0u;
    __syncthreads();
#if MK_ONE_LAUNCH
    (void)xcd_barrier_post((unsigned*)((gu32*)(args.ws + WS_CTL) + CW_BAR), MISC + 8, wave_s == 0 && __builtin_amdgcn_mbcnt_hi(~0u, __builtin_amdgcn_mbcnt_lo(~0u, 0u)) == 0);
#define IN(k) true
#define GRID_BAR() do { unsigned char* wb_ = args.ws; asm volatile("" : "+s"(wb_)); XcdBarrier bar_; bar_.bar = (unsigned*)((gu32*)(wb_ + WS_CTL) + CW_BAR); bar_.x = xb_xcc_id(); bar_.st = (volatile LAS unsigned*)(L + MISC_OFF) + 8; int ln0_; asm volatile("v_mbcnt_lo_u32_b32 %0, -1, 0\n\tv_mbcnt_hi_u32_b32 %0, -1, %0" : "=v"(ln0_)); xcd_barrier(bar_, wave_s == 0 && ln0_ == 0); } while (0)
#else
    const int lo = args.ph_lo, hi = args.ph_hi;
#define IN(k) (lo <= (k) && (k) < hi)
#define GRID_BAR() do { } while (0)
#endif

#define KA_PTR() ({ const char __attribute__((address_space(4)))* kp_ = (const char __attribute__((address_space(4)))*)__builtin_amdgcn_kernarg_segment_ptr(); asm volatile("" : "+s"(kp_)); kp_; })
#define KIN(kp, k) (*(const float* const __attribute__((address_space(4)))*)((kp) + 8 * (k)))

    if (IN(0)) {
        const int l = 0; PHASE_IDS(); const float* const modl = MOD + (size_t)l * NB * 6144; (void)modl;
        for (int rep0 = 0; rep0 < REP_P0; ++rep0) {
        {
            LAS float* cl = (LAS float*)L;
            LAS float* red = (LAS float*)(L + 16384);
            const char __attribute__((address_space(4)))* kp = KA_PTR(); const float* cin = KIN(kp, 1); const float* modw = KIN(kp, 3); const float* modb = KIN(kp, 4);
            bool loaded = false;
            for (int un = bx; un < DEPTH * 96; un += G) {
                if (!loaded) { for (int i = tid; i < NB * DM; i += NTHR) cl[i] = ((const GAS float*)cin)[i]; loaded = true; }
                __syncthreads();
                const int l = un / 96, col = (un % 96) * 64 + (tid & 63), kg = tid >> 6;
                const float* W = modw + (size_t)l * DM * 6144 + col;
                float a0 = 0.f, a1 = 0.f, a2 = 0.f, a3 = 0.f;
                for (int k0 = kg * 128; k0 < kg * 128 + 128; k0 += 32) {
                    float wv[32];
#pragma unroll
                    for (int i = 0; i < 32; ++i) wv[i] = ((const GAS float*)W)[(size_t)(k0 + i) * 6144];
#pragma unroll
                    for (int i = 0; i < 32; ++i) { const float w = wv[i]; a0 += cl[k0 + i] * w; a1 += cl[DM + k0 + i] * w; a2 += cl[2 * DM + k0 + i] * w; a3 += cl[3 * DM + k0 + i] * w; }
                }
                red[(kg * 4 + 0) * 64 + (tid & 63)] = a0; red[(kg * 4 + 1) * 64 + (tid & 63)] = a1; red[(kg * 4 + 2) * 64 + (tid & 63)] = a2; red[(kg * 4 + 3) * 64 + (tid & 63)] = a3;
                __syncthreads();
                if (tid < 256) { const int b = tid >> 6, j = tid & 63; float s = 0.f;
#pragma unroll
                    for (int g = 0; g < 8; ++g) s += red[(g * 4 + b) * 64 + j];
                    const int cc = (un % 96) * 64 + j;
                    ((GAS float*)MOD)[((size_t)l * NB + b) * 6144 + cc] = s + ((const GAS float*)modb)[(size_t)l * 6144 + cc]; }
                __syncthreads();
            }
            __syncthreads();
        }
        {
            const char __attribute__((address_space(4)))* kp = KA_PTR(); const int* pos = (const int*)KIN(kp, 2);
            for (int i = (vcu * NTHR + tid); i < MTOK * 8; i += G * NTHR) {
                const int row = i >> 3, j = i & 7;
                const float invf = (j == 0) ? 1.0f : (j == 1) ? 0.19392274f : (j == 2) ? 0.03760603f : (j == 3) ? 0.0072926646f : (j == 4) ? 0.0014142136f : (j == 5) ? 0.0002742482f : (j == 6) ? 5.3182957e-05f : 1.0313385e-05f;
                const float ang = (float)((const GAS int*)pos)[row] * invf;
                float co, si; cos_sin_acc(ang, co, si);
                { typedef float f32x2g __attribute__((ext_vector_type(2))); *(GAS f32x2g*)(CS + (size_t)i * 2) = (f32x2g){co, si}; }
            }
        }
        {
            const char __attribute__((address_space(4)))* kp = KA_PTR();
            LAS float* scr = (LAS float*)(L + wave * 16384);
            constexpr int I_IN = (DM / 64) * (NIN / 32), I_A = (WSP / 64) * (DM / 32), I_O = (DM / 64) * (DM / 32), I_UP = (DM / 64) * (NUP / 32), I_D = (DFF / 64) * (DM / 32);
            constexpr int I_L = I_IN + 2 * I_A + I_O + I_UP + I_D;
            for (int it = gw; it < DEPTH * I_L; it += NGW) {
                const int l = it / I_L; int r = it % I_L;
                if (r < I_IN) { transpose_item<1>(KIN(kp, 7) + (size_t)l * DM * NIN_SRC, DM, NIN_SRC, NIN, (bf16*)(ws + WS_WIN + l * WIN_L), scr, r, lane); continue; } r -= I_IN;
                if (r < I_A) { transpose_item<0>(KIN(kp, 9) + (size_t)l * WSP * DM, WSP, DM, DM, (bf16*)(ws + WS_WA + l * 2 * WA_L), scr, r, lane, DM, 0); continue; } r -= I_A;
                if (r < I_A) { transpose_item<0>(KIN(kp, 10) + (size_t)l * WSP * DM, WSP, DM, DM, (bf16*)(ws + WS_WA + l * 2 * WA_L), scr, r, lane, DM, WSP); continue; } r -= I_A;
                if (r < I_O) { transpose_item<0>(KIN(kp, 11) + (size_t)l * DM * DM, DM, DM, DM, (bf16*)(ws + WS_WO + l * WO_L), scr, r, lane); continue; } r -= I_O;
                if (r < I_UP) { transpose_item<2>(KIN(kp, 12) + (size_t)l * DM * NUP, DM, NUP, NUP, (bf16*)(ws + WS_WUP + l * WUP_L), scr, r, lane); continue; } r -= I_UP;
                transpose_item<0>(KIN(kp, 15) + (size_t)l * DFF * DM, DFF, DM, DM, (bf16*)(ws + WS_WD + l * WD_L), scr, r, lane);
            }
        }
        if (REP_P0 > 1) __syncthreads();
        }
        GRID_BAR();
    }

    for (int l = 0; l < DEPTH; ++l) {
        const int pb = 1 + l * NPL;
#if MK_STEP < 2
        if (IN(pb + 5)) {
            PHASE_IDS(); const float* const modl = MOD + (size_t)l * NB * 6144; (void)modl;
            if (l == 0) { const float* x_in = KIN(KA_PTR(), 0); for (size_t i = (size_t)vcu * NTHR + tid; i < (size_t)MTOK * DM / 4; i += (size_t)G * NTHR) ((GAS f32x4*)outp)[i] = ((const GAS f32x4*)x_in)[i]; }
            GRID_BAR();
        }
#else
        if (IN(pb + 0)) {
            PHASE_IDS(); const float* const modl = MOD + (size_t)l * NB * 6144; (void)modl;
            const char __attribute__((address_space(4)))* kp = KA_PTR();
            if (bx == 0 && tid < NB) ((gu32*)(ws + WS_CUM + MiB))[tid] = 0u;
            const float* g = KIN(kp, 5) + (size_t)l * DM;
            constexpr int RPW = MTOK / (256 * NWAVES);
            if (l == 0) {
                const float* xs = KIN(kp, 0);
                for (int r0 = gw * RPW; r0 < MTOK; r0 += NGW * RPW) {
                    const int b = r0 / SEQ; const float* mb = modl + (size_t)b * 6144;
                    f32x4 gv[4], scv[4], shv[4]; load_vec16(g, lane, gv); load_vec16(mb + 1024, lane, scv); load_vec16(mb, lane, shv);
#pragma unroll
                    for (int j = 0; j < 4; ++j) gv[j] = gv[j] * (scv[j] + 1.0f);
                    for (int r = r0; r < r0 + RPW; ++r) {
                        f32x4 v[4]; load_vec16(xs + (size_t)r * DM, lane, v); float s = 0.f;
#pragma unroll
                        for (int j = 0; j < 4; ++j) s += (v[j].x * v[j].x + v[j].y * v[j].y) + (v[j].z * v[j].z + v[j].w * v[j].w);
                        const float rstd = rsqrtf(wave_sum(s, lane) * (1.f / DM) + EPS);
                        GAS unsigned long long* o8 = (GAS unsigned long long*)(H + (size_t)r * DM) + lane;
#pragma unroll
                        for (int j = 0; j < 4; ++j) { const f32x4 y = v[j] * rstd * gv[j] + shv[j]; o8[64 * j] = (unsigned long long)pk2(y.x, y.y) | ((unsigned long long)pk2(y.z, y.w) << 32); }
                    }
                }
            } else {
                for (int r0 = gw * RPW; r0 < MTOK; r0 += NGW * RPW) {
                    const int b = r0 / SEQ; const float* mb = modl + (size_t)b * 6144;
                    f32x4 gv[4], scv[4], shv[4]; load_vec16b(g, lane, gv); load_vec16b(mb + 1024, lane, scv); load_vec16b(mb, lane, shv);
#pragma unroll
                    for (int j = 0; j < 4; ++j) gv[j] = gv[j] * (scv[j] + 1.0f);
                    for (int r = r0; r < r0 + RPW; ++r) {
                        f32x4 v[4]; load_row16b(XB + (size_t)r * DM, lane, v); float s = 0.f;
#pragma unroll
                        for (int j = 0; j < 4; ++j) s += (v[j].x * v[j].x + v[j].y * v[j].y) + (v[j].z * v[j].z + v[j].w * v[j].w);
                        const float rstd = rsqrtf(wave_sum(s, lane) * (1.f / DM) + EPS);
                        f32x4 y[4];
#pragma unroll
                        for (int j = 0; j < 4; ++j) y[j] = v[j] * rstd * gv[j] + shv[j];
                        store_row16b(H + (size_t)r * DM, lane, y);
                    }
                }
            }
            GRID_BAR();
        }
        if (IN(pb + 1)) {
            PHASE_IDS(); const float* const modl = MOD + (size_t)l * NB * 6144; (void)modl;
            pg8::Gemm g{H, (const bf16*)(ws + WS_WIN + l * WIN_L), MTOK, NIN, DM}; pg8::StaticOrder S; S.init(MTOK, NIN, G, bx);
            pg8::EpiInProj E{ws, CS, KIN(KA_PTR(), 8) + (size_t)l * 8};
            for (int rep = 0; rep < REP_INPROJ; ++rep) pg8::gemm_phase<pg8::EpiInProj, pg8::StaticOrder, true, true>(L, g, S, E, wave_s);
            GRID_BAR();
        }
        if (IN(pb + 2)) {
            PHASE_IDS(); const float* const modl = MOD + (size_t)l * NB * 6144; (void)modl;
            const float* LOGF = (const float*)(ws + WS_LOGF); float* CUM = (float*)(ws + WS_CUM);
            {
                GAS float* NRM = (GAS float*)(ws + WS_CUM + MiB + 4096);
                for (int jb = gw; jb < 2048; jb += NGW) {
                    const int idx = jb & 1023, b = idx >> 8, h = (idx >> 5) & 7, qb = idx & 31;
                    const bf16* P = (const bf16*)(ws + ((jb >> 10) ? WS_KF : WS_QF)) + ((size_t)b * SEQ + 256 * qb + 4 * lane) * 512 + h * 64; float mx = 0.f;
                    v4u wq[4][8];
#pragma unroll
                    for (int r = 0; r < 4; ++r)
#pragma unroll
                        for (int c8 = 0; c8 < 8; ++c8) wq[r][c8] = *(const GAS v4u*)(P + (size_t)r * 512 + 8 * c8);
#pragma unroll
                    for (int r = 0; r < 4; ++r) { float n2 = 0.f;
#pragma unroll
                        for (int c8 = 0; c8 < 8; ++c8) { const v4u wv = wq[r][c8]; const unsigned ww[4] = {wv.x, wv.y, wv.z, wv.w};
#pragma unroll
                            for (int e = 0; e < 4; ++e) { const float a = __uint_as_float(ww[e] << 16), bb = __uint_as_float(ww[e] & 0xffff0000u); n2 = fmaf(a, a, n2); n2 = fmaf(bb, bb, n2); } }
                        mx = fmaxf(mx, n2); }
#pragma unroll
                    for (int o = 1; o < 64; o <<= 1) mx = fmaxf(mx, lane_read(mx, lane ^ o));
                    if (lane == 0) NRM[jb] = sqrtf(mx) * 1.0001f;
                }
            }
            LAS float* wtot = (LAS float*)L;
            {
                for (int s = bx; s < 256; s += G) {
                    const bf16* KI = (const bf16*)(ws + WS_KI) + ((size_t)s * 128 + (tid >> 2)) * 64 + (tid & 3) * 16; float n2 = 0.f;
#pragma unroll
                    for (int c8 = 0; c8 < 2; ++c8) { const v4u wv = *(const GAS v4u*)(KI + 8 * c8); const unsigned ww[4] = {wv.x, wv.y, wv.z, wv.w};
#pragma unroll
                        for (int e = 0; e < 4; ++e) { const float a = __uint_as_float(ww[e] << 16), bb = __uint_as_float(ww[e] & 0xffff0000u); n2 = fmaf(a, a, n2); n2 = fmaf(bb, bb, n2); } }
                    n2 += lane_read(n2, lane ^ 1); n2 += lane_read(n2, lane ^ 2);
#pragma unroll
                    for (int o = 4; o < 64; o <<= 1) n2 = fmaxf(n2, lane_read(n2, lane ^ o));
                    if (lane == 0) __hip_atomic_fetch_max((gu32*)(ws + WS_CUM + MiB) + (s >> 6), __float_as_uint(n2), __ATOMIC_RELAXED, __HIP_MEMORY_SCOPE_AGENT);
                }
            }
            for (int sq = bx; sq < NB * 8; sq += G) {
                const int b = sq >> 3, h = sq & 7; float v[16]; float run = 0.f;
#pragma unroll
                for (int i = 0; i < 16; ++i) { run += ((const GAS float*)LOGF)[((size_t)b * SEQ + tid * 16 + i) * 8 + h]; v[i] = run; }
                float inc = run;
#pragma unroll
                for (int o = 1; o < 64; o <<= 1) { const float t = lane_read(inc, (lane - o) & 63); if (lane >= o) inc += t; }
                if (lane == 63) wtot[wave] = inc;
                __syncthreads();
                float base = inc - run;
                for (int w = 0; w < wave; ++w) base += wtot[w];
                float* o = CUM + (size_t)sq * SEQ + tid * 16;
#pragma unroll
                for (int i = 0; i < 16; i += 4) *(GAS f32x4*)(o + i) = (f32x4){v[i] + base, v[i + 1] + base, v[i + 2] + base, v[i + 3] + base};
                __syncthreads();
            }
            GRID_BAR();
        }
        if (IN(pb + 3)) {
            PHASE_IDS(); const float* const modl = MOD + (size_t)l * NB * 6144; (void)modl;
            if (wave >= 4) __builtin_amdgcn_s_setprio(1);
            gu32* const qctr = (gu32*)(ws + WS_CTL) + 8192 + 64 * l;
            volatile LAS unsigned* const qslot = (volatile LAS unsigned*)(L + MISC_OFF) + 12;
            for (;;) {
                if (tid == 0) *qslot = __hip_atomic_fetch_add(qctr, 1u, __ATOMIC_RELAXED, __HIP_MEMORY_SCOPE_AGENT);
                __syncthreads();
                const int u = (int)*qslot;
                __syncthreads();
                if (u >= 1536) break;
                if (u < 512) {
#if MK_STEP >= 3
                    dsa::unit(L, ws, (unsigned char*)outp, u & 3, 127 - (u >> 2), wave_s);
#endif
                } else {
                    const int r = u - 512, qb = 31 - (r >> 5), bh = r & 31;
                    attn_body::attn_unit<8>(bh >> 3, bh & 7, qb, (const attn_body::bf16*)(ws + WS_QF), (const attn_body::bf16*)(ws + WS_KF), (const attn_body::bf16*)(ws + WS_VF), (attn_body::bf16*)outp + 512,
                                            (const float*)(ws + WS_CUM), (const float*)(ws + WS_CUM + MiB + 4096), (char*)lds, wave_s);
                }
            }
            __builtin_amdgcn_s_setprio(0);
            GRID_BAR();
        }
        if (IN(pb + 4)) {
            PHASE_IDS(); const float* const modl = MOD + (size_t)l * NB * 6144; (void)modl;
            { pg8::Gemm g{(const bf16*)outp, (const bf16*)(ws + WS_WA + l * 2 * WA_L), MTOK, DM, DM}; pg8::StaticOrder S; S.init(MTOK, DM, G, bx);
              pg8::EpiMerge E{H, (const bf16*)(ws + WS_GATES)};
              pg8::gemm_phase<pg8::EpiMerge, pg8::StaticOrder, true, true>(L, g, S, E, wave_s); }
            GRID_BAR();
        }
        if (IN(pb + 5)) {
            PHASE_IDS(); const float* const modl = MOD + (size_t)l * NB * 6144; (void)modl;
            const void* xs = (l == 0) ? (const void*)KIN(KA_PTR(), 0) : (const void*)XB;
            pg8::Gemm g{H, (const bf16*)(ws + WS_WO + l * WO_L), MTOK, DM, DM}; pg8::StaticOrder S; S.init(MTOK, DM, G, bx);
            pg8::EpiResidB E{xs, XB, modl + 2048, l == 0 ? 1 : 0};
            pg8::gemm_phase<pg8::EpiResidB, pg8::StaticOrder, true, true>(L, g, S, E, wave_s);
            GRID_BAR();
        }
#endif
        if (IN(pb + 6)) {
            PHASE_IDS(); const float* const modl = MOD + (size_t)l * NB * 6144; (void)modl;
            const float* g = KIN(KA_PTR(), 6) + (size_t)l * DM;
            constexpr int RPW = MTOK / (256 * NWAVES);
            for (int r0 = gw * RPW; r0 < MTOK; r0 += NGW * RPW) {
                const int b = r0 / SEQ; const float* mb = modl + (size_t)b * 6144;
                f32x4 gv[4], scv[4], shv[4]; load_vec16b(g, lane, gv); load_vec16b(mb + 4096, lane, scv); load_vec16b(mb + 3072, lane, shv);
#pragma unroll
                for (int j = 0; j < 4; ++j) gv[j] = gv[j] * (scv[j] + 1.0f);
                for (int r = r0; r < r0 + RPW; ++r) {
                    f32x4 v[4]; load_row16b(XB + (size_t)r * DM, lane, v); float s = 0.f;
#pragma unroll
                    for (int j = 0; j < 4; ++j) s += (v[j].x * v[j].x + v[j].y * v[j].y) + (v[j].z * v[j].z + v[j].w * v[j].w);
                    const float rstd = rsqrtf(wave_sum(s, lane) * (1.f / DM) + EPS);
                    f32x4 y[4];
#pragma unroll
                    for (int j = 0; j < 4; ++j) y[j] = v[j] * rstd * gv[j] + shv[j];
                    store_row16b(H + (size_t)r * DM, lane, y);
                }
            }
            GRID_BAR();
        }
        if (IN(pb + 7)) {
            PHASE_IDS(); const float* const modl = MOD + (size_t)l * NB * 6144; (void)modl;
            pg8::Gemm g{H, (const bf16*)(ws + WS_WUP + l * WUP_L), MTOK, NUP, DM}; pg8::StaticOrder S; S.init(MTOK, NUP, G, bx);
            const char __attribute__((address_space(4)))* kp = KA_PTR();
            pg8::EpiUpConv E{(bf16*)(ws + WS_ACT), (float*)(ws + WS_UH), (float*)(ws + WS_UT), KIN(kp, 13) + (size_t)l * 3 * NUP, KIN(kp, 14) + (size_t)l * NUP};
            for (int rep = 0; rep < REP_UP; ++rep) pg8::gemm_phase<pg8::EpiUpConv, pg8::StaticOrder, true, true>(L, g, S, E, wave_s);
            GRID_BAR();
        }
        if (IN(pb + 8)) {
            PHASE_IDS(); const float* const modl = MOD + (size_t)l * NB * 6144; (void)modl;
            const float* UH = (const float*)(ws + WS_UH); const float* UT = (const float*)(ws + WS_UT);
            const char __attribute__((address_space(4)))* kp = KA_PTR(); const float* cw = KIN(kp, 13) + (size_t)l * 3 * NUP; const float* cb = KIN(kp, 14) + (size_t)l * NUP;
            bf16* ACT = (bf16*)(ws + WS_ACT);
            for (int it = vcu * NTHR + tid; it < 512 * 2 * (DFF / 4); it += G * NTHR) {
                const int c4 = it % (DFF / 4), rr = (it / (DFF / 4)) & 1, Gq = it / (2 * (DFF / 4));
                const int j = 4 * c4, pn = j >> 7, cl = j & 127, ua = 256 * pn + cl;
                const bool first = (Gq % (SEQ / 64)) == 0;
                const f32x4 z = {0.f, 0.f, 0.f, 0.f};
                f32x4 res;
                f32x4 cv[2];
#pragma unroll
                for (int hb = 0; hb < 2; ++hb) {
                    const int uc = ua + 128 * hb, ch = hb * DFF + j;
                    const f32x4 u0 = *(const GAS f32x4*)(UH + ((size_t)Gq * 2 + rr) * NUP + uc);
                    const f32x4 u1 = rr ? *(const GAS f32x4*)(UH + ((size_t)Gq * 2) * NUP + uc) : (first ? z : *(const GAS f32x4*)(UT + ((size_t)(Gq - 1) * 2 + 1) * NUP + uc));
                    const f32x4 u2 = first ? z : *(const GAS f32x4*)(UT + ((size_t)(Gq - 1) * 2 + (rr ? 1 : 0)) * NUP + uc);
                    cv[hb] = *(const GAS f32x4*)(cb + ch) + *(const GAS f32x4*)(cw + ch) * u2 + *(const GAS f32x4*)(cw + NUP + ch) * u1 + *(const GAS f32x4*)(cw + 2 * NUP + ch) * u0;
                }
#pragma unroll
                for (int i = 0; i < 4; ++i) res[i] = cv[0][i] * pg8::fast_sigmoid(cv[0][i]) * cv[1][i];
                *(GAS unsigned long long*)(ACT + (size_t)(Gq * 64 + rr) * DFF + j) = (unsigned long long)pk2(res[0], res[1]) | ((unsigned long long)pk2(res[2], res[3]) << 32);
            }
            GRID_BAR();
        }
        if (IN(pb + 9)) {
            PHASE_IDS(); const float* const modl = MOD + (size_t)l * NB * 6144; (void)modl;
            pg8::Gemm g{(const bf16*)(ws + WS_ACT), (const bf16*)(ws + WS_WD + l * WD_L), MTOK, DM, DFF}; pg8::StaticOrder S; S.init(MTOK, DM, G, bx);
            pg8::EpiResidB E{(const void*)XB, XB, modl + 5120, 0};
            pg8::gemm_phase<pg8::EpiResidB, pg8::StaticOrder, true, true>(L, g, S, E, wave_s);
            GRID_BAR();
        }
    }
    if (IN(PH_FINAL)) {
        const int l = 0; PHASE_IDS(); const float* const modl = MOD + (size_t)l * NB * 6144; (void)modl;
        f32x4 gv[4]; load_vec16b(KIN(KA_PTR(), 16), lane, gv);
        for (int r = gw; r < MTOK; r += NGW) {
            f32x4 v[4]; load_row16b(XB + (size_t)r * DM, lane, v); float s = 0.f;
#pragma unroll
            for (int j = 0; j < 4; ++j) s += (v[j].x * v[j].x + v[j].y * v[j].y) + (v[j].z * v[j].z + v[j].w * v[j].w);
            const float rstd = rsqrtf(wave_sum(s, lane) * (1.f / DM) + EPS);
#pragma unroll
            for (int j = 0; j < 2; ++j) { *(GAS f32x4*)(outp + (size_t)r * DM + 512 * j + 8 * lane) = v[2 * j] * rstd * gv[2 * j]; *(GAS f32x4*)(outp + (size_t)r * DM + 512 * j + 8 * lane + 4) = v[2 * j + 1] * rstd * gv[2 * j + 1]; }
        }
    }
#undef IN
#undef GRID_BAR
}

extern "C" void kernel_launch(void* const* d_in, const int* in_sizes, int n_in, void* d_out, int out_size, void* d_ws, size_t ws_size, hipStream_t stream) {
    static int grid = 0;
    if (grid == 0) {
        if (n_in != 17 || out_size != MTOK * DM || ws_size < WS_END) { fprintf(stderr, "kernel_launch: unexpected problem (n_in %d, out %d, ws %zu)\n", n_in, out_size, ws_size); grid = -1; return; }
        int dev = 0, cus = 0, per_cu = 0;
        if (hipGetDevice(&dev) != hipSuccess || hipDeviceGetAttribute(&cus, hipDeviceAttributeMultiprocessorCount, dev) != hipSuccess) { grid = -1; return; }
        if (hipFuncSetAttribute((const void*)mk_fwd, hipFuncAttributeMaxDynamicSharedMemorySize, LDS_BYTES) != hipSuccess) { fprintf(stderr, "kernel_launch: hipFuncSetAttribute failed\n"); grid = -1; return; }
        if (hipOccupancyMaxActiveBlocksPerMultiprocessor(&per_cu, (const void*)mk_fwd, NTHR, LDS_BYTES) != hipSuccess || per_cu < 1) { fprintf(stderr, "kernel_launch: occupancy query says %d\n", per_cu); (void)hipGetLastError(); grid = -1; return; }
        grid = cus;
    }
    if (grid < 0) return;
    (void)hipMemsetAsync((char*)d_ws + WS_CTL, 0, CTL_ZERO_BYTES, stream);
    Args a{};
    for (int i = 0; i < 17; ++i) a.in[i] = (const float*)d_in[i];
    a.out = (float*)d_out; a.ws = (unsigned char*)d_ws; a.pad = 0;
#if MK_ONE_LAUNCH
    a.ph_lo = 0; a.ph_hi = N_PHASES; a.use_bar = 1;
    hipLaunchKernelGGL(mk_fwd, dim3(grid), dim3(NTHR), LDS_BYTES, stream, a);
#else
    for (int p = 0; p < N_PHASES; ++p) { a.ph_lo = p; a.ph_hi = p + 1; a.use_bar = 0; hipLaunchKernelGGL(mk_fwd, dim3(grid), dim3(NTHR), LDS_BYTES, stream, a); }
#endif
}
```

```cpp
#include <hip/hip_runtime.h>
#include <cstdio>
#include <cstdint>

constexpr int DM = 1024, NB = 4, SEQ = 8192, MTOK = NB * SEQ, DEPTH = 2;
constexpr int NIN_SRC = 4816, NIN = 4864;
constexpr int DFF = 2816, NUP = 2 * DFF;
constexpr int WSP = 512;
constexpr float EPS = 1e-6f;
constexpr float LOG2E = 1.4426950408889634f;
constexpr float C2 = 0.125f * LOG2E;


__device__ __forceinline__ float lane_read(float v, int src_lane) { return __builtin_bit_cast(float, __builtin_amdgcn_ds_bpermute(src_lane << 2, __builtin_bit_cast(int, v))); }
__device__ __forceinline__ unsigned lane_read_u(unsigned v, int src_lane) { return (unsigned)__builtin_amdgcn_ds_bpermute(src_lane << 2, (int)v); }

constexpr size_t MiB = 1u << 20;
constexpr size_t WS_CTL = 0, CTL_ZERO_BYTES = 1 * MiB;
constexpr size_t WS_MOD = 1 * MiB;
constexpr size_t WS_CS = 2 * MiB;
constexpr size_t WS_WIN = 4 * MiB, WIN_L = (size_t)NIN * DM * 2;
constexpr size_t WS_WA = 23 * MiB, WA_L = (size_t)DM * WSP * 2;
constexpr size_t WS_WB = 25 * MiB;
constexpr size_t WS_WO = 27 * MiB, WO_L = (size_t)DM * DM * 2;
constexpr size_t WS_WUP = 31 * MiB, WUP_L = (size_t)NUP * DM * 2;
constexpr size_t WS_WD = 53 * MiB, WD_L = (size_t)DM * DFF * 2;
constexpr size_t WS_H = 64 * MiB;
constexpr size_t WS_QA = 128 * MiB, WS_QF = 160 * MiB, WS_QI = 192 * MiB, WS_KF = 224 * MiB, WS_VF = 256 * MiB;
constexpr int GLD = 2080;
constexpr size_t WS_GATES = 288 * MiB;
constexpr size_t WS_KA = 419 * MiB, WS_VA = 423 * MiB, WS_KI = 427 * MiB, WS_WI = 431 * MiB, WS_LOGF = 432 * MiB, WS_CUM = 433 * MiB;
constexpr size_t WS_XB = 436 * MiB;
constexpr size_t WS_ACT = 128 * MiB;
constexpr size_t WS_UH = 304 * MiB, WS_UT = 326 * MiB;
constexpr size_t WS_END = 500 * MiB;
static_assert(WS_GATES + (size_t)MTOK * GLD * 2 <= WS_KA && WS_CUM + 2 * MiB <= WS_XB, "projection map");
static_assert(WS_WIN + 2 * WIN_L <= WS_WA && WS_WUP + 2 * WUP_L <= WS_WD && WS_WD + 2 * WD_L <= WS_H, "weight map");
static_assert(WS_ACT + (size_t)MTOK * DFF * 2 <= WS_UH && WS_UH + (size_t)512 * 2 * NUP * 4 <= WS_UT && WS_UT + (size_t)512 * 2 * NUP * 4 <= WS_GATES + 128 * MiB, "ffn map");
constexpr int CW_TMO = 0, CW_CODE = 1, CW_BAR = 4096;


namespace pg8 {
#define PG8_LAS __attribute__((address_space(3)))
typedef unsigned short bf16_t;
typedef short bf16x8 __attribute__((ext_vector_type(8)));
typedef float f32x4 __attribute__((ext_vector_type(4)));
typedef unsigned u32x4 __attribute__((ext_vector_type(4)));
constexpr int BM = 256, BK = 64, HALF = 128, HTB = HALF * BK * 2  , STAGE_BYTES = 8 * HTB, NXCD = 8, WGM = 8;

__host__ __device__ __forceinline__ int lds_byte(int r, int c) { const int st = (r >> 4) * 2 + (c >> 5), rr = r & 15, cc = c & 31, ob = rr * 64 + cc * 2; return st * 1024 + (ob ^ (((ob >> 9) & 1) << 5)); }
__host__ __device__ __forceinline__ void stage_rc(int b, int& R, int& C) { const int st = b / 1024, sb = b % 1024, swz = sb ^ (((sb >> 9) & 1) << 5); R = (st >> 1) * 16 + swz / 64; C = (st & 1) * 32 + (swz % 64) / 2; }
__host__ __device__ __forceinline__ int perm32(int rho) { const int n = rho >> 4, i = rho & 15; return 8 * (i >> 2) + 4 * n + (i & 3); }

struct Unit { int pm, pn, hs; };
struct Gemm { const bf16_t* A; const bf16_t* Bt; int M, N, K; };

struct StaticOrder {
    int nM, nN, nwg, G, c;
    __host__ __device__ void init(int M, int N, int G_, int c_) { nM = M / BM; nN = N / BM; nwg = nM * nN; G = G_; c = c_; }
    __host__ __device__ __forceinline__ bool next(int i, Unit& u) const {
        const long L = (long)i * G + c; if (L >= nwg) return false;
        int wgid = (int)L; { const int q = nwg / NXCD, r = nwg % NXCD, xcd = wgid % NXCD, off = wgid / NXCD; wgid = (xcd < r ? xcd * (q + 1) : r * (q + 1) + (xcd - r) * q) + off; }
        const int nig = WGM * nN, gid = wgid / nig, fm = gid * WGM, gsz = (nM - fm) < WGM ? (nM - fm) : WGM;
        u.pm = fm + ((wgid % nig) % gsz); u.pn = (wgid % nig) / gsz; u.hs = 0; return true;
    }
    __device__ __forceinline__ void a_ready(const Unit&) const {}
    __device__ __forceinline__ void done(const Unit&) const {}
};

struct HalfTailOrder {
    int nM, nN, nwg, G, c;
    __host__ __device__ void init(int M, int N, int G_, int c_) { nM = M / BM; nN = N / BM; nwg = nM * nN; G = G_; c = c_; }
    __host__ __device__ __forceinline__ bool next(int i, Unit& u) const {
        const int full = nwg / G, rem = nwg % G; long L; int hs = 0;
        if (i < full) L = (long)i * G + c;
        else if (i == full && rem > 0 && 2 * rem == G) { L = (long)full * G + (c % rem); hs = 1 + c / rem; }
        else if (i == full && c < rem) L = (long)full * G + c;
        else return false;
        int wgid = (int)L; { const int q = nwg / NXCD, r = nwg % NXCD, xcd = wgid % NXCD, off = wgid / NXCD; wgid = (xcd < r ? xcd * (q + 1) : r * (q + 1) + (xcd - r) * q) + off; }
        const int nig = WGM * nN, gid = wgid / nig, fm = gid * WGM, gsz = (nM - fm) < WGM ? (nM - fm) : WGM;
        u.pm = fm + ((wgid % nig) % gsz); u.pn = (wgid % nig) / gsz; u.hs = hs; return true;
    }
    __device__ __forceinline__ void a_ready(const Unit&) const {}
    __device__ __forceinline__ void done(const Unit&) const {}
};

typedef float f32x2_cv __attribute__((ext_vector_type(2))); typedef __bf16 bf16x2_cv __attribute__((ext_vector_type(2)));
__device__ __forceinline__ unsigned cvt_pk_bf16(float lo, float hi) { const f32x2_cv v = {lo, hi}; const bf16x2_cv b = __builtin_convertvector(v, bf16x2_cv); return __builtin_bit_cast(unsigned, b); }

typedef float f32x2 __attribute__((ext_vector_type(2)));
typedef unsigned u32x2 __attribute__((ext_vector_type(2)));
#define PG8_GAS __attribute__((address_space(1)))
__device__ __forceinline__ float fast_sigmoid(float z) { return __builtin_amdgcn_rcpf(1.f + __builtin_amdgcn_exp2f(-z * 1.4426950408889634f)); }
__device__ __forceinline__ u32x4 pack8(const f32x4& v0, const f32x4& v1) { u32x4 w; w.x = cvt_pk_bf16(v0[0], v0[1]); w.y = cvt_pk_bf16(v0[2], v0[3]); w.z = cvt_pk_bf16(v1[0], v1[1]); w.w = cvt_pk_bf16(v1[2], v1[3]); return w; }

struct EpiInProj {
    static constexpr bool PERM = true, AFTER_DRAIN = false, MIDK = false;
    unsigned char* ws; const float* CS; const float* fbias;
    enum { K_PLAIN = 0, K_ROPE = 1, K_SIG = 2, K_SMALL = 3, K_NONE = 4 };
    __device__ __forceinline__ void operator()(const f32x4 (&acc)[2][2][4][2], const Unit& u, int wr, int wc, int fr_, int fq_) const {
        int fr = fr_, fq = fq_; asm volatile("" : "+v"(fr), "+v"(fq));
        const int row0 = u.pm * BM + (u.hs == 2 ? HALF : 0) + wr * 64 + fr, pn = u.pn;
        const int nai = u.hs ? 1 : 2;
#pragma unroll
        for (int bj = 0; bj < 2; ++bj) {
            const int cg = 128 * bj + 32 * wc;
            int kind = K_PLAIN; size_t off = 0; int ld = 512, dcol = 0; float sc = 1.f;
            if (pn < 2)       { off = WS_QA; dcol = 256 * pn + cg; kind = (cg & 32) ? K_PLAIN : K_ROPE; sc = C2; }
            else if (pn == 2) {
                ld = 64;
                if (cg < 64)       { off = WS_KA; dcol = cg; kind = (cg == 0) ? K_ROPE : K_PLAIN; }
                else if (cg < 128) { off = WS_VA; dcol = cg - 64; }
                else if (cg < 192) { off = WS_KI; dcol = cg - 128; kind = (cg == 128) ? K_ROPE : K_PLAIN; }
                else kind = (cg == 192) ? K_SMALL : K_NONE;
            }
            else if (pn < 5)  { off = WS_QI; dcol = 256 * (pn - 3) + cg; kind = (cg & 32) ? K_PLAIN : K_ROPE; }
            else if (pn < 7)  { off = WS_QF; dcol = 256 * (pn - 5) + cg; sc = C2; }
            else if (pn < 9)  { off = WS_KF; dcol = 256 * (pn - 7) + cg; }
            else if (pn < 11) { off = WS_VF; dcol = 256 * (pn - 9) + cg; }
            else              { off = WS_GATES; ld = GLD; dcol = 256 * (pn - 11) + cg; kind = K_SIG; }
            kind = __builtin_amdgcn_readfirstlane(kind);
            if (kind == K_NONE) continue;
            if (kind == K_SMALL) {
                PG8_GAS float* p = (PG8_GAS float*)(ws + (fq == 0 ? WS_WI : WS_LOGF)) + (size_t)row0 * 8;
                const f32x4 fb0 = *(const PG8_GAS f32x4*)(fbias), fb1 = *(const PG8_GAS f32x4*)(fbias + 4);
#pragma unroll
                for (int ai = 0; ai < nai; ++ai)
#pragma unroll
                    for (int m = 0; m < 4; ++m) {
                        const f32x4 v0 = acc[ai][bj][m][0], v1 = acc[ai][bj][m][1];
                        const f32x4 z0 = v0 + fb0, z1 = v1 + fb1; f32x4 l0, l1;
#pragma unroll
                        for (int i = 0; i < 4; ++i) { l0[i] = fminf(z0[i], 0.f) - log1pf(__expf(-fabsf(z0[i]))); l1[i] = fminf(z1[i], 0.f) - log1pf(__expf(-fabsf(z1[i]))); }
                        const float s8 = 0.35355339059327373f;
                        const f32x4 o0 = (fq == 0) ? v0 * s8 : l0, o1 = (fq == 0) ? v1 * s8 : l1;
                        if (fq < 2) { *(PG8_GAS f32x4*)p = o0; *(PG8_GAS f32x4*)(p + 4) = o1; }
                        p += ((m < 3) ? 16 : (HALF - 48)) * 8; asm volatile("" : "+v"(p));
                    }
                continue;
            }
            PG8_GAS bf16_t* p = (PG8_GAS bf16_t*)(ws + off) + (size_t)row0 * ld + dcol + 8 * fq;
            if (kind == K_ROPE) {
                const int f4 = 4 * (fq & 1);
                const PG8_GAS float* cp = (const PG8_GAS float*)CS + (size_t)row0 * 16 + 2 * f4;
                PG8_GAS bf16_t* ph = p - 8 * fq;
                f32x4 cs0 = *(const PG8_GAS f32x4*)cp, cs1 = *(const PG8_GAS f32x4*)(cp + 4);
#pragma unroll
                for (int ai = 0; ai < nai; ++ai)
#pragma unroll
                    for (int m = 0; m < 4; ++m) {
                        const int adv = (m < 3) ? 16 : (HALF - 48);
                        const bool lastrow = (ai == 1 && m == 3);
                        const PG8_GAS float* cpn = cp + (lastrow ? 0 : adv * 16);
                        const f32x4 ns0 = *(const PG8_GAS f32x4*)cpn, ns1 = *(const PG8_GAS f32x4*)(cpn + 4);
                        const f32x4 v0 = acc[ai][bj][m][0] * sc, v1 = acc[ai][bj][m][1] * sc;
                        f32x4 o1, o2;
                        o1[0] = v0[0] * cs0[0] - v1[0] * cs0[1]; o2[0] = v1[0] * cs0[0] + v0[0] * cs0[1];
                        o1[1] = v0[1] * cs0[2] - v1[1] * cs0[3]; o2[1] = v1[1] * cs0[2] + v0[1] * cs0[3];
                        o1[2] = v0[2] * cs1[0] - v1[2] * cs1[1]; o2[2] = v1[2] * cs1[0] + v0[2] * cs1[1];
                        o1[3] = v0[3] * cs1[2] - v1[3] * cs1[3]; o2[3] = v1[3] * cs1[2] + v0[3] * cs1[3];
                        u32x2 w1, w2; w1.x = cvt_pk_bf16(o1[0], o1[1]); w1.y = cvt_pk_bf16(o1[2], o1[3]); w2.x = cvt_pk_bf16(o2[0], o2[1]); w2.y = cvt_pk_bf16(o2[2], o2[3]);
                        if (fq < 2) { *(PG8_GAS u32x2*)(ph + f4) = w1; *(PG8_GAS u32x2*)(ph + 8 + f4) = w2; }
                        else *(PG8_GAS u32x4*)p = pack8(v0, v1);
                        p += (size_t)adv * ld; ph += (size_t)adv * ld; cp = cpn; cs0 = ns0; cs1 = ns1; asm volatile("" : "+v"(p), "+v"(ph), "+v"(cp));
                    }
            } else if (kind == K_SIG) {
#pragma unroll
                for (int ai = 0; ai < nai; ++ai)
#pragma unroll
                    for (int m = 0; m < 4; ++m) {
                        f32x4 v0 = acc[ai][bj][m][0], v1 = acc[ai][bj][m][1];
#pragma unroll
                        for (int i = 0; i < 4; ++i) { v0[i] = fast_sigmoid(v0[i]); v1[i] = fast_sigmoid(v1[i]); }
                        *(PG8_GAS u32x4*)p = pack8(v0, v1);
                        p += (size_t)((m < 3) ? 16 : (HALF - 48)) * ld; asm volatile("" : "+v"(p));
                    }
            } else {
#pragma unroll
                for (int ai = 0; ai < nai; ++ai)
#pragma unroll
                    for (int m = 0; m < 4; ++m) {
                        *(PG8_GAS u32x4*)p = pack8(acc[ai][bj][m][0] * sc, acc[ai][bj][m][1] * sc);
                        p += (size_t)((m < 3) ? 16 : (HALF - 48)) * ld; asm volatile("" : "+v"(p));
                    }
            }
        }
    }
};

template <int MODE> struct EpiGate {
    static constexpr bool PERM = true, AFTER_DRAIN = false, MIDK = false;
    bf16_t* O; const bf16_t* T; const bf16_t* G; int ldg;
    __device__ __forceinline__ void operator()(const f32x4 (&acc)[2][2][4][2], const Unit& u, int wr, int wc, int fr_, int fq_) const {
        int fr = fr_, fq = fq_; asm volatile("" : "+v"(fr), "+v"(fq));
        const int row0 = u.pm * BM + wr * 64 + fr, col0 = u.pn * BM + wc * 32 + 8 * fq;
        const PG8_GAS bf16_t* gp = (const PG8_GAS bf16_t*)G + (size_t)row0 * ldg + col0; const PG8_GAS bf16_t* tp = (const PG8_GAS bf16_t*)T + (size_t)row0 * DM + col0;
        PG8_GAS bf16_t* op = (PG8_GAS bf16_t*)O + (size_t)row0 * DM + col0;
        u32x4 gw[2], tw[2];
#pragma unroll
        for (int bj = 0; bj < 2; ++bj) { gw[bj] = *(const PG8_GAS u32x4*)(gp + bj * HALF); if (MODE == 1) tw[bj] = *(const PG8_GAS u32x4*)(tp + bj * HALF); }
#pragma unroll
        for (int ai = 0; ai < 2; ++ai)
#pragma unroll
            for (int m = 0; m < 4; ++m) {
                const int adv = (m < 3) ? 16 : (HALF - 48); const bool lastrow = (ai == 1 && m == 3);
                const PG8_GAS bf16_t* gpn = gp + (lastrow ? 0 : (size_t)adv * ldg); const PG8_GAS bf16_t* tpn = tp + (lastrow ? 0 : (size_t)adv * DM);
                u32x4 gn[2], tn[2];
#pragma unroll
                for (int bj = 0; bj < 2; ++bj) { gn[bj] = *(const PG8_GAS u32x4*)(gpn + bj * HALF); if (MODE == 1) tn[bj] = *(const PG8_GAS u32x4*)(tpn + bj * HALF); }
#pragma unroll
                for (int bj = 0; bj < 2; ++bj) {
                    f32x4 v0 = acc[ai][bj][m][0], v1 = acc[ai][bj][m][1];
                    v0[0] *= __uint_as_float(gw[bj].x << 16); v0[1] *= __uint_as_float(gw[bj].x & 0xffff0000u); v0[2] *= __uint_as_float(gw[bj].y << 16); v0[3] *= __uint_as_float(gw[bj].y & 0xffff0000u);
                    v1[0] *= __uint_as_float(gw[bj].z << 16); v1[1] *= __uint_as_float(gw[bj].z & 0xffff0000u); v1[2] *= __uint_as_float(gw[bj].w << 16); v1[3] *= __uint_as_float(gw[bj].w & 0xffff0000u);
                    if (MODE == 1) {
                        v0[0] += __uint_as_float(tw[bj].x << 16); v0[1] += __uint_as_float(tw[bj].x & 0xffff0000u); v0[2] += __uint_as_float(tw[bj].y << 16); v0[3] += __uint_as_float(tw[bj].y & 0xffff0000u);
                        v1[0] += __uint_as_float(tw[bj].z << 16); v1[1] += __uint_as_float(tw[bj].z & 0xffff0000u); v1[2] += __uint_as_float(tw[bj].w << 16); v1[3] += __uint_as_float(tw[bj].w & 0xffff0000u); }
                    *(PG8_GAS u32x4*)(op + bj * HALF) = pack8(v0, v1); }
                op += (size_t)adv * DM; gp = gpn; tp = tpn; gw[0] = gn[0]; gw[1] = gn[1]; if (MODE == 1) { tw[0] = tn[0]; tw[1] = tn[1]; }
                asm volatile("" : "+v"(op), "+v"(gp), "+v"(tp));
            }
    }
};


struct EpiMerge {
    static constexpr bool PERM = true, AFTER_DRAIN = false, MIDK = true;
    bf16_t* O; const bf16_t* G;
    static __device__ __forceinline__ constexpr int roff(int r) { return (r >> 2) * HALF + (r & 3) * 16; }
    __device__ __forceinline__ void mid(f32x4 (&acc)[2][2][4][2], const Unit& u, int wr, int wc, int fr_, int fq_) const {
        int fr = fr_, fq = fq_; asm volatile("" : "+v"(fr), "+v"(fq));
        const PG8_GAS bf16_t* gp = (const PG8_GAS bf16_t*)G + (size_t)(u.pm * BM + wr * 64 + fr) * GLD + u.pn * BM + wc * 32 + 8 * fq;
        u32x4 ga[4][2], gb[4][2];
#pragma unroll
        for (int r = 0; r < 4; ++r)
#pragma unroll
            for (int bj = 0; bj < 2; ++bj) { ga[r][bj] = *(const PG8_GAS u32x4*)(gp + (size_t)roff(r) * GLD + bj * HALF); gb[r][bj] = *(const PG8_GAS u32x4*)(gp + (size_t)roff(r) * GLD + 1024 + bj * HALF); }
#pragma unroll
        for (int r = 0; r < 8; ++r) {
            const int ai = r >> 2, m = r & 3, s = r & 3;
#pragma unroll
            for (int bj = 0; bj < 2; ++bj) {
                const unsigned gaw[4] = {ga[s][bj].x, ga[s][bj].y, ga[s][bj].z, ga[s][bj].w}, gbw[4] = {gb[s][bj].x, gb[s][bj].y, gb[s][bj].z, gb[s][bj].w};
#pragma unroll
                for (int i = 0; i < 4; ++i) {
                    const float r0 = __uint_as_float(gaw[i] << 16) * __builtin_amdgcn_rcpf(fmaxf(__uint_as_float(gbw[i] << 16), 1e-20f)), r1 = __uint_as_float(gaw[i] & 0xffff0000u) * __builtin_amdgcn_rcpf(fmaxf(__uint_as_float(gbw[i] & 0xffff0000u), 1e-20f));
                    acc[ai][bj][m][i >> 1][2 * (i & 1)] *= r0; acc[ai][bj][m][i >> 1][2 * (i & 1) + 1] *= r1; }
            }
            if (r < 4) {
#pragma unroll
                for (int bj = 0; bj < 2; ++bj) { ga[s][bj] = *(const PG8_GAS u32x4*)(gp + (size_t)roff(r + 4) * GLD + bj * HALF); gb[s][bj] = *(const PG8_GAS u32x4*)(gp + (size_t)roff(r + 4) * GLD + 1024 + bj * HALF); }
            }
        }
    }
    __device__ __forceinline__ void operator()(const f32x4 (&acc)[2][2][4][2], const Unit& u, int wr, int wc, int fr_, int fq_) const {
        int fr = fr_, fq = fq_; asm volatile("" : "+v"(fr), "+v"(fq));
        const int row0 = u.pm * BM + wr * 64 + fr, col0 = u.pn * BM + wc * 32 + 8 * fq;
        const PG8_GAS bf16_t* gp = (const PG8_GAS bf16_t*)G + (size_t)row0 * GLD + 1024 + col0; PG8_GAS bf16_t* op = (PG8_GAS bf16_t*)O + (size_t)row0 * DM + col0;
        u32x4 gw[8][2];
#pragma unroll
        for (int r = 0; r < 8; ++r)
#pragma unroll
            for (int bj = 0; bj < 2; ++bj) gw[r][bj] = *(const PG8_GAS u32x4*)(gp + (size_t)roff(r) * GLD + bj * HALF);
#pragma unroll
        for (int r = 0; r < 8; ++r) {
            const int ai = r >> 2, m = r & 3;
#pragma unroll
            for (int bj = 0; bj < 2; ++bj) {
                f32x4 v0 = acc[ai][bj][m][0], v1 = acc[ai][bj][m][1];
                v0[0] *= fmaxf(__uint_as_float(gw[r][bj].x << 16), 1e-20f); v0[1] *= fmaxf(__uint_as_float(gw[r][bj].x & 0xffff0000u), 1e-20f); v0[2] *= fmaxf(__uint_as_float(gw[r][bj].y << 16), 1e-20f); v0[3] *= fmaxf(__uint_as_float(gw[r][bj].y & 0xffff0000u), 1e-20f);
                v1[0] *= fmaxf(__uint_as_float(gw[r][bj].z << 16), 1e-20f); v1[1] *= fmaxf(__uint_as_float(gw[r][bj].z & 0xffff0000u), 1e-20f); v1[2] *= fmaxf(__uint_as_float(gw[r][bj].w << 16), 1e-20f); v1[3] *= fmaxf(__uint_as_float(gw[r][bj].w & 0xffff0000u), 1e-20f);
                *(PG8_GAS u32x4*)(op + (size_t)roff(r) * DM + bj * HALF) = pack8(v0, v1); }
        }
    }
};

struct EpiResid {
    static constexpr bool PERM = false, AFTER_DRAIN = false, MIDK = false;
    const float* SRC; float* OUT; const float* gate;
    __device__ __forceinline__ void operator()(const f32x4 (&acc)[2][2][4][2], const Unit& u, int wr, int wc, int fr_, int fq_) const {
        int fr = fr_, fq = fq_; asm volatile("" : "+v"(fr), "+v"(fq));
        const int row0 = u.pm * BM + wr * 64 + fr, col0 = u.pn * BM + wc * 32 + 4 * fq;
        const float* gb = gate + (size_t)(u.pm / (SEQ / BM)) * 6144 + col0;
        f32x4 g[2][2];
#pragma unroll
        for (int bj = 0; bj < 2; ++bj) { g[bj][0] = *(const PG8_GAS f32x4*)(gb + bj * HALF); g[bj][1] = *(const PG8_GAS f32x4*)(gb + bj * HALF + 16); }
        const PG8_GAS float* sp = (const PG8_GAS float*)SRC + (size_t)row0 * DM + col0; PG8_GAS float* op = (PG8_GAS float*)OUT + (size_t)row0 * DM + col0;
        f32x4 sv[2][2];
#pragma unroll
        for (int bj = 0; bj < 2; ++bj) { sv[bj][0] = *(const PG8_GAS f32x4*)(sp + bj * HALF); sv[bj][1] = *(const PG8_GAS f32x4*)(sp + bj * HALF + 16); }
#pragma unroll
        for (int ai = 0; ai < 2; ++ai)
#pragma unroll
            for (int m = 0; m < 4; ++m) {
                const int adv = (m < 3) ? 16 : (HALF - 48); const bool lastrow = (ai == 1 && m == 3);
                const PG8_GAS float* spn = sp + (lastrow ? 0 : (size_t)adv * DM);
                f32x4 sn[2][2];
#pragma unroll
                for (int bj = 0; bj < 2; ++bj) { sn[bj][0] = *(const PG8_GAS f32x4*)(spn + bj * HALF); sn[bj][1] = *(const PG8_GAS f32x4*)(spn + bj * HALF + 16); }
#pragma unroll
                for (int bj = 0; bj < 2; ++bj) {
                    *(PG8_GAS f32x4*)(op + bj * HALF) = sv[bj][0] + g[bj][0] * acc[ai][bj][m][0];
                    *(PG8_GAS f32x4*)(op + bj * HALF + 16) = sv[bj][1] + g[bj][1] * acc[ai][bj][m][1]; }
                op += (size_t)adv * DM; sp = spn;
#pragma unroll
                for (int bj = 0; bj < 2; ++bj) { sv[bj][0] = sn[bj][0]; sv[bj][1] = sn[bj][1]; }
                asm volatile("" : "+v"(op), "+v"(sp));
            }
    }
};

struct EpiResidB {
    static constexpr bool PERM = true, AFTER_DRAIN = false, MIDK = false;
    const void* SRC; bf16_t* OUT; const float* gate; int src_f32;
    __device__ __forceinline__ void operator()(const f32x4 (&acc)[2][2][4][2], const Unit& u, int wr, int wc, int fr_, int fq_) const {
        int fr = fr_, fq = fq_; asm volatile("" : "+v"(fr), "+v"(fq));
        const int row0 = u.pm * BM + wr * 64 + fr, col0 = u.pn * BM + wc * 32 + 8 * fq;
        const float* gb = gate + (size_t)(u.pm / (SEQ / BM)) * 6144 + col0;
        f32x4 g[2][2];
#pragma unroll
        for (int bj = 0; bj < 2; ++bj) { g[bj][0] = *(const PG8_GAS f32x4*)(gb + bj * HALF); g[bj][1] = *(const PG8_GAS f32x4*)(gb + bj * HALF + 4); }
        PG8_GAS bf16_t* op = (PG8_GAS bf16_t*)OUT + (size_t)row0 * DM + col0;
        if (src_f32) {
            const PG8_GAS float* sp = (const PG8_GAS float*)SRC + (size_t)row0 * DM + col0;
            f32x4 sv[2][2];
#pragma unroll
            for (int bj = 0; bj < 2; ++bj) { sv[bj][0] = *(const PG8_GAS f32x4*)(sp + bj * HALF); sv[bj][1] = *(const PG8_GAS f32x4*)(sp + bj * HALF + 4); }
#pragma unroll
            for (int ai = 0; ai < 2; ++ai)
#pragma unroll
                for (int m = 0; m < 4; ++m) {
                    const int adv = (m < 3) ? 16 : (HALF - 48); const bool lastrow = (ai == 1 && m == 3);
                    const PG8_GAS float* spn = sp + (lastrow ? 0 : (size_t)adv * DM);
                    f32x4 sn[2][2];
#pragma unroll
                    for (int bj = 0; bj < 2; ++bj) { sn[bj][0] = *(const PG8_GAS f32x4*)(spn + bj * HALF); sn[bj][1] = *(const PG8_GAS f32x4*)(spn + bj * HALF + 4); }
#pragma unroll
                    for (int bj = 0; bj < 2; ++bj) *(PG8_GAS u32x4*)(op + bj * HALF) = pack8(sv[bj][0] + g[bj][0] * acc[ai][bj][m][0], sv[bj][1] + g[bj][1] * acc[ai][bj][m][1]);
                    op += (size_t)adv * DM; sp = spn;
#pragma unroll
                    for (int bj = 0; bj < 2; ++bj) { sv[bj][0] = sn[bj][0]; sv[bj][1] = sn[bj][1]; }
                    asm volatile("" : "+v"(op), "+v"(sp));
                }
        } else {
            const PG8_GAS bf16_t* sp = (const PG8_GAS bf16_t*)SRC + (size_t)row0 * DM + col0;
            u32x4 sv[2];
#pragma unroll
            for (int bj = 0; bj < 2; ++bj) sv[bj] = *(const PG8_GAS u32x4*)(sp + bj * HALF);
#pragma unroll
            for (int ai = 0; ai < 2; ++ai)
#pragma unroll
                for (int m = 0; m < 4; ++m) {
                    const int adv = (m < 3) ? 16 : (HALF - 48); const bool lastrow = (ai == 1 && m == 3);
                    const PG8_GAS bf16_t* spn = sp + (lastrow ? 0 : (size_t)adv * DM);
                    u32x4 sn[2];
#pragma unroll
                    for (int bj = 0; bj < 2; ++bj) sn[bj] = *(const PG8_GAS u32x4*)(spn + bj * HALF);
#pragma unroll
                    for (int bj = 0; bj < 2; ++bj) {
                        const f32x4 s0 = {__uint_as_float(sv[bj].x << 16), __uint_as_float(sv[bj].x & 0xffff0000u), __uint_as_float(sv[bj].y << 16), __uint_as_float(sv[bj].y & 0xffff0000u)};
                        const f32x4 s1 = {__uint_as_float(sv[bj].z << 16), __uint_as_float(sv[bj].z & 0xffff0000u), __uint_as_float(sv[bj].w << 16), __uint_as_float(sv[bj].w & 0xffff0000u)};
                        *(PG8_GAS u32x4*)(op + bj * HALF) = pack8(s0 + g[bj][0] * acc[ai][bj][m][0], s1 + g[bj][1] * acc[ai][bj][m][1]); }
                    op += (size_t)adv * DM; sp = spn; sv[0] = sn[0]; sv[1] = sn[1];
                    asm volatile("" : "+v"(op), "+v"(sp));
                }
        }
    }
};

__device__ __forceinline__ float dpp_shr1(float old, float src) { return __builtin_bit_cast(float, __builtin_amdgcn_update_dpp(__builtin_bit_cast(int, old), __builtin_bit_cast(int, src), 0x111, 0xf, 0xf, false)); }
__device__ __forceinline__ float dpp_shr2(float old, float src) { return __builtin_bit_cast(float, __builtin_amdgcn_update_dpp(__builtin_bit_cast(int, old), __builtin_bit_cast(int, src), 0x112, 0xf, 0xf, false)); }
__device__ __forceinline__ float dpp_ror1(float src) { return __builtin_bit_cast(float, __builtin_amdgcn_update_dpp(0, __builtin_bit_cast(int, src), 0x121, 0xf, 0xf, false)); }
__device__ __forceinline__ float dpp_ror2(float src) { return __builtin_bit_cast(float, __builtin_amdgcn_update_dpp(0, __builtin_bit_cast(int, src), 0x122, 0xf, 0xf, false)); }
struct EpiUpConv {
    static constexpr bool PERM = true, AFTER_DRAIN = false, MIDK = false;
    bf16_t* ACT; float* UH; float* UT; const float* cw; const float* cb;
    __device__ __forceinline__ void operator()(const f32x4 (&acc)[2][2][4][2], const Unit& u, int wr, int wc, int fr_, int fq_) const {
        int fr = fr_, fq = fq_; asm volatile("" : "+v"(fr), "+v"(fq));
        const int row0 = u.pm * BM + wr * 64 + fr, cl = wc * 32 + 8 * fq;
        const int jc = u.pn * HALF + cl;
#pragma unroll
        for (int n = 0; n < 2; ++n) {
            const float* cwp = cw + jc + 4 * n; asm volatile("" : "+v"(cwp));
            const f32x4 wa0 = *(const PG8_GAS f32x4*)(cwp), wa1 = *(const PG8_GAS f32x4*)(cwp + NUP), wa2 = *(const PG8_GAS f32x4*)(cwp + 2 * NUP), ba = *(const PG8_GAS f32x4*)(cb + jc + 4 * n);
            const f32x4 wb0 = *(const PG8_GAS f32x4*)(cwp + DFF), wb1 = *(const PG8_GAS f32x4*)(cwp + NUP + DFF), wb2 = *(const PG8_GAS f32x4*)(cwp + 2 * NUP + DFF), bb = *(const PG8_GAS f32x4*)(cb + DFF + jc + 4 * n);
            bf16_t* ap = ACT + (size_t)row0 * DFF + jc + 4 * n;
#pragma unroll
            for (int ai = 0; ai < 2; ++ai) {
#pragma unroll
                for (int m = 0; m < 4; ++m) {
                    const f32x4 a = acc[ai][0][m][n], b = acc[ai][1][m][n];
                    const f32x4 z4 = {0.f, 0.f, 0.f, 0.f};
                    const f32x4 ap_ = (m > 0) ? acc[ai][0][m > 0 ? m - 1 : 0][n] : z4, bp_ = (m > 0) ? acc[ai][1][m > 0 ? m - 1 : 0][n] : z4;
                    f32x4 res;
#pragma unroll
                    for (int i = 0; i < 4; ++i) {
                        const float a1 = dpp_shr1(dpp_ror1(ap_[i]), a[i]), a2 = dpp_shr2(dpp_ror2(ap_[i]), a[i]), b1 = dpp_shr1(dpp_ror1(bp_[i]), b[i]), b2 = dpp_shr2(dpp_ror2(bp_[i]), b[i]);
                        const float ca = ba[i] + wa0[i] * a2 + wa1[i] * a1 + wa2[i] * a[i];
                        const float cbv = bb[i] + wb0[i] * b2 + wb1[i] * b1 + wb2[i] * b[i];
                        res[i] = ca * fast_sigmoid(ca) * cbv;
                    }
                    if (!(m == 0 && fr < 2)) { u32x2 w; w.x = cvt_pk_bf16(res[0], res[1]); w.y = cvt_pk_bf16(res[2], res[3]); *(PG8_GAS u32x2*)ap = w; }
                    ap += (m < 3) ? 16 * DFF : (HALF - 48) * DFF; asm volatile("" : "+v"(ap));
                    __builtin_amdgcn_sched_barrier(0);
                }
            }
        }
#pragma unroll
        for (int ai = 0; ai < 2; ++ai) {
            const int G = (u.pm * BM + ai * HALF + wr * 64) >> 6;
            if (fr < 2) { float* p = UH + ((size_t)G * 2 + fr) * NUP + u.pn * BM + cl; asm volatile("" : "+v"(p));
#pragma unroll
                for (int bj = 0; bj < 2; ++bj) { *(PG8_GAS f32x4*)(p + bj * HALF) = acc[ai][bj][0][0]; *(PG8_GAS f32x4*)(p + bj * HALF + 4) = acc[ai][bj][0][1]; } }
            if (fr >= 14) { float* p = UT + ((size_t)G * 2 + (fr - 14)) * NUP + u.pn * BM + cl; asm volatile("" : "+v"(p));
#pragma unroll
                for (int bj = 0; bj < 2; ++bj) { *(PG8_GAS f32x4*)(p + bj * HALF) = acc[ai][bj][3][0]; *(PG8_GAS f32x4*)(p + bj * HALF + 4) = acc[ai][bj][3][1]; } }
            __builtin_amdgcn_sched_barrier(0);
        }
    }
};
template <class Epi, class Sched, bool ALIGN_EPI = false, bool SP2 = false>
__device__ __forceinline__ void gemm_phase(PG8_LAS unsigned char* lds, const Gemm g, const Sched& S, const Epi& E, int wave_in) {
    int tid_; { int ln_; asm volatile("v_mbcnt_lo_u32_b32 %0, -1, 0\n\tv_mbcnt_hi_u32_b32 %0, -1, %0" : "=v"(ln_)); tid_ = wave_in * 64 + ln_; }
    const int tid = tid_, wid = __builtin_amdgcn_readfirstlane(tid >> 6), lane = tid & 63, wr = wid >> 2, wc = wid & 3, fr = lane & 15, fq = lane >> 4;
    const int K = g.K, nt = K / BK;
    unsigned voffA[2], voffB[2];
#pragma unroll
    for (int i = 0; i < 2; ++i) { int R, C; stage_rc(tid * 16 + i * 8192, R, C); const int Rb = Epi::PERM ? ((R & ~31) + perm32(R & 31)) : R;
        voffA[i] = (unsigned)(R * K + C) * 2u; voffB[i] = (unsigned)(Rb * K + C) * 2u; }
    const size_t kstep = (size_t)(BK * 2);
    const size_t hstep = (size_t)HALF * K * 2;
    const size_t tstep = 2 * hstep;
    const unsigned ldsw = (unsigned)wid * 1024u;
    const int aoff = lds_byte(wr * 64 + fr, fq * 8), boff = lds_byte(wc * 32 + fr, fq * 8);
#define PG8_SA(b, h) (((b) * 2 + (h)) * HTB)
#define PG8_SB(b, h) ((4 + (b) * 2 + (h)) * HTB)
#define PG8_STAGE(bufoff, gbase, voff) do { _Pragma("unroll") for (int _i = 0; _i < 2; ++_i) \
        __builtin_amdgcn_global_load_lds((const unsigned*)((const char*)(gbase) + (voff)[_i]), (PG8_LAS unsigned*)(lds + (bufoff) + ldsw + _i * 8192), 16, 0, 0); } while (0)
#define PG8_LDA(dst, b, h) do { _Pragma("unroll") for (int m = 0; m < 4; ++m) _Pragma("unroll") for (int k = 0; k < 2; ++k) dst[m][k] = *(const PG8_LAS bf16x8*)(lds + PG8_SA(b, h) + aoff + m * 2048 + k * 1024); } while (0)
#define PG8_LDB(dst, b, h) do { _Pragma("unroll") for (int n = 0; n < 2; ++n) _Pragma("unroll") for (int k = 0; k < 2; ++k) dst[n][k] = *(const PG8_LAS bf16x8*)(lds + PG8_SB(b, h) + boff + n * 2048 + k * 1024); } while (0)
#define PG8_MMA(ai, bj, At, Bt) do { __builtin_amdgcn_s_setprio(1); _Pragma("unroll") for (int m = 0; m < 4; ++m) _Pragma("unroll") for (int n = 0; n < 2; ++n) _Pragma("unroll") for (int k = 0; k < 2; ++k) \
        acc[ai][bj][m][n] = __builtin_amdgcn_mfma_f32_16x16x32_bf16(Bt[n][k], At[m][k], acc[ai][bj][m][n], 0, 0, 0); __builtin_amdgcn_s_setprio(0); } while (0)
#define PG8_WAIT_V(n) asm volatile("s_waitcnt vmcnt(" #n ")" ::: "memory")
#define PG8_WAIT_L(n) asm volatile("s_waitcnt lgkmcnt(" #n ")" ::: "memory")
#define PG8_BAR __builtin_amdgcn_s_barrier()
#define PG8_SCHED __builtin_amdgcn_sched_barrier(0)
    Unit cur, nxt; int ui = 0;
    if (!S.next(0, cur)) return;
    f32x4 acc[2][2][4][2];
#pragma unroll
    for (int a = 0; a < 2; ++a)
#pragma unroll
        for (int b = 0; b < 2; ++b)
#pragma unroll
            for (int m = 0; m < 4; ++m)
#pragma unroll
                for (int n = 0; n < 2; ++n) acc[a][b][m][n] = (f32x4){0.f, 0.f, 0.f, 0.f};
    bf16x8 At[4][2], B0[2][2], B1[2][2];
    const char* cA = (const char*)g.A + (size_t)cur.pm * tstep + (cur.hs == 2 ? hstep : 0); const char* cB = (const char*)g.Bt + (size_t)cur.pn * tstep;
    S.a_ready(cur);
    if constexpr (SP2) {
        PG8_STAGE(PG8_SB(0, 0), cB, voffB); PG8_STAGE(PG8_SB(0, 1), cB + hstep, voffB); PG8_STAGE(PG8_SA(0, 0), cA, voffA); PG8_STAGE(PG8_SA(0, 1), cA + hstep, voffA);
        if (wr == 1) PG8_BAR;
        PG8_WAIT_V(2); PG8_BAR;
        PG8_STAGE(PG8_SB(1, 0), cB + kstep, voffB); PG8_STAGE(PG8_SA(1, 0), cA + kstep, voffA); PG8_STAGE(PG8_SB(1, 1), cB + hstep + kstep, voffB);
        PG8_WAIT_V(6); PG8_BAR;
    } else {
        PG8_STAGE(PG8_SB(0, 0), cB, voffB); PG8_STAGE(PG8_SA(0, 0), cA, voffA); PG8_STAGE(PG8_SB(0, 1), cB + hstep, voffB); PG8_STAGE(PG8_SA(0, 1), cA + hstep, voffA);
        if (wr == 1) PG8_BAR;
        PG8_WAIT_V(4); PG8_BAR;
        PG8_STAGE(PG8_SB(1, 0), cB + kstep, voffB); PG8_STAGE(PG8_SA(1, 0), cA + kstep, voffA); PG8_STAGE(PG8_SB(1, 1), cB + hstep + kstep, voffB);
        PG8_WAIT_V(6); PG8_BAR;
    }
    for (;;) {
        const bool has_next = S.next(ui + 1, nxt);
        const char* nA = has_next ? (const char*)g.A + (size_t)nxt.pm * tstep + (nxt.hs == 2 ? hstep : 0) : cA; const char* nB = has_next ? (const char*)g.Bt + (size_t)nxt.pn * tstep : cB;
        for (int t = 0; t < nt; t += 2) {
            if constexpr (Epi::MIDK) { if (t == (nt >> 1)) E.mid(acc, cur, wr, wc, fr, fq); }
            const bool last = (t == nt - 2);
            const char* a1 = cA + (size_t)(t + 1) * kstep;
            const char* a2 = last ? nA : cA + (size_t)(t + 2) * kstep; const char* b2 = last ? nB : cB + (size_t)(t + 2) * kstep;
            const char* a3 = a2 + kstep; const char* b3 = b2 + kstep;
            if (last && has_next) S.a_ready(nxt);
            if constexpr (SP2) {
            PG8_LDB(B0, 0, 0); PG8_LDB(B1, 0, 1); PG8_SCHED; PG8_LDA(At, 0, 0); PG8_STAGE(PG8_SA(1, 1), a1 + hstep, voffA);
            PG8_WAIT_V(8); PG8_WAIT_L(0); PG8_BAR; PG8_MMA(0, 0, At, B0); PG8_MMA(0, 1, At, B1); PG8_BAR; PG8_SCHED;
            PG8_LDA(At, 0, 1); PG8_STAGE(PG8_SB(0, 0), b2, voffB); PG8_STAGE(PG8_SB(0, 1), b2 + hstep, voffB); PG8_STAGE(PG8_SA(0, 0), a2, voffA);
            PG8_WAIT_V(8); PG8_WAIT_L(0); PG8_BAR; if (cur.hs == 0) { PG8_MMA(1, 0, At, B0); PG8_MMA(1, 1, At, B1); } PG8_BAR; PG8_SCHED;
            PG8_LDB(B0, 1, 0); PG8_LDB(B1, 1, 1); PG8_SCHED; PG8_LDA(At, 1, 0); PG8_STAGE(PG8_SA(0, 1), a2 + hstep, voffA);
            PG8_WAIT_V(8); PG8_WAIT_L(0); PG8_BAR; PG8_MMA(0, 0, At, B0); PG8_MMA(0, 1, At, B1); PG8_BAR; PG8_SCHED;
            PG8_LDA(At, 1, 1); PG8_STAGE(PG8_SB(1, 0), b3, voffB); PG8_STAGE(PG8_SB(1, 1), b3 + hstep, voffB); PG8_STAGE(PG8_SA(1, 0), a3, voffA);
            PG8_WAIT_V(8); PG8_WAIT_L(0); PG8_BAR; if (cur.hs == 0) { PG8_MMA(1, 0, At, B0); PG8_MMA(1, 1, At, B1); } PG8_BAR; PG8_SCHED;
            } else {
            PG8_LDB(B0, 0, 0); PG8_SCHED; PG8_LDA(At, 0, 0); PG8_STAGE(PG8_SA(1, 1), a1 + hstep, voffA);
            PG8_WAIT_L(8); PG8_BAR; PG8_WAIT_L(0); PG8_MMA(0, 0, At, B0); PG8_BAR; PG8_SCHED;
            PG8_LDB(B1, 0, 1); PG8_STAGE(PG8_SB(0, 0), b2, voffB);
            PG8_BAR; PG8_WAIT_L(0); PG8_MMA(0, 1, At, B1); PG8_BAR;
            PG8_LDA(At, 0, 1); PG8_STAGE(PG8_SA(0, 0), a2, voffA);
            PG8_BAR; PG8_WAIT_L(0); PG8_MMA(1, 0, At, B0); PG8_BAR; PG8_SCHED;
            PG8_STAGE(PG8_SB(0, 1), b2 + hstep, voffB);
            PG8_WAIT_V(6); PG8_BAR; PG8_MMA(1, 1, At, B1); PG8_BAR;
            PG8_LDB(B0, 1, 0); PG8_SCHED; PG8_LDA(At, 1, 0); PG8_STAGE(PG8_SA(0, 1), a2 + hstep, voffA);
            PG8_WAIT_L(8); PG8_BAR; PG8_WAIT_L(0); PG8_MMA(0, 0, At, B0); PG8_BAR; PG8_SCHED;
            PG8_LDB(B1, 1, 1); PG8_STAGE(PG8_SB(1, 0), b3, voffB);
            PG8_BAR; PG8_WAIT_L(0); PG8_MMA(0, 1, At, B1); PG8_BAR;
            PG8_LDA(At, 1, 1); PG8_STAGE(PG8_SA(1, 0), a3, voffA);
            PG8_BAR; PG8_WAIT_L(0); PG8_MMA(1, 0, At, B0); PG8_BAR; PG8_SCHED;
            PG8_STAGE(PG8_SB(1, 1), b3 + hstep, voffB);
            PG8_WAIT_V(6); PG8_BAR; PG8_MMA(1, 1, At, B1); PG8_BAR;
            }
        }
        if constexpr (ALIGN_EPI) { if (wr == 0) PG8_BAR; }
        if constexpr (!Epi::AFTER_DRAIN) { E(acc, cur, wr, wc, fr, fq); S.done(cur); }
        if (!has_next) break;
#pragma unroll
        for (int a = 0; a < 2; ++a)
#pragma unroll
            for (int b = 0; b < 2; ++b)
#pragma unroll
                for (int m = 0; m < 4; ++m)
#pragma unroll
                    for (int n = 0; n < 2; ++n) acc[a][b][m][n] = (f32x4){0.f, 0.f, 0.f, 0.f};
        cur = nxt; cA = nA; cB = nB; ++ui;
        if constexpr (ALIGN_EPI) { if (wr == 1) PG8_BAR; }
    }
    PG8_WAIT_V(0);
    if constexpr (!ALIGN_EPI) { if (wr == 0) PG8_BAR; }
    PG8_BAR;
    if constexpr (Epi::AFTER_DRAIN) { E.fused(acc, cur, wr, wc, fr, fq, lds, wid, lane); S.done(cur); }
#undef PG8_SA
#undef PG8_SB
#undef PG8_STAGE
#undef PG8_LDA
#undef PG8_LDB
#undef PG8_MMA
#undef PG8_WAIT_V
#undef PG8_WAIT_L
#undef PG8_BAR
#undef PG8_SCHED
}
}
#include <hip/hip_bf16.h>
#include <cmath>
namespace attn_body {
using bf16=__hip_bfloat16;
using bf16x8=__attribute__((ext_vector_type(8)))short;
using s16x4=__attribute__((ext_vector_type(4)))short;
using f32x16=__attribute__((ext_vector_type(16)))float;
using u32x4=__attribute__((ext_vector_type(4)))unsigned;
constexpr int BATCH=4,NHEAD=8,SEQ=8192,D=64,DM=NHEAD*D;
constexpr int ODM=1024; constexpr int NW=8,QBLK=32,QB=QBLK*NW,KVBLK=64,NQB=SEQ/QB;
constexpr int ATTN_PITCH=DM, ATTN_UNIT_ROWS=QB;
__device__ __forceinline__ int crow(int r,int hi){return (r&3)+8*(r>>2)+4*hi;}
#define SBAR() __builtin_amdgcn_sched_barrier(0)
__device__ __forceinline__ void cmask(f32x16&p0,f32x16&p1,int jb,int qrel,int hi){
  const float NEG=-INFINITY; int kb=64*jb+4*hi;
  #pragma unroll
  for(int r=0;r<16;++r){int kv=kb+(r&3)+8*(r>>2); if(kv>qrel)p0[r]=NEG; if(kv+32>qrel)p1[r]=NEG;}
}

constexpr int NSLOT=3, SLOTB=8192;
constexpr int LDS_K=0, LDS_V=NSLOT*SLOTB, LDS_WS=2*NSLOT*SLOTB, LDS_OST=LDS_WS+NW*64*4, LDS_BYTES=LDS_OST+NW*4096;
constexpr float C2=0.125f*1.4426950408889634f; constexpr int LDS_KB=LDS_BYTES;
__device__ __forceinline__ void glds16(const void*gsrc,unsigned lds_dst){unsigned keep;
  asm volatile("s_mov_b32 %0, m0\n\ts_mov_b32 m0, %2\n\ts_nop 0\n\tglobal_load_lds_dwordx4 %1, off\n\ts_mov_b32 m0, %0":"=&s"(keep):"v"(gsrc),"s"(lds_dst):"memory");}
__device__ __forceinline__ float max3f(float a,float b,float c){float r;asm("v_max3_f32 %0, %1, %2, %3":"=v"(r):"v"(a),"v"(b),"v"(c));return r;}
__device__ __forceinline__ float max2f(float a,float b){float r;asm("v_max_f32_e32 %0, %1, %2":"=v"(r):"v"(a),"v"(b));return r;}
__device__ __forceinline__ float fadd_s(float a,float b){float r;asm("v_add_f32_e32 %0, %1, %2":"=v"(r):"v"(a),"v"(b));return r;}
__device__ __forceinline__ float fsub_s(float a,float b){float r;asm("v_sub_f32_e32 %0, %1, %2":"=v"(r):"v"(a),"v"(b));return r;}
typedef float f32x2_t __attribute__((ext_vector_type(2))); typedef __bf16 bf16x2_t __attribute__((ext_vector_type(2)));
__device__ __forceinline__ unsigned cvtpk_s(float lo,float hi){f32x2_t v={lo,hi};bf16x2_t b=__builtin_convertvector(v,bf16x2_t);return __builtin_bit_cast(unsigned,b);}
#define WAIT_BAR(N) asm volatile("s_waitcnt vmcnt(" #N ") lgkmcnt(0)\n\ts_barrier":::"memory")

__device__ __forceinline__ void qkt(f32x16&p0,f32x16&p1,const char*Kslot,const bf16x8*qr,const f32x16&negm,int r32,int hi){
  const char*kb=Kslot+hi*1024+r32*16;
  #pragma unroll
  for(int d0=0;d0<4;++d0){
    const bf16x8 b0=*reinterpret_cast<const bf16x8*>(kb+d0*2048);
    const bf16x8 b1=*reinterpret_cast<const bf16x8*>(kb+d0*2048+512);
    if(d0==0){p0=__builtin_amdgcn_mfma_f32_32x32x16_bf16(b0,qr[0],negm,0,0,0);p1=__builtin_amdgcn_mfma_f32_32x32x16_bf16(b1,qr[0],negm,0,0,0);}
    else{p0=__builtin_amdgcn_mfma_f32_32x32x16_bf16(b0,qr[d0],p0,0,0,0);p1=__builtin_amdgcn_mfma_f32_32x32x16_bf16(b1,qr[d0],p1,0,0,0);}}
}
__device__ __forceinline__ bf16x8 bias_frag(float v,int hi){
  const unsigned h=cvtpk_s(v,0.f)&0xffffu; const float r1=v-__uint_as_float(h<<16);
  const unsigned m=cvtpk_s(r1,0.f)&0xffffu; const float r2=r1-__uint_as_float(m<<16);
  const unsigned l=cvtpk_s(r2,0.f)&0xffffu;
  u32x4 w; w.x=hi?0u:(h|(m<<16)); w.y=hi?0u:l; w.z=0u; w.w=0u; return __builtin_bit_cast(bf16x8,w);
}
typedef __attribute__((address_space(3))) const char* lds_cptr;
typedef short v4i16_t __attribute__((ext_vector_type(4)));
__device__ __forceinline__ void kload8(bf16x8*kf,lds_cptr kp){
  kf[0]=*(const __attribute__((address_space(3))) bf16x8*)(kp);      kf[1]=*(const __attribute__((address_space(3))) bf16x8*)(kp+512);
  kf[2]=*(const __attribute__((address_space(3))) bf16x8*)(kp+2048); kf[3]=*(const __attribute__((address_space(3))) bf16x8*)(kp+2560);
  kf[4]=*(const __attribute__((address_space(3))) bf16x8*)(kp+4096); kf[5]=*(const __attribute__((address_space(3))) bf16x8*)(kp+4608);
  kf[6]=*(const __attribute__((address_space(3))) bf16x8*)(kp+6144); kf[7]=*(const __attribute__((address_space(3))) bf16x8*)(kp+6656);
}
__device__ __forceinline__ void kload2(bf16x8*kf,lds_cptr kp,int j){ kf[2*j]=*(const __attribute__((address_space(3))) bf16x8*)(kp+j*2048); kf[2*j+1]=*(const __attribute__((address_space(3))) bf16x8*)(kp+j*2048+512); }
__device__ __forceinline__ s16x4 vtr(lds_cptr p){ return __builtin_bit_cast(s16x4,__builtin_amdgcn_ds_read_tr16_b64_v4i16((__attribute__((address_space(3))) v4i16_t*)p)); }
__device__ __forceinline__ float rowmax(const f32x16&p0,const f32x16&p1){
  float a=max3f(p0[0],p0[1],p1[0]),b=max3f(p0[2],p0[3],p1[1]);a=max3f(a,p1[2],p1[3]);
  #pragma unroll
  for(int r=4;r<16;r+=4){a=max3f(a,p0[r],p0[r+1]);b=max3f(b,p0[r+2],p0[r+3]);a=max3f(a,p1[r],p1[r+1]);b=max3f(b,p1[r+2],p1[r+3]);}
  const float m=max2f(a,b);
  auto rr=__builtin_amdgcn_permlane32_swap(__float_as_uint(m),__float_as_uint(m),false,false);
  return max2f(__uint_as_float(rr[0]),__uint_as_float(rr[1]));
}
__device__ __forceinline__ void pv(f32x16*o,int vb,bf16x8 pa0,bf16x8 pa1,bf16x8 pa2,bf16x8 pa3){
  #pragma unroll
  for(int d0=0;d0<2;++d0){s16x4 lo[4],hi[4];
    #pragma unroll
    for(int ks=0;ks<4;++ks){
      asm volatile("ds_read_b64_tr_b16 %0,%1 offset:%c2":"=&v"(lo[ks]):"v"(vb),"i"(d0*4096+ks*1024):"memory");
      asm volatile("ds_read_b64_tr_b16 %0,%1 offset:%c2":"=&v"(hi[ks]):"v"(vb),"i"(d0*4096+ks*1024+512):"memory");}
    asm volatile("s_waitcnt lgkmcnt(0)":::"memory");SBAR();
    #define PK(k) (bf16x8){lo[k][0],lo[k][1],lo[k][2],lo[k][3],hi[k][0],hi[k][1],hi[k][2],hi[k][3]}
    o[d0]=__builtin_amdgcn_mfma_f32_32x32x16_bf16(pa0,PK(0),o[d0],0,0,0);
    o[d0]=__builtin_amdgcn_mfma_f32_32x32x16_bf16(pa1,PK(1),o[d0],0,0,0);
    o[d0]=__builtin_amdgcn_mfma_f32_32x32x16_bf16(pa2,PK(2),o[d0],0,0,0);
    o[d0]=__builtin_amdgcn_mfma_f32_32x32x16_bf16(pa3,PK(3),o[d0],0,0,0);
    #undef PK
  }
}

#ifndef ATTN_STORE16
#define ATTN_STORE16(p,v) (*(u32x4*)(p)=(v))
#endif
template<int THRL> __device__ __forceinline__ void attn_unit(int b,int h,int qb,const bf16*Q,const bf16*__restrict__ K,const bf16*__restrict__ V,bf16*O,const float*__restrict__ CUM,const float*NRM,char*shm,int wave_in){
  int tid_; { int ln_; asm volatile("v_mbcnt_lo_u32_b32 %0, -1, 0\n\tv_mbcnt_hi_u32_b32 %0, -1, %0" : "=v"(ln_)); tid_ = wave_in * 64 + ln_; }
  const int tid=tid_,lane=tid&63,r32=lane&31,hi=lane>>5; const int wid=__builtin_amdgcn_readfirstlane(tid>>6);
  const long rowbase=(long)b*SEQ; const int q0=qb*QB;
  const __attribute__((address_space(1))) float*cu=(const __attribute__((address_space(1))) float*)(CUM+((long)b*NHEAD+h)*SEQ); const float c0=cu[q0];
  int t0;
  { const __attribute__((address_space(1))) float*nrm=(const __attribute__((address_space(1))) float*)NRM; const int bh32=(b*NHEAD+h)*32;
    float kn=(lane<=qb)?nrm[1024+bh32+lane]:0.f;
    #pragma unroll
    for(int o=1;o<64;o<<=1)kn=__builtin_fmaxf(kn,lane_read(kn,lane^o));
    const float thr=-(2.f*nrm[bh32+qb]*kn+49.f);
    int cnt=0; for(int i=lane;i<(q0+QB)/KVBLK;i+=64)cnt+=((c0-cu[KVBLK*i+KVBLK-1])*1.4426950408889634f<thr)?1:0;
    #pragma unroll
    for(int o=1;o<64;o<<=1)cnt+=(int)lane_read_u((unsigned)cnt,lane^o);
    cnt&=~1; const int lim=(q0+QB)/KVBLK-4; t0=__builtin_amdgcn_readfirstlane(cnt<lim?cnt:lim); }
  const bf16*Qw=Q+(rowbase+q0+wid*QBLK)*DM+h*D;
  const bf16*Kh=K+(rowbase+(long)t0*KVBLK)*DM+h*D,*Vh=V+(rowbase+(long)t0*KVBLK)*DM+h*D;
  const unsigned lds0=(unsigned)(uintptr_t)shm;
  float*wsf=(float*)(shm+LDS_WS)+wid*64;
  const bf16*ksrc=Kh+(long)lane*DM+wid*8;
  const bf16*vsrc=Vh+(long)(16*(wid&3)+(lane>>2))*DM+(wid>>2)*32+(lane&3)*8;
  const unsigned kdst=lds0+LDS_K+wid*1024, vdst=lds0+LDS_V+wid*1024;
  #define DMA_K(t,slot) glds16(ksrc+(long)(t)*KVBLK*DM,(unsigned)__builtin_amdgcn_readfirstlane(kdst+(slot)))
  #define DMA_V(t,slot) glds16(vsrc+(long)(t)*KVBLK*DM,(unsigned)__builtin_amdgcn_readfirstlane(vdst+(slot)))
  const int vb0=(int)(lds0+LDS_V)+((lane>>4)&1)*32+(lane&3)*8+(4*hi+((lane&15)>>2))*64;
  const char*Kbase=shm+LDS_K; bf16x8 kf[8];
  const lds_cptr shm3=(lds_cptr)shm; const lds_cptr kp0=shm3+LDS_K+hi*1024+r32*16; const lds_cptr vp0=shm3+LDS_V+((lane>>4)&1)*32+(lane&3)*8+(4*hi+((lane&15)>>2))*64;
  const int NT=(q0+QB)/KVBLK-t0;
  float*kbl=(float*)(shm+LDS_KB);
  { const int sk=t0*KVBLK;
    for(int s=tid;s<q0+QB-sk;s+=NW*64)kbl[s]=(c0-cu[s+sk])*1.4426950408889634f;
    asm volatile("s_waitcnt vmcnt(0)":::"memory"); }
  const bf16x8 ones=__builtin_bit_cast(bf16x8,(u32x4){hi?0u:0x3f803f80u,hi?0u:0x00003f80u,0u,0u});
  DMA_K(0,0);DMA_V(0,0);DMA_K(1,SLOTB);
  bf16x8 qr[4];
  #pragma unroll
  for(int d0=0;d0<4;++d0)qr[d0]=*reinterpret_cast<const bf16x8*>(&Qw[(long)r32*DM+d0*16+hi*8]);
  float mhat=0.f,l_reg=0.f;f32x16 o[2];o[0]=f32x16{};o[1]=f32x16{};f32x16 negm=f32x16{};asm volatile("":"+v"(negm));
  const int qrel=wid*QBLK+r32;
  #define CMASK(P0,P1,t) do{int jb_=(t)-(NT-4); if(jb_>=0)cmask(P0,P1,jb_,qrel,hi);}while(0)
  bool resc=false;
  #define START(P0,P1) do{ const float rm=rowmax(P0,P1); resc=false; \
    { const float dl=__builtin_fmaxf(rm,0.f); mhat=fadd_s(mhat,dl); \
      _Pragma("unroll") for(int r=0;r<16;++r){P0[r]=fsub_s(P0[r],dl);P1[r]=fsub_s(P1[r],dl);} \
      _Pragma("unroll") for(int r=0;r<16;++r)negm[r]=-mhat; asm volatile("":"+v"(negm)); } \
    _Pragma("unroll") for(int r=0;r<16;++r)P0[r]=__builtin_amdgcn_exp2f(P0[r]); }while(0)
  #define RESC() do{ if(resc){ asm volatile("s_waitcnt lgkmcnt(0)":::"memory"); \
      _Pragma("unroll") for(int d_=0;d_<2;++d_) _Pragma("unroll") for(int r=0;r<16;++r)o[d_][r]*=wsf[crow(r,hi)]; } }while(0)
  f32x16 pA0,pA1,pB0,pB1;
  int sl_prev=0,sl_cur=0,sl_next=SLOTB;
  #define ROT() do{sl_prev=sl_cur;sl_cur=sl_next;sl_next=(sl_next==(NSLOT-1)*SLOTB)?0:sl_next+SLOTB;}while(0)
  DMA_K(2,2*SLOTB);
  WAIT_BAR(3);
  qkt(pA0,pA1,Kbase,qr,negm,r32,hi);
  pA0=__builtin_amdgcn_mfma_f32_32x32x16_bf16(bias_frag(kbl[r32],hi),ones,pA0,0,0,0);pA1=__builtin_amdgcn_mfma_f32_32x32x16_bf16(bias_frag(kbl[32+r32],hi),ones,pA1,0,0,0);
  asm volatile("s_nop 15\n\ts_nop 7":"+v"(pA0),"+v"(pA1));CMASK(pA0,pA1,0);
  START(pA0,pA1);
  _Pragma("unroll") for(int r=0;r<16;++r)pA1[r]=__builtin_amdgcn_exp2f(pA1[r]);
  WAIT_BAR(0);
  DMA_K(3,0);DMA_V(1,SLOTB);
  ROT();
  kload8(kf,kp0+sl_cur);
  WAIT_BAR(2);
  s16x4 vlo[8],vhi[8]; u32x4 pw0,pw1,pw2,pw3;
  #define PKW(P,B) cvtpk_s(P[B],P[B+1])
  #define PAF(k) __builtin_bit_cast(bf16x8,pw##k)
  #define VFR(i) (bf16x8){vlo[i][0],vlo[i][1],vlo[i][2],vlo[i][3],vhi[i][0],vhi[i][1],vhi[i][2],vhi[i][3]}
  #define PIN(x) asm volatile("":"+v"(x))
  #define MX3(a,b,c) __builtin_fmaxf(__builtin_fmaxf((a),(b)),(c))
  #define GAPA(MF,A0,A1,A2,A3,W0,W1,PW) do{ MF; sacc+=A0; sacc+=A1; sacc+=A2; sacc+=A3; PIN(sacc); W0; W1; PIN(PW); SBAR(); }while(0)
  #define EX(v) __builtin_amdgcn_exp2f(v)
  #define GAPB(MF,X,B) do{ MF; X[B]=EX(X[B]); X[B+1]=EX(X[B+1]); X[B+2]=EX(X[B+2]); X[B+3]=EX(X[B+3]); PIN(X); SBAR(); }while(0)
  #define VRD(i) do{ vlo[i]=vtr(vp_+(((i)>>2)*4096+((i)&3)*1024)); vhi[i]=vtr(vp_+(((i)>>2)*4096+((i)&3)*1024+512)); }while(0)
  #define KRD(G,j) do{ if(G){ kload2(kf,kp0+sl_next,j); SBAR(); } }while(0)
  #define STEP(C0,C1,P0,P1,t,GK,GV,GL) do{ SBAR(); \
    const lds_cptr vp_=vp0+sl_prev; \
    const bf16x8 kbf0_=bias_frag(kbl[(t)*KVBLK+r32],hi), kbf1_=bias_frag(kbl[(t)*KVBLK+32+r32],hi); \
    VRD(0); SBAR(); float sacc=(P0[0]+P0[1]); \
    GAPA(C0=__builtin_amdgcn_mfma_f32_32x32x16_bf16(kf[0],qr[0],negm,0,0,0), P0[2],P0[3],P0[4],P0[5],     pw0[0]=PKW(P0,0), pw0[1]=PKW(P0,2), pw0); \
    VRD(4); SBAR(); GAPA(C1=__builtin_amdgcn_mfma_f32_32x32x16_bf16(kf[1],qr[0],negm,0,0,0), P0[6],P0[7],P0[8],P0[9],     pw0[2]=PKW(P0,4), pw0[3]=PKW(P0,6), pw0); \
    VRD(1); SBAR(); GAPA(C0=__builtin_amdgcn_mfma_f32_32x32x16_bf16(kf[2],qr[1],C0,0,0,0),   P0[10],P0[11],P0[12],P0[13], pw1[0]=PKW(P0,8), pw1[1]=PKW(P0,10), pw1); \
    VRD(5); SBAR(); GAPA(C1=__builtin_amdgcn_mfma_f32_32x32x16_bf16(kf[3],qr[1],C1,0,0,0),   P0[14],P0[15],P1[0],P1[1],   pw1[2]=PKW(P0,12),pw1[3]=PKW(P0,14), pw1); \
    VRD(2); SBAR(); GAPA(C0=__builtin_amdgcn_mfma_f32_32x32x16_bf16(kf[4],qr[2],C0,0,0,0),   P1[2],P1[3],P1[4],P1[5],     pw2[0]=PKW(P1,0), pw2[1]=PKW(P1,2), pw2); \
    VRD(6); SBAR(); GAPA(C1=__builtin_amdgcn_mfma_f32_32x32x16_bf16(kf[5],qr[2],C1,0,0,0),   P1[6],P1[7],P1[8],P1[9],     pw2[2]=PKW(P1,4), pw2[3]=PKW(P1,6), pw2); \
    VRD(3); SBAR(); GAPA(C0=__builtin_amdgcn_mfma_f32_32x32x16_bf16(kf[6],qr[3],C0,0,0,0),   P1[10],P1[11],P1[12],P1[13], pw3[0]=PKW(P1,8), pw3[1]=PKW(P1,10), pw3); \
    VRD(7); SBAR(); GAPA(C1=__builtin_amdgcn_mfma_f32_32x32x16_bf16(kf[7],qr[3],C1,0,0,0),   P1[14],P1[15],0.f,0.f,       pw3[2]=PKW(P1,12),pw3[3]=PKW(P1,14), pw3); \
    C0=__builtin_amdgcn_mfma_f32_32x32x16_bf16(kbf0_,ones,C0,0,0,0); C1=__builtin_amdgcn_mfma_f32_32x32x16_bf16(kbf1_,ones,C1,0,0,0); \
    l_reg+=sacc; \
    if(GK){DMA_K((t)+3,sl_cur);} if(GV){DMA_V((t)+1,sl_next);} \
    CMASK(C0,C1,t); \
    { float a=MX3(C0[0],C0[1],C1[0]),b=MX3(C0[2],C0[3],C1[1]); a=MX3(a,C1[2],C1[3]); \
      _Pragma("unroll") for(int r=4;r<16;r+=4){a=MX3(a,C0[r],C0[r+1]);b=MX3(b,C0[r+2],C0[r+3]);a=MX3(a,C1[r],C1[r+1]);b=MX3(b,C1[r+2],C1[r+3]);} \
      float rm=__builtin_fmaxf(a,b); { auto rr=__builtin_amdgcn_permlane32_swap(__float_as_uint(rm),__float_as_uint(rm),false,false); rm=__builtin_fmaxf(__uint_as_float(rr[0]),__uint_as_float(rr[1])); } \
      resc=false; \
      if(__builtin_expect(__any(rm>(float)THRL),0)){ const float dl=__builtin_fmaxf(rm,0.f); mhat+=dl; \
        _Pragma("unroll") for(int r=0;r<16;++r){C0[r]-=dl;C1[r]-=dl;} \
        _Pragma("unroll") for(int r=0;r<16;++r)negm[r]=-mhat; asm volatile("":"+v"(negm)); \
        const float f=__builtin_amdgcn_exp2f(-dl); l_reg*=f; if(hi==0)wsf[r32]=f; resc=true; } } \
    SBAR(); \
    GAPB(o[0]=__builtin_amdgcn_mfma_f32_32x32x16_bf16(PAF(0),VFR(0),o[0],0,0,0), C0,0); \
    GAPB(o[1]=__builtin_amdgcn_mfma_f32_32x32x16_bf16(PAF(0),VFR(4),o[1],0,0,0), C0,4); \
    KRD(GL,0); GAPB(o[0]=__builtin_amdgcn_mfma_f32_32x32x16_bf16(PAF(1),VFR(1),o[0],0,0,0), C0,8); \
    KRD(GL,1); GAPB(o[1]=__builtin_amdgcn_mfma_f32_32x32x16_bf16(PAF(1),VFR(5),o[1],0,0,0), C0,12); \
    KRD(GL,2); GAPB(o[0]=__builtin_amdgcn_mfma_f32_32x32x16_bf16(PAF(2),VFR(2),o[0],0,0,0), C1,0); \
    KRD(GL,3); GAPB(o[1]=__builtin_amdgcn_mfma_f32_32x32x16_bf16(PAF(2),VFR(6),o[1],0,0,0), C1,4); \
    GAPB(o[0]=__builtin_amdgcn_mfma_f32_32x32x16_bf16(PAF(3),VFR(3),o[0],0,0,0), C1,8); \
    GAPB(o[1]=__builtin_amdgcn_mfma_f32_32x32x16_bf16(PAF(3),VFR(7),o[1],0,0,0), C1,12); \
    }while(0)
  int t=1;
  #undef CMASK
  #define CMASK(P0,P1,t) do{}while(0)
  for(;t+5<NT;t+=2){
    STEP(pB0,pB1,pA0,pA1,t,true,true,true);     WAIT_BAR(2); RESC(); ROT();
    STEP(pA0,pA1,pB0,pB1,t+1,true,true,true);   WAIT_BAR(2); RESC(); ROT();
  }
  #undef CMASK
  #define CMASK(P0,P1,t) do{int jb_=(t)-(NT-4); if(jb_>=0)cmask(P0,P1,jb_,qrel,hi);}while(0)
  #define ENDW(tt) do{ if((tt)+3<NT){WAIT_BAR(2);} else if((tt)+2<NT){WAIT_BAR(1);} else {WAIT_BAR(0);} }while(0)
  for(;t+1<NT;t+=2){
    STEP(pB0,pB1,pA0,pA1,t,(t+3<NT),(t+1<NT),(t+1<NT));       ENDW(t);   RESC(); ROT();
    STEP(pA0,pA1,pB0,pB1,t+1,(t+4<NT),(t+2<NT),(t+2<NT));     ENDW(t+1); RESC(); ROT();
  }
  STEP(pB0,pB1,pA0,pA1,NT-1,false,false,false); RESC();
  { float sacc=pB0[0]+pB0[1]; _Pragma("unroll") for(int r=2;r<16;++r)sacc+=pB0[r]; _Pragma("unroll") for(int r=0;r<16;++r)sacc+=pB1[r]; l_reg+=sacc;
    pw0=(u32x4){PKW(pB0,0),PKW(pB0,2),PKW(pB0,4),PKW(pB0,6)};pw1=(u32x4){PKW(pB0,8),PKW(pB0,10),PKW(pB0,12),PKW(pB0,14)};pw2=(u32x4){PKW(pB1,0),PKW(pB1,2),PKW(pB1,4),PKW(pB1,6)};pw3=(u32x4){PKW(pB1,8),PKW(pB1,10),PKW(pB1,12),PKW(pB1,14)};
    SBAR(); pv(o,vb0+sl_cur,PAF(0),PAF(1),PAF(2),PAF(3)); }
  #undef PKW
  #undef PAF
  #undef VFR
  #undef PIN
  #undef MX3
  #undef GAPA
  #undef GAPB
  #undef EX
  #undef VRD
  #undef KRD
  #undef STEP
  #undef ENDW
  {auto rr=__builtin_amdgcn_permlane32_swap(__float_as_uint(l_reg),__float_as_uint(l_reg),false,false);l_reg=__uint_as_float(rr[0])+__uint_as_float(rr[1]);}
  if(hi==0)wsf[32+r32]=l_reg;asm volatile("s_waitcnt lgkmcnt(0)":::"memory");
  float rli[16];
  #pragma unroll
  for(int r=0;r<16;++r)rli[r]=__builtin_amdgcn_rcpf(wsf[32+crow(r,hi)]);
  bf16*Ow=O+(rowbase+q0+wid*QBLK)*ODM+h*D;
  { bf16*stg=(bf16*)(shm+LDS_OST)+wid*2048;
    #pragma unroll
    for(int r=0;r<16;++r){const int orow=crow(r,hi);
      #pragma unroll
      for(int d0=0;d0<2;++d0)stg[orow*64+d0*32+r32]=__float2bfloat16(o[d0][r]*rli[r]);}
    asm volatile("s_waitcnt lgkmcnt(0)":::"memory");
    #pragma unroll
    for(int i=0;i<4;++i){const int row=i*8+(lane>>3),ch=lane&7; const u32x4 v=*(const u32x4*)(stg+row*64+ch*8); ATTN_STORE16(Ow+(long)row*ODM+ch*8,v);} }
  asm volatile("s_waitcnt lgkmcnt(0)\n\ts_barrier":::"memory");
  #undef DMA_K
  #undef DMA_V
  #undef CMASK
  #undef START
  #undef RESC
  #undef ROT
}
constexpr int ATTN_LDS_BYTES=LDS_BYTES+SEQ*4;
struct AttnTensors { const bf16* Q; const bf16* K; const bf16* V; bf16* O; const float* CUM; const float* NRM; };
struct AttnUnit { int bh; int qb; };
struct StaticOrder {
  int vcu;
  __device__ __forceinline__ explicit StaticOrder(int grid,int block):vcu((block%8)*(grid/8)+block/8){}
  __device__ __forceinline__ bool next(int i,AttnUnit&u)const{ if(i>=4)return false; const int s=vcu&7; u.bh=vcu>>3; u.qb=(i==0)?s:(i==1)?15-s:(i==2)?16+s:31-s; return true; }
  __device__ __forceinline__ void a_ready(const AttnUnit&)const{}
  __device__ __forceinline__ void done(const AttnUnit&)const{}
};
template<class Sched,int THRL=8> __device__ __forceinline__ void attn_phase(char*lds,const AttnTensors&T,const Sched&S,int wave_in){
  AttnUnit u;
  for(int i=0;S.next(i,u);++i){ S.a_ready(u); attn_unit<THRL>(u.bh/NHEAD,u.bh%NHEAD,u.qb,T.Q,T.K,T.V,T.O,T.CUM,T.NRM,lds,wave_in); S.done(u); }
}
#undef SBAR
#undef WAIT_BAR
}
namespace dsa {
typedef __attribute__((address_space(3))) unsigned char* ldsp;
typedef float f32x16 __attribute__((ext_vector_type(16)));
typedef float f32x4 __attribute__((ext_vector_type(4)));
typedef short bf16x8 __attribute__((ext_vector_type(8)));
typedef short s16x4 __attribute__((ext_vector_type(4)));
typedef unsigned u32x4 __attribute__((ext_vector_type(4)));
typedef unsigned u32x2 __attribute__((ext_vector_type(2)));
typedef unsigned short bf16;
#define DLAS __attribute__((address_space(3)))
#define DGAS __attribute__((address_space(1)))
constexpr int NBIN = 512, CAP2 = 192, TOPK = 256;
constexpr int L_LBK = 64 * CAP2 * 4;
constexpr int L_HIST = 0;
constexpr int L_LISTA = 73728;
constexpr int L_CNTA = L_LISTA + 32768, L_CNTB = L_CNTA + 256, L_THR = L_CNTB + 256, L_R = L_THR + 256, L_NSEL = L_R + 256, L_LSUM = L_NSEL + 256, L_POOLC = L_LSUM + 512, L_CNTA1 = L_POOLC + 16, L_KW = L_CNTA1 + 256, L_END = L_KW + 8 * CAP2 * 4;
constexpr int STASH_B = 16, STASH_A = 12;
constexpr int POOLCAP = 8192;
constexpr int VST = 144;
static_assert(8 * 64 * VST <= L_LISTA && 64 * CAP2 * 6 <= L_LISTA && 64 * NBIN * 2 <= L_LISTA && L_END <= 131072, "dsa LDS map");

__device__ __forceinline__ unsigned wave_incl_prefix(unsigned x) {
    x += (unsigned)__builtin_amdgcn_update_dpp(0, (int)x, 0x111, 0xf, 0xf, true);
    x += (unsigned)__builtin_amdgcn_update_dpp(0, (int)x, 0x112, 0xf, 0xf, true);
    x += (unsigned)__builtin_amdgcn_update_dpp(0, (int)x, 0x114, 0xf, 0xf, true);
    x += (unsigned)__builtin_amdgcn_update_dpp(0, (int)x, 0x118, 0xf, 0xf, true);
    x += (unsigned)__builtin_amdgcn_update_dpp(0, (int)x, 0x142, 0xa, 0xf, false);
    x += (unsigned)__builtin_amdgcn_update_dpp(0, (int)x, 0x143, 0xc, 0xf, false);
    return x;
}
__device__ __forceinline__ int score_bin(float s, int e0) {
    const unsigned u = __float_as_uint(s);
    int rel = (int)((u >> 19) & 0xFFFu) - e0; rel = rel < 0 ? 0 : (rel > 255 ? 255 : rel);
    return ((int)u < 0) ? 255 - rel : 256 + rel;
}
__device__ __forceinline__ float fmac_s(float a, float b, float acc) { asm("v_fmac_f32_e32 %0, %1, %2" : "+v"(acc) : "v"(a), "v"(b)); return acc; }
__device__ __forceinline__ float bin_edge(int b, int e0) {
    if (b >= 257) { const int r = b - 256; if (r > 255) return INFINITY; int E = e0 + r; if (E <= 0) return 0.f; if (E > 0xFF0) E = 0xFF0; return __uint_as_float((unsigned)E << 19); }
    if (b == 256) return 0.f;
    const int rp = 255 - b; if (rp >= 255) return -INFINITY;
    const int E = e0 + rp + 1; if (E <= 0) return 0.f; if (E > 0xFF0) return -3.402823466e38f;
    return __uint_as_float(0x80000000u | (((unsigned)E << 19) - 1u));
}
#define DSA_MF "v_mfma_f32_16x16x32_bf16 "
__device__ __forceinline__ void tile_open(f32x4& sc0, f32x4& sc1, f32x4& a0, f32x4& a1, const bf16x8 (&kf)[2][2], const bf16x8 (&ql)[2], const bf16x8 (&q0)[2]) {
    asm volatile(DSA_MF "%0, %4, %8, 0\n\t" DSA_MF "%1, %6, %8, 0\n\t" DSA_MF "%0, %5, %9, %0\n\t" DSA_MF "%1, %7, %9, %1\n\t"
                 DSA_MF "%2, %4, %10, 0\n\t" DSA_MF "%3, %6, %10, 0\n\t" DSA_MF "%2, %5, %11, %2\n\t" DSA_MF "%3, %7, %11, %3"
                 : "=&v"(sc0), "=&v"(sc1), "=&v"(a0), "=&v"(a1)
                 : "v"(kf[0][0]), "v"(kf[0][1]), "v"(kf[1][0]), "v"(kf[1][1]), "v"(ql[0]), "v"(ql[1]), "v"(q0[0]), "v"(q0[1]));
}
template <bool FIRST>
__device__ __forceinline__ void head_step(f32x4& b0, f32x4& b1, f32x4& sc0, f32x4& sc1, const f32x4& a0, const f32x4& a1, float wh, const bf16x8 (&kf)[2][2], const bf16x8 (&qn)[2]) {
#define DSA_HS(NOP) asm volatile(DSA_MF "%0, %19, %23, 0\n\t" DSA_MF "%1, %21, %23, 0\n\t" NOP \
                 "v_fma_f32 %2, |%10|, %18, %2\n\tv_fma_f32 %3, |%11|, %18, %3\n\t" DSA_MF "%0, %20, %24, %0\n\t" \
                 "v_fma_f32 %4, |%12|, %18, %4\n\tv_fma_f32 %5, |%13|, %18, %5\n\t" DSA_MF "%1, %22, %24, %1\n\t" \
                 "v_fma_f32 %6, |%14|, %18, %6\n\tv_fma_f32 %7, |%15|, %18, %7\n\tv_fma_f32 %8, |%16|, %18, %8\n\tv_fma_f32 %9, |%17|, %18, %9" \
                 : "=&v"(b0), "=&v"(b1), "+v"(sc0[0]), "+v"(sc0[1]), "+v"(sc0[2]), "+v"(sc0[3]), "+v"(sc1[0]), "+v"(sc1[1]), "+v"(sc1[2]), "+v"(sc1[3]) \
                 : "v"(a0[0]), "v"(a0[1]), "v"(a0[2]), "v"(a0[3]), "v"(a1[0]), "v"(a1[1]), "v"(a1[2]), "v"(a1[3]), "v"(wh), \
                   "v"(kf[0][0]), "v"(kf[0][1]), "v"(kf[1][0]), "v"(kf[1][1]), "v"(qn[0]), "v"(qn[1]))
    if (FIRST) DSA_HS("s_nop 3\n\t"); else DSA_HS("");
#undef DSA_HS
}
__device__ __forceinline__ void abs_fma8(f32x4& s0, f32x4& s1, const f32x4& a0, const f32x4& a1, float wh) {
    asm volatile("s_nop 1\n\tv_fma_f32 %0, |%8|, %16, %0\n\tv_fma_f32 %1, |%9|, %16, %1\n\tv_fma_f32 %2, |%10|, %16, %2\n\tv_fma_f32 %3, |%11|, %16, %3\n\t"
                 "v_fma_f32 %4, |%12|, %16, %4\n\tv_fma_f32 %5, |%13|, %16, %5\n\tv_fma_f32 %6, |%14|, %16, %6\n\tv_fma_f32 %7, |%15|, %16, %7"
                 : "+v"(s0[0]), "+v"(s0[1]), "+v"(s0[2]), "+v"(s0[3]), "+v"(s1[0]), "+v"(s1[1]), "+v"(s1[2]), "+v"(s1[3])
                 : "v"(a0[0]), "v"(a0[1]), "v"(a0[2]), "v"(a0[3]), "v"(a1[0]), "v"(a1[1]), "v"(a1[2]), "v"(a1[3]), "v"(wh));
}
__device__ __forceinline__ float relu_i(float x) { const int b = __builtin_bit_cast(int, x); return __builtin_bit_cast(float, b > 0 ? b : 0); }
__device__ __forceinline__ bool ahead(float sj, unsigned ij, float si, unsigned ii) { return sj > si || (sj == si && ij < ii); }

template <bool PASS2>
__device__ __forceinline__ void score_consume(ldsp L, DGAS u32x2* pool, const f32x4& sc0, const f32x4& sc1, int j, int qloc, int g, int e0, float tauA, float tauB) {
    if (!PASS2) {
#pragma unroll
        for (int k = 0; k < 8; ++k) { const unsigned u = __float_as_uint((k >> 2) ? sc1[k & 3] : sc0[k & 3]);
            int rel = (int)((u >> 19) & 0xFFFu) - e0; rel = rel < 0 ? 0 : (rel > 255 ? 255 : rel);
            __hip_atomic_fetch_add((DLAS unsigned*)(L + L_HIST + qloc * (NBIN * 2)) + rel, (int)u < 0 ? 0x10000u : 1u, __ATOMIC_RELAXED, __HIP_MEMORY_SCOPE_WORKGROUP); }
    }
}
struct Pend { unsigned mA, mB, pa, pb; int j; f32x4 s0, s1; };
__device__ __forceinline__ void pend_issue(ldsp L, Pend& P, const f32x4& sc0, const f32x4& sc1, int j, int qloc, float tauA, float tauB) {
    unsigned mA = 0u, mB = 0u;
#pragma unroll
    for (int k = 0; k < 8; ++k) { const float x = (k >> 2) ? sc1[k & 3] : sc0[k & 3]; mA |= (x >= tauA) ? (1u << k) : 0u; mB |= (x >= tauB && !(x >= tauA)) ? (1u << k) : 0u; }
    const bool up = (j & 1) == 0;
    P.pa = __hip_atomic_fetch_add((DLAS unsigned*)(L + (up ? L_CNTA : L_CNTA1)) + qloc, (unsigned)__builtin_popcount(mA), __ATOMIC_RELAXED, __HIP_MEMORY_SCOPE_WORKGROUP);
    P.pb = __hip_atomic_fetch_add((DLAS unsigned*)(L + L_CNTB) + qloc, (unsigned)__builtin_popcount(mB), __ATOMIC_RELAXED, __HIP_MEMORY_SCOPE_WORKGROUP);
    P.mA = mA; P.mB = mB; P.j = j; P.s0 = sc0; P.s1 = sc1;
}
__device__ __forceinline__ void pend_finish(ldsp L, DGAS u32x2* pool, Pend& P, int qloc, int g) {
    const bool up = (P.j & 1) == 0;
    unsigned pa = P.pa, pb = P.pb;
    const unsigned kbase = (unsigned)(32 * P.j + 4 * g);
    {
        DLAS unsigned short* la = (DLAS unsigned short*)(L + L_LISTA) + qloc * TOPK;
        for (unsigned m = P.mA; m; m &= m - 1u) { const unsigned k = (unsigned)__builtin_ctz(m);
            if (pa < (unsigned)TOPK) la[up ? pa : (unsigned)(TOPK - 1) - pa] = (unsigned short)(kbase + 4u * (k & 4u) + (k & 3u)); ++pa; }
    }
    {
        DLAS float* lbs = (DLAS float*)(L + L_HIST) + qloc * CAP2; DLAS unsigned short* lbk = (DLAS unsigned short*)(L + L_LBK) + qloc * CAP2;
        for (unsigned m = P.mB; m; m &= m - 1u) { const unsigned k = (unsigned)__builtin_ctz(m);
            const f32x4 v = (k & 4u) ? P.s1 : P.s0; const float xs = (k & 2u) ? ((k & 1u) ? v[3] : v[2]) : ((k & 1u) ? v[1] : v[0]); const unsigned key = kbase + 4u * (k & 4u) + (k & 3u);
            if (pb < (unsigned)CAP2) { lbs[pb] = xs; lbk[pb] = (unsigned short)key; }
            else { const unsigned gp = __hip_atomic_fetch_add((DLAS unsigned*)(L + L_POOLC), 1u, __ATOMIC_RELAXED, __HIP_MEMORY_SCOPE_WORKGROUP); if (gp < (unsigned)POOLCAP) pool[gp] = (u32x2){__float_as_uint(xs), ((unsigned)qloc << 16) | key}; }
            ++pb; }
    }
    P.mA = 0u; P.mB = 0u;
}
template <bool PASS2>
__device__ __forceinline__ void score_tile(ldsp L, DGAS u32x2* pool, const bf16x8 (&kf)[2][2], int j, int qloc, int g, const bf16x8 (&qf)[8][2], const bf16x8 (&ql)[2], const float (&w)[8], int e0, float tauA, float tauB, __amdgpu_buffer_rsrc_t rsS, int so, int lane, Pend& P) {
    f32x4 sc0, sc1, a0, a1, b0, b1;
    tile_open(sc0, sc1, a0, a1, kf, ql, qf[0]);
    head_step<true>(b0, b1, sc0, sc1, a0, a1, w[0], kf, qf[1]);
    head_step<false>(a0, a1, sc0, sc1, b0, b1, w[1], kf, qf[2]);
    head_step<false>(b0, b1, sc0, sc1, a0, a1, w[2], kf, qf[3]);
    head_step<false>(a0, a1, sc0, sc1, b0, b1, w[3], kf, qf[4]);
    head_step<false>(b0, b1, sc0, sc1, a0, a1, w[4], kf, qf[5]);
    head_step<false>(a0, a1, sc0, sc1, b0, b1, w[5], kf, qf[6]);
    head_step<false>(b0, b1, sc0, sc1, a0, a1, w[6], kf, qf[7]);
    abs_fma8(sc0, sc1, b0, b1, w[7]);
    if (!PASS2) { if (so >= 0) { __builtin_amdgcn_raw_buffer_store_b128(__builtin_bit_cast(u32x4, sc0), rsS, lane * 16, so, 16); __builtin_amdgcn_raw_buffer_store_b128(__builtin_bit_cast(u32x4, sc1), rsS, 1024 + lane * 16, so, 16); } }
    if (PASS2) { pend_finish(L, pool, P, qloc, g); pend_issue(L, P, sc0, sc1, j, qloc, tauA, tauB); }
    else score_consume<false>(L, pool, sc0, sc1, j, qloc, g, e0, tauA, tauB);
}
template <bool PASS2>
__device__ __forceinline__ void score_pass(ldsp L, DGAS u32x2* pool, const DGAS bf16* KIb, int NT, int kh, int qloc, int n16, int g, const bf16x8 (&qf)[8][2], const bf16x8 (&ql)[2], const float (&w)[8], int e0, float tauA, float tauB, DGAS f32x4* stB, DGAS f32x4* stA, int lane) {
    const int nIt = (NT - kh + 1) >> 1;
    const int nS = stB ? (nIt < STASH_B + STASH_A ? nIt : STASH_B + STASH_A) : 0;
    const __amdgpu_buffer_rsrc_t rsB = __builtin_amdgcn_make_buffer_rsrc((void*)stB, (short)0, STASH_B * 2048, 0x00020000), rsA = __builtin_amdgcn_make_buffer_rsrc((void*)stA, (short)0, STASH_A * 2048, 0x00020000);
#define DSA_SRS(I) ((I) < STASH_B ? rsB : rsA)
#define DSA_SOF(I) ((I) < nS ? ((I) < STASH_B ? (I) * 2048 : ((I) - STASH_B) * 2048) : -1)
    const __amdgpu_buffer_rsrc_t rsK = __builtin_amdgcn_make_buffer_rsrc((void*)KIb, (short)0, 8192 * 64 * 2, 0x00020000); const int voff = (n16 * 64 + 8 * g) * 2 + kh * (32 * 64 * 2);
    bf16x8 k0[2][2], k1[2][2], k2[2][2];
    const f32x4 zp4 = {0.f, 0.f, 0.f, 0.f}; Pend P{0u, 0u, 0u, 0u, 0, zp4, zp4};
#define DSA_LOADK(KF, IT) do { const int it_ = (IT) < nIt ? (IT) : nIt - 1; const int so_ = it_ * (64 * 64 * 2); \
        _Pragma("unroll") for (int t = 0; t < 2; ++t) _Pragma("unroll") for (int ks = 0; ks < 2; ++ks) KF[t][ks] = __builtin_bit_cast(bf16x8, __builtin_amdgcn_raw_buffer_load_b128(rsK, voff + (t * 16 * 64 + 32 * ks) * 2, so_, 0)); asm volatile("" ::: "memory"); } while (0)
    int it = 0;
    if (PASS2) {
        if (nS > 0) {
#define DSA_LDG(X, BASE) do { _Pragma("unroll") for (int t = 0; t < 4; ++t) { const int i_ = (BASE) + t < nS ? (BASE) + t : nS - 1; \
                if (i_ < STASH_B) { X[t][0] = __builtin_bit_cast(f32x4, __builtin_amdgcn_raw_buffer_load_b128(rsB, lane * 16, i_ * 2048, 16)); X[t][1] = __builtin_bit_cast(f32x4, __builtin_amdgcn_raw_buffer_load_b128(rsB, 1024 + lane * 16, i_ * 2048, 16)); } \
                else { X[t][0] = __builtin_bit_cast(f32x4, __builtin_amdgcn_raw_buffer_load_b128(rsA, lane * 16, (i_ - STASH_B) * 2048, 16)); X[t][1] = __builtin_bit_cast(f32x4, __builtin_amdgcn_raw_buffer_load_b128(rsA, 1024 + lane * 16, (i_ - STASH_B) * 2048, 16)); } } } while (0)
#define DSA_CSG(X, BASE) do { _Pragma("unroll") for (int t = 0; t < 4; ++t) if ((BASE) + t < nS) { pend_finish(L, pool, P, qloc, g); pend_issue(L, P, X[t][0], X[t][1], kh + 2 * ((BASE) + t), qloc, tauA, tauB); } } while (0)
            f32x4 ga[4][2], gb[4][2];
            DSA_LDG(ga, 0);
            for (int b8 = 0; b8 < nS; b8 += 8) {
                DSA_LDG(gb, b8 + 4); DSA_CSG(ga, b8);
                DSA_LDG(ga, b8 + 8); DSA_CSG(gb, b8 + 4);
            }
#undef DSA_LDG
#undef DSA_CSG
            it = nS;
        }
    }
    DSA_LOADK(k0, it); DSA_LOADK(k1, it + 1);
    for (; it + 3 <= nIt; it += 3) {
        DSA_LOADK(k2, it + 2); score_tile<PASS2>(L, pool, k0, kh + 2 * it, qloc, g, qf, ql, w, e0, tauA, tauB, DSA_SRS(it), PASS2 ? -1 : DSA_SOF(it), lane, P);
        DSA_LOADK(k0, it + 3); score_tile<PASS2>(L, pool, k1, kh + 2 * it + 2, qloc, g, qf, ql, w, e0, tauA, tauB, DSA_SRS(it + 1), PASS2 ? -1 : DSA_SOF(it + 1), lane, P);
        DSA_LOADK(k1, it + 4); score_tile<PASS2>(L, pool, k2, kh + 2 * it + 4, qloc, g, qf, ql, w, e0, tauA, tauB, DSA_SRS(it + 2), PASS2 ? -1 : DSA_SOF(it + 2), lane, P);
    }
    if (it < nIt) {
        score_tile<PASS2>(L, pool, k0, kh + 2 * it, qloc, g, qf, ql, w, e0, tauA, tauB, DSA_SRS(it), PASS2 ? -1 : DSA_SOF(it), lane, P);
        if (it + 1 < nIt) score_tile<PASS2>(L, pool, k1, kh + 2 * it + 2, qloc, g, qf, ql, w, e0, tauA, tauB, DSA_SRS(it + 1), PASS2 ? -1 : DSA_SOF(it + 1), lane, P);
    }
    if (PASS2) pend_finish(L, pool, P, qloc, g);
#undef DSA_LOADK
#undef DSA_SRS
#undef DSA_SOF
}

struct Tensors { const DGAS bf16* QI; const DGAS bf16* KI; const DGAS float* WI; const DGAS bf16* QA; const DGAS bf16* KA; const DGAS bf16* VA; DGAS bf16* OA; const DGAS float* KMAX; };

__device__ __forceinline__ void unit(ldsp L, unsigned char* wsb, unsigned char* ob, int b, int c, int wave_in) {
    asm volatile("" : "+s"(wsb), "+s"(ob));
    const Tensors T{(const DGAS bf16*)(wsb + WS_QI), (const DGAS bf16*)(wsb + WS_KI), (const DGAS float*)(wsb + WS_WI), (const DGAS bf16*)(wsb + WS_QA), (const DGAS bf16*)(wsb + WS_KA), (const DGAS bf16*)(wsb + WS_VA), (DGAS bf16*)ob, (const DGAS float*)(wsb + WS_CUM + MiB)};
    int tid_; { int ln_; asm volatile("v_mbcnt_lo_u32_b32 %0, -1, 0\n\tv_mbcnt_hi_u32_b32 %0, -1, %0" : "=v"(ln_)); tid_ = wave_in * 64 + ln_; }
    const int tid = tid_, lane = tid & 63, wave = __builtin_amdgcn_readfirstlane(tid >> 6);
    const int N = 64 * (c + 1), t0 = 64 * c;
    DGAS u32x2* const pool = (DGAS u32x2*)(wsb + WS_H) + (size_t)blockIdx.x * POOLCAP;
    const bool stash_ok = gridDim.x <= 256;
    DGAS f32x4* const stB = stash_ok ? (DGAS f32x4*)(ob + 64 * MiB + ((size_t)blockIdx.x * 8 + wave) * (STASH_B * 2048)) : (DGAS f32x4*)nullptr;
    DGAS f32x4* const stA = (DGAS f32x4*)(wsb + WS_H + 16 * MiB + ((size_t)blockIdx.x * 8 + wave) * (STASH_A * 2048));
    const size_t rowb = (size_t)b * 8192;
#ifndef REP_DSA_IDX
#define REP_DSA_IDX 1
#endif
#ifndef REP_DSA_ATT
#define REP_DSA_ATT 1
#endif
    for (int rep_i = 0; rep_i < REP_DSA_IDX; ++rep_i) {
    for (int i = tid; i < 64 * 6; i += 512) ((DLAS unsigned*)(L + L_CNTA))[i] = 0u;
    if (tid == 0) *(DLAS unsigned*)(L + L_POOLC) = 0u;
    if (tid < 64) ((DLAS unsigned*)(L + L_CNTA1))[tid] = 0u;
    if (N > TOPK) { u32x4 z4u = {0u, 0u, 0u, 0u}; asm volatile("" : "+v"(z4u)); for (int i = tid; i < 64 * NBIN / 2 / 4; i += 512) ((DLAS u32x4*)(L + L_HIST))[i] = z4u; }
    __syncthreads();
    if (N > TOPK) {
        const int n16 = lane & 15, g = lane >> 4, qsub = wave & 3, kh = wave >> 2, qloc = 16 * qsub + n16;
        const size_t rowq = rowb + t0 + qloc;
        bf16x8 qf[8][2]; float w[8];
#pragma unroll
        for (int h = 0; h < 8; ++h)
#pragma unroll
            for (int ks = 0; ks < 2; ++ks) qf[h][ks] = *(const DGAS bf16x8*)(T.QI + rowq * 512 + h * 64 + 32 * ks + 8 * g);
        { const f32x4 w0 = *(const DGAS f32x4*)(T.WI + rowq * 8), w1 = *(const DGAS f32x4*)(T.WI + rowq * 8 + 4);
          w[0] = w0[0]; w[1] = w0[1]; w[2] = w0[2]; w[3] = w0[3]; w[4] = w1[0]; w[5] = w1[1]; w[6] = w1[2]; w[7] = w1[3]; }
        float U = 0.f;
#pragma unroll
        for (int h = 0; h < 8; ++h) { float n2 = 0.f;
#pragma unroll
            for (int ks = 0; ks < 2; ++ks)
#pragma unroll
                for (int e = 0; e < 8; ++e) { const float x = __uint_as_float(((unsigned)(unsigned short)qf[h][ks][e]) << 16); n2 = fmaf(x, x, n2); }
            n2 += lane_read(n2, lane ^ 16); n2 += lane_read(n2, lane ^ 32);
            U += fabsf(w[h]) * sqrtf(n2); }
        U *= sqrtf(T.KMAX[b]) * 1.01f;
        bf16x8 ql[2];
#pragma unroll
        for (int h = 0; h < 8; ++h) w[h] *= 0.5f;
#pragma unroll
        for (int ks = 0; ks < 2; ++ks) { float acc8[8];
#pragma unroll
            for (int e = 0; e < 8; ++e) { float a = 0.f;
#pragma unroll
                for (int h = 0; h < 8; ++h) a = fmaf(w[h], __uint_as_float(((unsigned)(unsigned short)qf[h][ks][e]) << 16), a);
                acc8[e] = a; }
            u32x4 pk; pk.x = attn_body::cvtpk_s(acc8[0], acc8[1]); pk.y = attn_body::cvtpk_s(acc8[2], acc8[3]); pk.z = attn_body::cvtpk_s(acc8[4], acc8[5]); pk.w = attn_body::cvtpk_s(acc8[6], acc8[7]);
            ql[ks] = __builtin_bit_cast(bf16x8, pk); }
        const int e0 = (int)((__float_as_uint(U) >> 19) & 0xFFFu) + 1 - 255;
        const int NT = N / 32;
        score_pass<false>(L, pool, T.KI + rowb * 64, NT, kh, qloc, n16, g, qf, ql, w, e0, 0.f, 0.f, stB, stA, lane);
        __syncthreads();
        { int lane_t = lane; asm volatile("" : "+v"(lane_t)); const int lane = lane_t;
        for (int qq = 0; qq < 8; ++qq) {
            const int q = 8 * wave + qq;
            const u32x4 hw = *((DLAS u32x4*)(L + L_HIST + q * (NBIN * 2)) + lane);
            const unsigned pc[4] = {hw.x & 0xffffu, hw.y & 0xffffu, hw.z & 0xffffu, hw.w & 0xffffu}, nc[4] = {hw.x >> 16, hw.y >> 16, hw.z >> 16, hw.w >> 16};
            const unsigned totP = (pc[0] + pc[1]) + (pc[2] + pc[3]), totN = (nc[0] + nc[1]) + (nc[2] + nc[3]);
            const unsigned preP = wave_incl_prefix(totP);
            const unsigned TP = (unsigned)__builtin_amdgcn_readlane((int)preP, 63);
            const unsigned sufP = TP - preP + totP;
            if (TP >= (unsigned)TOPK) {
                const unsigned above = sufP - totP;
                if (above < (unsigned)TOPK && sufP >= (unsigned)TOPK) {
                    unsigned run = above; int bsel = 256 + 4 * lane, found = 0;
#pragma unroll
                    for (int k = 3; k >= 0; --k) { if (!found) { if (run + pc[k] >= (unsigned)TOPK) { bsel = 256 + 4 * lane + k; found = 1; } else run += pc[k]; } }
                    ((DLAS int*)(L + L_THR))[q] = bsel; ((DLAS int*)(L + L_R))[q] = TOPK - (int)run;
                }
            } else {
                const unsigned need = (unsigned)TOPK - TP;
                const unsigned preN = wave_incl_prefix(totN);
                const unsigned below = preN - totN;
                if (below < need && preN >= need) {
                    unsigned run = below; int bsel = 255 - 4 * lane, found = 0;
#pragma unroll
                    for (int k = 0; k < 4; ++k) { if (!found) { if (run + nc[k] >= need) { bsel = 255 - (4 * lane + k); found = 1; } else run += nc[k]; } }
                    ((DLAS int*)(L + L_THR))[q] = bsel; ((DLAS int*)(L + L_R))[q] = (int)(need - run);
                }
            }
        }
        }
        __syncthreads();
        const int thr = ((DLAS int*)(L + L_THR))[qloc];
        __syncthreads();
        score_pass<true>(L, pool, T.KI + rowb * 64, NT, kh, qloc, n16, g, qf, ql, w, e0, bin_edge(thr + 1, e0), bin_edge(thr, e0), stB, stA, lane);
        __syncthreads();
        for (int qq = 0; qq < 8; ++qq) {
            const int q = 8 * wave + qq;
            const unsigned nBraw = ((DLAS unsigned*)(L + L_CNTB))[q]; const int nB = nBraw < (unsigned)CAP2 ? (int)nBraw : CAP2;
            const int R = ((DLAS int*)(L + L_R))[q]; const int nA0 = (int)((DLAS unsigned*)(L + L_CNTA))[q]; const int base = nA0 < TOPK - R ? nA0 : TOPK - R;
            const DLAS float* lbs = (const DLAS float*)(L + L_HIST) + q * CAP2; const DLAS unsigned short* lbk = (const DLAS unsigned short*)(L + L_LBK) + q * CAP2;
            DLAS unsigned short* la = (DLAS unsigned short*)(L + L_LISTA) + q * TOPK;
            const int thrq = ((DLAS int*)(L + L_THR))[q];
            if (nBraw <= (unsigned)CAP2 && thrq != 0 && thrq != 255 && thrq != 256 && thrq != 511) {
                const unsigned flip = thrq < 256 ? 0x7FFFFu : 0u;
                unsigned k0 = 0u, k1 = 0u, k2 = 0u, i0 = 0u, i1 = 0u, i2 = 0u;
                if (lane < nB) { i0 = lbk[lane]; k0 = (((__float_as_uint(lbs[lane]) ^ flip) & 0x7FFFFu) << 13) | (8191u - i0); }
                if (lane + 64 < nB) { i1 = lbk[lane + 64]; k1 = (((__float_as_uint(lbs[lane + 64]) ^ flip) & 0x7FFFFu) << 13) | (8191u - i1); }
                if (lane + 128 < nB) { i2 = lbk[lane + 128]; k2 = (((__float_as_uint(lbs[lane + 128]) ^ flip) & 0x7FFFFu) << 13) | (8191u - i2); }
                DLAS unsigned* kw = (DLAS unsigned*)(L + L_KW + wave * (CAP2 * 4));
                kw[lane] = k0; kw[lane + 64] = k1; kw[lane + 128] = k2;
                int rk0 = 0, rk1 = 0, rk2 = 0;
                const int n4 = (nB + 3) >> 2;
                if (nB <= 64) {
#pragma unroll 4
                    for (int j4 = 0; j4 < n4; ++j4) { const u32x4 kq = *((const DLAS u32x4*)kw + j4);
                        rk0 += (kq.x > k0 ? 1 : 0) + (kq.y > k0 ? 1 : 0) + (kq.z > k0 ? 1 : 0) + (kq.w > k0 ? 1 : 0); }
                } else {
#pragma unroll 2
                    for (int j4 = 0; j4 < n4; ++j4) { const u32x4 kq = *((const DLAS u32x4*)kw + j4);
                        rk0 += (kq.x > k0 ? 1 : 0) + (kq.y > k0 ? 1 : 0) + (kq.z > k0 ? 1 : 0) + (kq.w > k0 ? 1 : 0);
                        rk1 += (kq.x > k1 ? 1 : 0) + (kq.y > k1 ? 1 : 0) + (kq.z > k1 ? 1 : 0) + (kq.w > k1 ? 1 : 0);
                        rk2 += (kq.x > k2 ? 1 : 0) + (kq.y > k2 ? 1 : 0) + (kq.z > k2 ? 1 : 0) + (kq.w > k2 ? 1 : 0); }
                }
                if (lane < nB && rk0 < R) la[base + rk0] = (unsigned short)i0;
                if (lane + 64 < nB && rk1 < R) la[base + rk1] = (unsigned short)i1;
                if (lane + 128 < nB && rk2 < R) la[base + rk2] = (unsigned short)i2;
                if (lane == 0) ((DLAS int*)(L + L_NSEL))[q] = TOPK - R + (nB < R ? nB : R);
                if (nB < R) { const int nA1 = TOPK - R - base; for (int i = lane; i < nA1; i += 64) { const unsigned short kk = la[TOPK - nA1 + i]; la[base + nB + i] = kk; } }
            } else {
                float s0 = 0.f, s1 = 0.f, s2 = 0.f; unsigned i0 = 0u, i1 = 0u, i2 = 0u;
                if (lane < nB) { s0 = lbs[lane]; i0 = lbk[lane]; }
                if (lane + 64 < nB) { s1 = lbs[lane + 64]; i1 = lbk[lane + 64]; }
                if (lane + 128 < nB) { s2 = lbs[lane + 128]; i2 = lbk[lane + 128]; }
                int rk0 = 0, rk1 = 0, rk2 = 0;
                for (int j = 0; j < nB; ++j) { const float sj = lbs[j]; const unsigned ij = lbk[j];
                    rk0 += ahead(sj, ij, s0, i0) ? 1 : 0; rk1 += ahead(sj, ij, s1, i1) ? 1 : 0; rk2 += ahead(sj, ij, s2, i2) ? 1 : 0; }
                int ntot = nB;
                if (nBraw > (unsigned)CAP2) {
                    const unsigned pcr = *(const DLAS unsigned*)(L + L_POOLC); const int np = pcr < (unsigned)POOLCAP ? (int)pcr : POOLCAP;
                    for (int p = 0; p < np; ++p) { const unsigned long long e = __hip_atomic_load((DGAS unsigned long long*)(pool + p), __ATOMIC_RELAXED, __HIP_MEMORY_SCOPE_AGENT);
                        const unsigned tg = (unsigned)(e >> 32); if ((tg >> 16) != (unsigned)q) continue; const float sj = __uint_as_float((unsigned)e); const unsigned ij = tg & 0xffffu; ++ntot;
                        rk0 += ahead(sj, ij, s0, i0) ? 1 : 0; rk1 += ahead(sj, ij, s1, i1) ? 1 : 0; rk2 += ahead(sj, ij, s2, i2) ? 1 : 0; }
                    for (int p0 = 0; p0 < np; p0 += 64) {
                        const int p = p0 + lane; unsigned long long e = 0ull; if (p < np) e = __hip_atomic_load((DGAS unsigned long long*)(pool + p), __ATOMIC_RELAXED, __HIP_MEMORY_SCOPE_AGENT);
                        const unsigned tg = (unsigned)(e >> 32); const bool mine = (p < np) && ((tg >> 16) == (unsigned)q); const float si = __uint_as_float((unsigned)e); const unsigned ii = tg & 0xffffu;
                        int rk = 0;
                        for (int j = 0; j < nB; ++j) rk += ahead(lbs[j], lbk[j], si, ii) ? 1 : 0;
                        for (int j = 0; j < np; ++j) { const unsigned long long f = __hip_atomic_load((DGAS unsigned long long*)(pool + j), __ATOMIC_RELAXED, __HIP_MEMORY_SCOPE_AGENT);
                            const unsigned tf = (unsigned)(f >> 32); if ((tf >> 16) == (unsigned)q) rk += ahead(__uint_as_float((unsigned)f), tf & 0xffffu, si, ii) ? 1 : 0; }
                        if (mine && rk < R) la[base + rk] = (unsigned short)ii;
                    }
                }
                if (lane < nB && rk0 < R) la[base + rk0] = (unsigned short)i0;
                if (lane + 64 < nB && rk1 < R) la[base + rk1] = (unsigned short)i1;
                if (lane + 128 < nB && rk2 < R) la[base + rk2] = (unsigned short)i2;
                if (lane == 0) ((DLAS int*)(L + L_NSEL))[q] = TOPK - R + (ntot < R ? ntot : R);
                if (ntot < R) { const int nA1 = TOPK - R - base; for (int i = lane; i < nA1; i += 64) { const unsigned short kk = la[TOPK - nA1 + i]; la[base + ntot + i] = kk; } }
            }
        }
    } else {
        for (int i = tid; i < 64 * TOPK; i += 512) ((DLAS unsigned short*)(L + L_LISTA))[i] = (unsigned short)(i & (TOPK - 1));
        if (tid < 64) ((DLAS int*)(L + L_NSEL))[tid] = N;
    }
    __syncthreads();
    }
    {
        int lane_a = lane; asm volatile("" : "+v"(lane_a));
        const int lane = lane_a, n16 = lane & 15, g = lane >> 4, q4 = n16 >> 2, p4 = lane & 3;
        ldsp vst = L + L_HIST + wave * (64 * VST);
        const attn_body::lds_cptr vrd = (attn_body::lds_cptr)(vst + (4 * g + q4) * VST + 4 * p4 * 2);
        const DGAS bf16* KAb = T.KA + rowb * 64; const DGAS bf16* VAb = T.VA + rowb * 64;
        const int vsl = lane >> 3, vch = lane & 7;
#define DSA_REQ(R, LA, NSEL, J) do { const __amdgpu_buffer_rsrc_t rs_ = ((J) < 4) ? rsKA : rsVA; \
            const u32x4 ix_ = *(const DLAS u32x4*)((LA) + 64 * ((J) & 3) + 8 * vsl);        \
            const unsigned iw_[4] = {ix_.x, ix_.y, ix_.z, ix_.w}; \
            _Pragma("unroll") for (int i = 0; i < 8; ++i) { const unsigned key = ((i & 1) ? (iw_[i >> 1] >> 16) : iw_[i >> 1]) & 8191u; \
                R[i] = __builtin_amdgcn_raw_buffer_load_b128(rs_, (int)(key * 128u + (unsigned)vch * 16u), 0, 0); } } while (0)
#define DSA_PUT(R) do { _Pragma("unroll") for (int i = 0; i < 8; ++i) *(DLAS u32x4*)(vst + (8 * vsl + i) * VST + vch * 16) = R[i]; } while (0)
        const __amdgpu_buffer_rsrc_t rsKA = __builtin_amdgcn_make_buffer_rsrc((void*)KAb, (short)0, 8192 * 128, 0x00020000), rsVA = __builtin_amdgcn_make_buffer_rsrc((void*)VAb, (short)0, 8192 * 128, 0x00020000);
        const bf16x8 zf = {0, 0, 0, 0, 0, 0, 0, 0};
        u32x4 vr[2][8]; bf16x8 qn0 = zf, qn1 = zf;
        { const int q = 8 * wave; const int nsel = ((DLAS int*)(L + L_NSEL))[q]; const DLAS unsigned short* la = (const DLAS unsigned short*)(L + L_LISTA) + q * TOPK; const size_t row = rowb + t0 + q;
          DSA_REQ(vr[0], la, nsel, 0); DSA_REQ(vr[1], la, nsel, 1);
          if (n16 < 8) { qn0 = *(const DGAS bf16x8*)(T.QA + row * 512 + n16 * 64 + 8 * g); qn1 = *(const DGAS bf16x8*)(T.QA + row * 512 + n16 * 64 + 32 + 8 * g); } }
        for (int qq = 0; qq < 8 * REP_DSA_ATT; ++qq) {
            const int q = 8 * wave + (qq & 7); const size_t row = rowb + t0 + q;
            const int nsel = ((DLAS int*)(L + L_NSEL))[q];
            const DLAS unsigned short* la = (const DLAS unsigned short*)(L + L_LISTA) + q * TOPK;
            const int qx = 8 * wave + ((qq + 1 < 8 * REP_DSA_ATT) ? ((qq + 1) & 7) : (qq & 7));
            const int nseln = ((DLAS int*)(L + L_NSEL))[qx]; const DLAS unsigned short* lan = (const DLAS unsigned short*)(L + L_LISTA) + qx * TOPK; const size_t rown = rowb + t0 + qx;
            const bf16x8 qb0 = qn0, qb1 = qn1;
            f32x4 sa[16];
#pragma unroll
            for (int cst = 0; cst < 4; ++cst) {
                DSA_PUT(vr[cst & 1]);
                DSA_REQ(vr[cst & 1], la, nsel, cst + 2);
#pragma unroll
                for (int t4 = 0; t4 < 4; ++t4) {
                    const bf16x8 a0 = *(const DLAS bf16x8*)(vst + (16 * t4 + n16) * VST + 16 * g), a1 = *(const DLAS bf16x8*)(vst + (16 * t4 + n16) * VST + 64 + 16 * g);
                    f32x4 s = {0.f, 0.f, 0.f, 0.f};
                    s = __builtin_amdgcn_mfma_f32_16x16x32_bf16(a0, qb0, s, 0, 0, 0);
                    s = __builtin_amdgcn_mfma_f32_16x16x32_bf16(a1, qb1, s, 0, 0, 0);
                    sa[4 * cst + t4] = s;
                }
            }
            float m = -INFINITY;
#pragma unroll
            for (int tt = 0; tt < 16; ++tt)
#pragma unroll
                for (int i = 0; i < 4; ++i) { if (16 * tt + 4 * g + i >= nsel) sa[tt][i] = -INFINITY; m = fmaxf(m, sa[tt][i]); }
            m = fmaxf(m, lane_read(m, lane ^ 16)); m = fmaxf(m, lane_read(m, lane ^ 32));
            float ls = 0.f;
#pragma unroll
            for (int tt = 0; tt < 16; ++tt)
#pragma unroll
                for (int i = 0; i < 4; ++i) { const float p = __builtin_amdgcn_exp2f(sa[tt][i] - m); sa[tt][i] = p; ls += p; }
            ls += lane_read(ls, lane ^ 16); ls += lane_read(ls, lane ^ 32);
            if (g == 0) ((DLAS float*)(L + L_LSUM))[wave * 16 + n16] = ls;
            f32x4 o[4];
#pragma unroll
            for (int nb = 0; nb < 4; ++nb) o[nb] = (f32x4){0.f, 0.f, 0.f, 0.f};
#pragma unroll
            for (int cst = 0; cst < 4; ++cst) {
                DSA_PUT(vr[cst & 1]);
                if (cst < 2) DSA_REQ(vr[cst & 1], la, nsel, cst + 6);
                else { DSA_REQ(vr[cst & 1], lan, nseln, cst - 2);
                       if (cst == 2 && n16 < 8) { qn0 = *(const DGAS bf16x8*)(T.QA + rown * 512 + n16 * 64 + 8 * g); qn1 = *(const DGAS bf16x8*)(T.QA + rown * 512 + n16 * 64 + 32 + 8 * g); } }
#pragma unroll
                for (int s2 = 0; s2 < 2; ++s2) {
                    const int s = 2 * cst + s2;
                    u32x4 pw; pw.x = attn_body::cvtpk_s(sa[2 * s][0], sa[2 * s][1]); pw.y = attn_body::cvtpk_s(sa[2 * s][2], sa[2 * s][3]);
                    pw.z = attn_body::cvtpk_s(sa[2 * s + 1][0], sa[2 * s + 1][1]); pw.w = attn_body::cvtpk_s(sa[2 * s + 1][2], sa[2 * s + 1][3]);
                    const bf16x8 pa = __builtin_bit_cast(bf16x8, pw);
#pragma unroll
                    for (int nb = 0; nb < 4; ++nb) {
                        const s16x4 t1 = attn_body::vtr(vrd + (32 * s2) * VST + 32 * nb), t2 = attn_body::vtr(vrd + (32 * s2 + 16) * VST + 32 * nb);
                        const bf16x8 vb = {t1[0], t1[1], t1[2], t1[3], t2[0], t2[1], t2[2], t2[3]};
                        o[nb] = __builtin_amdgcn_mfma_f32_16x16x32_bf16(pa, vb, o[nb], 0, 0, 0);
                    }
                }
            }
            if (g < 2) {
                const f32x4 lv = *(const DLAS f32x4*)(L + L_LSUM + (wave * 16 + 4 * g) * 4);
#pragma unroll
                for (int i = 0; i < 4; ++i) { const float li = __builtin_amdgcn_rcpf(lv[i]);
#pragma unroll
                    for (int nb = 0; nb < 4; ++nb) T.OA[row * 1024 + (4 * g + i) * 64 + 16 * nb + n16] = (bf16)(attn_body::cvtpk_s(o[nb][i] * li, 0.f) & 0xffffu); }
            }
        }
    }
    __syncthreads();
}
#undef DSA_REQ
#undef DSA_PUT
#undef DLAS
#undef DGAS
}

constexpr int NWAVES = 8, NTHR = NWAVES * 64;
#define GAS __attribute__((address_space(1)))
#define LAS __attribute__((address_space(3)))
typedef unsigned short bf16;
typedef unsigned v4u __attribute__((ext_vector_type(4)));
typedef float f32x4 __attribute__((ext_vector_type(4)));
typedef short bf16x8 __attribute__((ext_vector_type(8)));
typedef GAS unsigned gu32;
#define RLX_AGENT __ATOMIC_RELAXED, __HIP_MEMORY_SCOPE_AGENT
#define LDS_WAIT() asm volatile("s_waitcnt lgkmcnt(0)" ::: "memory")
#define VM_WAIT() asm volatile("s_waitcnt vmcnt(0)" ::: "memory")
__device__ __forceinline__ unsigned f2bf(float f) { unsigned u = __builtin_bit_cast(unsigned, f); return (u + 0x7fffu + ((u >> 16) & 1u)) >> 16; }
__device__ __forceinline__ unsigned pk2(float lo, float hi) { return f2bf(lo) | (f2bf(hi) << 16); }

constexpr int RING_BYTES = 131072;
constexpr int LDSCTL_OFF = RING_BYTES, MISC_OFF = LDSCTL_OFF + 320;
constexpr int LDS_BYTES = 147456;
#define XB_TMO      128
#define XB_XCNT(j)  (256  + 64 * (j))
#define XB_XSUB(j)  (1280 + 64 * (j))
#define XB_XGEN(j)  (2304 + 64 * (j))
#define XB_TOP      3328
#define XB_TOPGEN   3392
#define XCD_BAR_WORDS 3456
#define XB_SPIN_CAP (1u << 18)

__device__ __forceinline__ unsigned xb_ld(unsigned* p)              { return __hip_atomic_load(p, __ATOMIC_RELAXED, __HIP_MEMORY_SCOPE_AGENT); }
__device__ __forceinline__ unsigned xb_add(unsigned* p, unsigned v) { return __hip_atomic_fetch_add(p, v, __ATOMIC_RELAXED, __HIP_MEMORY_SCOPE_AGENT); }
__device__ __forceinline__ unsigned xb_xcc_id() { return (unsigned)__builtin_amdgcn_s_getreg((3 << 11) | 20) & 0xFu; }
#define XB_SPIN(cond, bar) do { unsigned _sp = 0; while (cond) { __builtin_amdgcn_s_sleep(1); \
    if ((++_sp & 255u) == 0u) { if (xb_ld(&(bar)[XB_TMO])) break; if (_sp > XB_SPIN_CAP) { atomicAdd(&(bar)[XB_TMO], 1u); break; } } } } while (0)

struct XcdBarrier {
    unsigned* bar; unsigned x;
    volatile LAS unsigned* st;
};

__device__ __forceinline__ XcdBarrier xcd_barrier_post(unsigned* bar, volatile LAS unsigned* st, bool tid0) {
    XcdBarrier b; b.bar = bar; b.x = xb_xcc_id(); b.st = st;
    if (tid0) (void)xb_add(&bar[XB_XCNT(b.x)], 1u);
    return b;
}
__device__ __forceinline__ void xcd_barrier_complete(unsigned* bar, unsigned x, unsigned& nloc, unsigned& nx) {
    const unsigned G = gridDim.x * gridDim.y * gridDim.z;
    unsigned sum, cnt, mine, sp = 0u;
    for (;;) {
        sum = 0u; cnt = 0u; mine = 0u;
#pragma unroll
        for (unsigned j = 0; j < 16; ++j) { const unsigned c = xb_ld(&bar[XB_XCNT(j)]); sum += c; cnt += (c > 0u) ? 1u : 0u; mine = (j == x) ? c : mine; }
        if (sum == G) break;
        __builtin_amdgcn_s_sleep(1);
        if ((++sp & 255u) == 0u) { if (xb_ld(&bar[XB_TMO])) break; if (sp > XB_SPIN_CAP) { atomicAdd(&bar[XB_TMO], 1u); break; } }
    }
    nloc = mine > 0u ? mine : 1u; nx = cnt > 0u ? cnt : 1u;
}

__device__ __forceinline__ void xcd_barrier(const XcdBarrier& b, bool tid0) {
    asm volatile("s_waitcnt vmcnt(0)" ::: "memory");
    __syncthreads();
    if (tid0) {
        unsigned* bar = b.bar;
        __builtin_amdgcn_s_waitcnt(0);
        unsigned nloc = b.st[0], nx = b.st[1];
        if (nloc == 0u) { xcd_barrier_complete(bar, b.x, nloc, nx); b.st[0] = nloc; b.st[1] = nx; }
        const unsigned old = xb_add(&bar[XB_XSUB(b.x)], 1u);
        const unsigned gen = old / nloc;
        if (old + 1u == (gen + 1u) * nloc) {
            __builtin_amdgcn_fence(__ATOMIC_RELEASE, "agent");
            asm volatile("s_waitcnt vmcnt(0)" ::: "memory");
            const unsigned og = xb_add(&bar[XB_TOP], 1u);
            const unsigned tg = og / nx;
            if (og + 1u == (tg + 1u) * nx) xb_add(&bar[XB_TOPGEN], 1u);
            else XB_SPIN(xb_ld(&bar[XB_TOPGEN]) == tg, bar);
            __builtin_amdgcn_fence(__ATOMIC_ACQUIRE, "agent");
            xb_add(&bar[XB_XGEN(b.x)], 1u);
            asm volatile("s_waitcnt vmcnt(0)" ::: "memory");
        } else {
            XB_SPIN(xb_ld(&bar[XB_XGEN(b.x)]) == gen, bar);
            __builtin_amdgcn_fence(__ATOMIC_ACQUIRE, "agent");
            asm volatile("s_waitcnt vmcnt(0)" ::: "memory");
        }
    }
    __syncthreads();
}

__device__ __forceinline__ float wave_sum(float v, int lane) {
#pragma unroll
    for (int o = 1; o < 64; o <<= 1) v += lane_read(v, lane ^ o);
    return v;
}
__device__ __forceinline__ int ropeperm(int j) { return j < 4 ? j : j < 8 ? j + 4 : j < 12 ? j - 4 : j; }
template <int MAP> __device__ __forceinline__ int src_col(int n) {
    if (MAP == 0) return n;
    if (MAP == 2) { const int pn = n >> 8, w = n & 255; return w < 128 ? 128 * pn + w : DFF + 128 * pn + (w - 128); }
    const int t = n >> 8, w = n & 255;
    if (t < 2) return (n & ~63) + ropeperm(n & 63);
    if (t == 2) { if (w < 64) return 512 + ropeperm(w); if (w < 128) return 576 + (w - 64); if (w < 192) return 1152 + ropeperm(w - 128);
                  const int s = w - 192; return s < 8 ? 1216 + s : s < 16 ? 2760 + (s - 8) : -1; }
    if (t < 5) { const int hc = n - 768; return 640 + (hc & ~63) + ropeperm(hc & 63); }
    if (t < 7) return 1224 + (n - 1280);
    if (t < 9) return 1736 + (n - 1792);
    if (t < 11) return 2248 + (n - 2304);
    return 2768 + (n - 2816);
}
template <int MAP> __device__ __forceinline__ void transpose_item(const float* W, int K, int Nsrc, int Ndst, bf16* WT, LAS float* scr, int item, int lane, int ldk = 0, int kofs = 0) {
    if (ldk == 0) ldk = K;
    const int nblk = Ndst / 32, kb = item / nblk, nb = item % nblk, k0 = 64 * kb, n0 = 32 * nb;
    const int sc = src_col<MAP>(n0 + (lane & 31));
    float tv[32];
#pragma unroll
    for (int i = 0; i < 32; ++i) { const int kk = 2 * i + (lane >> 5); tv[i] = sc >= 0 ? ((const GAS float*)W)[(size_t)(k0 + kk) * Nsrc + sc] : 0.f; }
#pragma unroll
    for (int i = 0; i < 32; ++i) { const int kk = 2 * i + (lane >> 5); scr[kk * 33 + (lane & 31)] = tv[i]; }
    LDS_WAIT(); asm volatile("" ::: "memory");
    const int c = lane & 7;
#pragma unroll
    for (int j = 0; j < 4; ++j) { const int n = (lane >> 3) + 8 * j; const LAS float* s = scr + (8 * c) * 33 + n;
        v4u o; o.x = pk2(s[0 * 33], s[1 * 33]); o.y = pk2(s[2 * 33], s[3 * 33]); o.z = pk2(s[4 * 33], s[5 * 33]); o.w = pk2(s[6 * 33], s[7 * 33]);
        *(GAS v4u*)(WT + (size_t)(n0 + n) * ldk + kofs + k0 + 8 * c) = o; }
    LDS_WAIT(); asm volatile("" ::: "memory");
}
__device__ __forceinline__ void cos_sin_acc(float angf, float& co, float& si) {
    const double a = (double)angf, k = rint(a * 0.63661977236758134308), r = fma(-k, 6.123233995736766e-17, fma(-k, 1.5707963267948966, a)), r2 = r * r;
    double s = -1.0 / 39916800.0; s = fma(s, r2, 1.0 / 362880.0); s = fma(s, r2, -1.0 / 5040.0); s = fma(s, r2, 1.0 / 120.0); s = fma(s, r2, -1.0 / 6.0); s = fma(s * r2, r, r);
    double c = 1.0 / 479001600.0; c = fma(c, r2, -1.0 / 3628800.0); c = fma(c, r2, 1.0 / 40320.0); c = fma(c, r2, -1.0 / 720.0); c = fma(c, r2, 1.0 / 24.0); c = fma(c, r2, -0.5); c = fma(c, r2, 1.0);
    const int q = (int)((long long)k & 3);
    const double cc = (q == 0) ? c : (q == 1) ? -s : (q == 2) ? -c : s, ss = (q == 0) ? s : (q == 1) ? c : (q == 2) ? -s : -c;
    co = (float)cc; si = (float)ss;
}
__device__ __forceinline__ void load_vec16(const float* p, int lane, f32x4 (&v)[4]) {
#pragma unroll
    for (int j = 0; j < 4; ++j) v[j] = *((const GAS f32x4*)p + lane + 64 * j);
}
__device__ __forceinline__ void load_vec16b(const float* p, int lane, f32x4 (&v)[4]) {
#pragma unroll
    for (int j = 0; j < 2; ++j) { v[2 * j] = *(const GAS f32x4*)(p + 512 * j + 8 * lane); v[2 * j + 1] = *(const GAS f32x4*)(p + 512 * j + 8 * lane + 4); }
}
__device__ __forceinline__ void load_row16b(const bf16* row, int lane, f32x4 (&v)[4]) {
#pragma unroll
    for (int j = 0; j < 2; ++j) { const v4u w = *(const GAS v4u*)(row + 512 * j + 8 * lane);
        v[2 * j] = (f32x4){__uint_as_float(w.x << 16), __uint_as_float(w.x & 0xffff0000u), __uint_as_float(w.y << 16), __uint_as_float(w.y & 0xffff0000u)};
        v[2 * j + 1] = (f32x4){__uint_as_float(w.z << 16), __uint_as_float(w.z & 0xffff0000u), __uint_as_float(w.w << 16), __uint_as_float(w.w & 0xffff0000u)}; }
}
__device__ __forceinline__ void store_row16b(bf16* row, int lane, const f32x4 (&y)[4]) {
#pragma unroll
    for (int j = 0; j < 2; ++j) { v4u o; o.x = pk2(y[2 * j].x, y[2 * j].y); o.y = pk2(y[2 * j].z, y[2 * j].w); o.z = pk2(y[2 * j + 1].x, y[2 * j + 1].y); o.w = pk2(y[2 * j + 1].z, y[2 * j + 1].w);
        *(GAS v4u*)(row + 512 * j + 8 * lane) = o; }
}

#ifndef MK_ONE_LAUNCH
#define MK_ONE_LAUNCH 1
#endif
#ifndef REP_FOX
#define REP_FOX 1
#endif
#ifndef REP_DSA
#define REP_DSA 1
#endif
#ifndef REP_INPROJ
#define REP_INPROJ 1
#endif
#ifndef REP_P0
#define REP_P0 1
#endif
#ifndef REP_UP
#define REP_UP 1
#endif
#ifndef MK_STEP
#define MK_STEP 3
#endif
constexpr int NPL = 10, PH_FINAL = 1 + DEPTH * NPL, N_PHASES = PH_FINAL + 1;
struct Args { const float* in[17]; float* out; unsigned char* ws; int ph_lo, ph_hi, use_bar, pad; };
__global__ void __launch_bounds__(NTHR, 2) mk_fwd(Args args) {
    extern __shared__ __attribute__((aligned(16))) unsigned char lds[];
    LAS unsigned char* const L = (LAS unsigned char*)lds;
    volatile LAS unsigned* const MISC = (volatile LAS unsigned*)(L + MISC_OFF); (void)MISC;
#define PHASE_IDS() int tid; { int ws_ = wave_s, ln_; asm volatile("v_mbcnt_lo_u32_b32 %0, -1, 0\n\tv_mbcnt_hi_u32_b32 %0, -1, %0" : "=v"(ln_)); asm volatile("" : "+s"(ws_)); tid = ws_ * 64 + ln_; } int bx = blockIdx.x; asm volatile("" : "+s"(bx)); int G = (int)gridDim.x; asm volatile("" : "+s"(G)); \
    unsigned char* ws_l = args.ws; asm volatile("" : "+s"(ws_l)); unsigned char* const ws = ws_l; float* outp_l = args.out; asm volatile("" : "+s"(outp_l)); float* const outp = outp_l; \
    float* const MOD = (float*)(ws + WS_MOD); float* const CS = (float*)(ws + WS_CS); bf16* const H = (bf16*)(ws + WS_H); bf16* const XB = (bf16*)(ws + WS_XB); \
    const int lane = tid & 63, wave = __builtin_amdgcn_readfirstlane(tid >> 6), vcu = (G % 8 == 0) ? (bx % 8) * (G / 8) + bx / 8 : bx, gw = vcu * NWAVES + wave, NGW = G * NWAVES; \
    (void)lane; (void)wave; (void)vcu; (void)gw; (void)NGW; (void)MOD; (void)CS; (void)H; (void)XB; (void)outp
    const int wave_s = __builtin_amdgcn_readfirstlane((int)threadIdx.x >> 6);
    for (int u = wave_s * 64 + (int)__builtin_amdgcn_mbcnt_hi(~0u, __builtin_amdgcn_mbcnt_lo(~0u, 0u)); u < (LDS_BYTES - LDSCTL_OFF) / 4; u += NTHR) ((LAS unsigned*)(L + LDSCTL_OFF))[u] = 0u;
    __syncthreads();
#if MK_ONE_LAUNCH
    (void)xcd_barrier_post((unsigned*)((gu32*)(args.ws + WS_CTL) + CW_BAR), MISC + 8, wave_s == 0 && __builtin_amdgcn_mbcnt_hi(~0u, __builtin_amdgcn_mbcnt_lo(~0u, 0u)) == 0);
#define IN(k) true
#define GRID_BAR() do { unsigned char* wb_ = args.ws; asm volatile("" : "+s"(wb_)); XcdBarrier bar_; bar_.bar = (unsigned*)((gu32*)(wb_ + WS_CTL) + CW_BAR); bar_.x = xb_xcc_id(); bar_.st = (volatile LAS unsigned*)(L + MISC_OFF) + 8; int ln0_; asm volatile("v_mbcnt_lo_u32_b32 %0, -1, 0\n\tv_mbcnt_hi_u32_b32 %0, -1, %0" : "=v"(ln0_)); xcd_barrier(bar_, wave_s == 0 && ln0_ == 0); } while (0)
#else
    const int lo = args.ph_lo, hi = args.ph_hi;
#define IN(k) (lo <= (k) && (k) < hi)
#define GRID_BAR() do { } while (0)
#endif

#define KA_PTR() ({ const char __attribute__((address_space(4)))* kp_ = (const char __attribute__((address_space(4)))*)__builtin_amdgcn_kernarg_segment_ptr(); asm volatile("" : "+s"(kp_)); kp_; })
#define KIN(kp, k) (*(const float* const __attribute__((address_space(4)))*)((kp) + 8 * (k)))

    if (IN(0)) {
        const int l = 0; PHASE_IDS(); const float* const modl = MOD + (size_t)l * NB * 6144; (void)modl;
        for (int rep0 = 0; rep0 < REP_P0; ++rep0) {
        {
            LAS float* cl = (LAS float*)L;
            LAS float* red = (LAS float*)(L + 16384);
            const char __attribute__((address_space(4)))* kp = KA_PTR(); const float* cin = KIN(kp, 1); const float* modw = KIN(kp, 3); const float* modb = KIN(kp, 4);
            bool loaded = false;
            for (int un = bx; un < DEPTH * 96; un += G) {
                if (!loaded) { for (int i = tid; i < NB * DM; i += NTHR) cl[i] = ((const GAS float*)cin)[i]; loaded = true; }
                __syncthreads();
                const int l = un / 96, col = (un % 96) * 64 + (tid & 63), kg = tid >> 6;
                const float* W = modw + (size_t)l * DM * 6144 + col;
                float a0 = 0.f, a1 = 0.f, a2 = 0.f, a3 = 0.f;
                for (int k0 = kg * 128; k0 < kg * 128 + 128; k0 += 32) {
                    float wv[32];
#pragma unroll
                    for (int i = 0; i < 32; ++i) wv[i] = ((const GAS float*)W)[(size_t)(k0 + i) * 6144];
#pragma unroll
                    for (int i = 0; i < 32; ++i) { const float w = wv[i]; a0 += cl[k0 + i] * w; a1 += cl[DM + k0 + i] * w; a2 += cl[2 * DM + k0 + i] * w; a3 += cl[3 * DM + k0 + i] * w; }
                }
                red[(kg * 4 + 0) * 64 + (tid & 63)] = a0; red[(kg * 4 + 1) * 64 + (tid & 63)] = a1; red[(kg * 4 + 2) * 64 + (tid & 63)] = a2; red[(kg * 4 + 3) * 64 + (tid & 63)] = a3;
                __syncthreads();
                if (tid < 256) { const int b = tid >> 6, j = tid & 63; float s = 0.f;
#pragma unroll
                    for (int g = 0; g < 8; ++g) s += red[(g * 4 + b) * 64 + j];
                    const int cc = (un % 96) * 64 + j;
                    ((GAS float*)MOD)[((size_t)l * NB + b) * 6144 + cc] = s + ((const GAS float*)modb)[(size_t)l * 6144 + cc]; }
                __syncthreads();
            }
            __syncthreads();
        }
        {
            const char __attribute__((address_space(4)))* kp = KA_PTR(); const int* pos = (const int*)KIN(kp, 2);
            for (int i = (vcu * NTHR + tid); i < MTOK * 8; i += G * NTHR) {
                const int row = i >> 3, j = i & 7;
                const float invf = (j == 0) ? 1.0f : (j == 1) ? 0.19392274f : (j == 2) ? 0.03760603f : (j == 3) ? 0.0072926646f : (j == 4) ? 0.0014142136f : (j == 5) ? 0.0002742482f : (j == 6) ? 5.3182957e-05f : 1.0313385e-05f;
                const float ang = (float)((const GAS int*)pos)[row] * invf;
                float co, si; cos_sin_acc(ang, co, si);
                { typedef float f32x2g __attribute__((ext_vector_type(2))); *(GAS f32x2g*)(CS + (size_t)i * 2) = (f32x2g){co, si}; }
            }
        }
        {
            const char __attribute__((address_space(4)))* kp = KA_PTR();
            LAS float* scr = (LAS float*)(L + wave * 16384);
            constexpr int I_IN = (DM / 64) * (NIN / 32), I_A = (WSP / 64) * (DM / 32), I_O = (DM / 64) * (DM / 32), I_UP = (DM / 64) * (NUP / 32), I_D = (DFF / 64) * (DM / 32);
            constexpr int I_L = I_IN + 2 * I_A + I_O + I_UP + I_D;
            for (int it = gw; it < DEPTH * I_L; it += NGW) {
                const int l = it / I_L; int r = it % I_L;
                if (r < I_IN) { transpose_item<1>(KIN(kp, 7) + (size_t)l * DM * NIN_SRC, DM, NIN_SRC, NIN, (bf16*)(ws + WS_WIN + l * WIN_L), scr, r, lane); continue; } r -= I_IN;
                if (r < I_A) { transpose_item<0>(KIN(kp, 9) + (size_t)l * WSP * DM, WSP, DM, DM, (bf16*)(ws + WS_WA + l * 2 * WA_L), scr, r, lane, DM, 0); continue; } r -= I_A;
                if (r < I_A) { transpose_item<0>(KIN(kp, 10) + (size_t)l * WSP * DM, WSP, DM, DM, (bf16*)(ws + WS_WA + l * 2 * WA_L), scr, r, lane, DM, WSP); continue; } r -= I_A;
                if (r < I_O) { transpose_item<0>(KIN(kp, 11) + (size_t)l * DM * DM, DM, DM, DM, (bf16*)(ws + WS_WO + l * WO_L), scr, r, lane); continue; } r -= I_O;
                if (r < I_UP) { transpose_item<2>(KIN(kp, 12) + (size_t)l * DM * NUP, DM, NUP, NUP, (bf16*)(ws + WS_WUP + l * WUP_L), scr, r, lane); continue; } r -= I_UP;
                transpose_item<0>(KIN(kp, 15) + (size_t)l * DFF * DM, DFF, DM, DM, (bf16*)(ws + WS_WD + l * WD_L), scr, r, lane);
            }
        }
        if (REP_P0 > 1) __syncthreads();
        }
        GRID_BAR();
    }

    for (int l = 0; l < DEPTH; ++l) {
        const int pb = 1 + l * NPL;
#if MK_STEP < 2
        if (IN(pb + 5)) {
            PHASE_IDS(); const float* const modl = MOD + (size_t)l * NB * 6144; (void)modl;
            if (l == 0) { const float* x_in = KIN(KA_PTR(), 0); for (size_t i = (size_t)vcu * NTHR + tid; i < (size_t)MTOK * DM / 4; i += (size_t)G * NTHR) ((GAS f32x4*)outp)[i] = ((const GAS f32x4*)x_in)[i]; }
            GRID_BAR();
        }
#else
        if (IN(pb + 0)) {
            PHASE_IDS(); const float* const modl = MOD + (size_t)l * NB * 6144; (void)modl;
            const char __attribute__((address_space(4)))* kp = KA_PTR();
            if (bx == 0 && tid < NB) ((gu32*)(ws + WS_CUM + MiB))[tid] = 0u;
            const float* g = KIN(kp, 5) + (size_t)l * DM;
            constexpr int RPW = MTOK / (256 * NWAVES);
            if (l == 0) {
                const float* xs = KIN(kp, 0);
                for (int r0 = gw * RPW; r0 < MTOK; r0 += NGW * RPW) {
                    const int b = r0 / SEQ; const float* mb = modl + (size_t)b * 6144;
                    f32x4 gv[4], scv[4], shv[4]; load_vec16(g, lane, gv); load_vec16(mb + 1024, lane, scv); load_vec16(mb, lane, shv);
#pragma unroll
                    for (int j = 0; j < 4; ++j) gv[j] = gv[j] * (scv[j] + 1.0f);
                    for (int r = r0; r < r0 + RPW; ++r) {
                        f32x4 v[4]; load_vec16(xs + (size_t)r * DM, lane, v); float s = 0.f;
#pragma unroll
                        for (int j = 0; j < 4; ++j) s += (v[j].x * v[j].x + v[j].y * v[j].y) + (v[j].z * v[j].z + v[j].w * v[j].w);
                        const float rstd = rsqrtf(wave_sum(s, lane) * (1.f / DM) + EPS);
                        GAS unsigned long long* o8 = (GAS unsigned long long*)(H + (size_t)r * DM) + lane;
#pragma unroll
                        for (int j = 0; j < 4; ++j) { const f32x4 y = v[j] * rstd * gv[j] + shv[j]; o8[64 * j] = (unsigned long long)pk2(y.x, y.y) | ((unsigned long long)pk2(y.z, y.w) << 32); }
                    }
                }
            } else {
                for (int r0 = gw * RPW; r0 < MTOK; r0 += NGW * RPW) {
                    const int b = r0 / SEQ; const float* mb = modl + (size_t)b * 6144;
                    f32x4 gv[4], scv[4], shv[4]; load_vec16b(g, lane, gv); load_vec16b(mb + 1024, lane, scv); load_vec16b(mb, lane, shv);
#pragma unroll
                    for (int j = 0; j < 4; ++j) gv[j] = gv[j] * (scv[j] + 1.0f);
                    for (int r = r0; r < r0 + RPW; ++r) {
                        f32x4 v[4]; load_row16b(XB + (size_t)r * DM, lane, v); float s = 0.f;
#pragma unroll
                        for (int j = 0; j < 4; ++j) s += (v[j].x * v[j].x + v[j].y * v[j].y) + (v[j].z * v[j].z + v[j].w * v[j].w);
                        const float rstd = rsqrtf(wave_sum(s, lane) * (1.f / DM) + EPS);
                        f32x4 y[4];
#pragma unroll
                        for (int j = 0; j < 4; ++j) y[j] = v[j] * rstd * gv[j] + shv[j];
                        store_row16b(H + (size_t)r * DM, lane, y);
                    }
                }
            }
            GRID_BAR();
        }
        if (IN(pb + 1)) {
            PHASE_IDS(); const float* const modl = MOD + (size_t)l * NB * 6144; (void)modl;
            pg8::Gemm g{H, (const bf16*)(ws + WS_WIN + l * WIN_L), MTOK, NIN, DM}; pg8::HalfTailOrder S; S.init(MTOK, NIN, G, bx);
            pg8::EpiInProj E{ws, CS, KIN(KA_PTR(), 8) + (size_t)l * 8};
            for (int rep = 0; rep < REP_INPROJ; ++rep) pg8::gemm_phase<pg8::EpiInProj, pg8::HalfTailOrder, true, true>(L, g, S, E, wave_s);
            GRID_BAR();
        }
        if (IN(pb + 2)) {
            PHASE_IDS(); const float* const modl = MOD + (size_t)l * NB * 6144; (void)modl;
            const float* LOGF = (const float*)(ws + WS_LOGF); float* CUM = (float*)(ws + WS_CUM);
            {
                GAS float* NRM = (GAS float*)(ws + WS_CUM + MiB + 4096);
                for (int jb = gw; jb < 2048; jb += NGW) {
                    const int idx = jb & 1023, b = idx >> 8, h = (idx >> 5) & 7, qb = idx & 31;
                    const bf16* P = (const bf16*)(ws + ((jb >> 10) ? WS_KF : WS_QF)) + ((size_t)b * SEQ + 256 * qb + 4 * lane) * 512 + h * 64; float mx = 0.f;
                    v4u wq[4][8];
#pragma unroll
                    for (int r = 0; r < 4; ++r)
#pragma unroll
                        for (int c8 = 0; c8 < 8; ++c8) wq[r][c8] = *(const GAS v4u*)(P + (size_t)r * 512 + 8 * c8);
#pragma unroll
                    for (int r = 0; r < 4; ++r) { float n2 = 0.f;
#pragma unroll
                        for (int c8 = 0; c8 < 8; ++c8) { const v4u wv = wq[r][c8]; const unsigned ww[4] = {wv.x, wv.y, wv.z, wv.w};
#pragma unroll
                            for (int e = 0; e < 4; ++e) { const float a = __uint_as_float(ww[e] << 16), bb = __uint_as_float(ww[e] & 0xffff0000u); n2 = fmaf(a, a, n2); n2 = fmaf(bb, bb, n2); } }
                        mx = fmaxf(mx, n2); }
#pragma unroll
                    for (int o = 1; o < 64; o <<= 1) mx = fmaxf(mx, lane_read(mx, lane ^ o));
                    if (lane == 0) NRM[jb] = sqrtf(mx) * 1.0001f;
                }
            }
            LAS float* wtot = (LAS float*)L;
            {
                for (int s = bx; s < 256; s += G) {
                    const bf16* KI = (const bf16*)(ws + WS_KI) + ((size_t)s * 128 + (tid >> 2)) * 64 + (tid & 3) * 16; float n2 = 0.f;
#pragma unroll
                    for (int c8 = 0; c8 < 2; ++c8) { const v4u wv = *(const GAS v4u*)(KI + 8 * c8); const unsigned ww[4] = {wv.x, wv.y, wv.z, wv.w};
#pragma unroll
                        for (int e = 0; e < 4; ++e) { const float a = __uint_as_float(ww[e] << 16), bb = __uint_as_float(ww[e] & 0xffff0000u); n2 = fmaf(a, a, n2); n2 = fmaf(bb, bb, n2); } }
                    n2 += lane_read(n2, lane ^ 1); n2 += lane_read(n2, lane ^ 2);
#pragma unroll
                    for (int o = 4; o < 64; o <<= 1) n2 = fmaxf(n2, lane_read(n2, lane ^ o));
                    if (lane == 0) __hip_atomic_fetch_max((gu32*)(ws + WS_CUM + MiB) + (s >> 6), __float_as_uint(n2), __ATOMIC_RELAXED, __HIP_MEMORY_SCOPE_AGENT);
                }
            }
            for (int sq = bx; sq < NB * 8; sq += G) {
                const int b = sq >> 3, h = sq & 7; float v[16]; float run = 0.f;
#pragma unroll
                for (int i = 0; i < 16; ++i) { run += ((const GAS float*)LOGF)[((size_t)b * SEQ + tid * 16 + i) * 8 + h]; v[i] = run; }
                float inc = run;
#pragma unroll
                for (int o = 1; o < 64; o <<= 1) { const float t = lane_read(inc, (lane - o) & 63); if (lane >= o) inc += t; }
                if (lane == 63) wtot[wave] = inc;
                __syncthreads();
                float base = inc - run;
                for (int w = 0; w < wave; ++w) base += wtot[w];
                float* o = CUM + (size_t)sq * SEQ + tid * 16;
#pragma unroll
                for (int i = 0; i < 16; i += 4) *(GAS f32x4*)(o + i) = (f32x4){v[i] + base, v[i + 1] + base, v[i + 2] + base, v[i + 3] + base};
                __syncthreads();
            }
            GRID_BAR();
        }
        if (IN(pb + 3)) {
            PHASE_IDS(); const float* const modl = MOD + (size_t)l * NB * 6144; (void)modl;
            if (wave >= 4) __builtin_amdgcn_s_setprio(1);
            gu32* const qctr = (gu32*)(ws + WS_CTL) + 8192 + 64 * l;
            volatile LAS unsigned* const qslot = (volatile LAS unsigned*)(L + MISC_OFF) + 12;
            for (;;) {
                if (tid == 0) *qslot = __hip_atomic_fetch_add(qctr, 1u, __ATOMIC_RELAXED, __HIP_MEMORY_SCOPE_AGENT);
                __syncthreads();
                const int u = (int)*qslot;
                __syncthreads();
                if (u >= 1536) break;
                if (u < 512) {
#if MK_STEP >= 3
                    dsa::unit(L, ws, (unsigned char*)outp, u & 3, 127 - (u >> 2), wave_s);
#endif
                } else {
                    const int r = u - 512, qb = 31 - (r >> 5), bh = r & 31;
                    attn_body::attn_unit<8>(bh >> 3, bh & 7, qb, (const attn_body::bf16*)(ws + WS_QF), (const attn_body::bf16*)(ws + WS_KF), (const attn_body::bf16*)(ws + WS_VF), (attn_body::bf16*)outp + 512,
                                            (const float*)(ws + WS_CUM), (const float*)(ws + WS_CUM + MiB + 4096), (char*)lds, wave_s);
                }
            }
            __builtin_amdgcn_s_setprio(0);
            GRID_BAR();
        }
        if (IN(pb + 4)) {
            PHASE_IDS(); const float* const modl = MOD + (size_t)l * NB * 6144; (void)modl;
            { pg8::Gemm g{(const bf16*)outp, (const bf16*)(ws + WS_WA + l * 2 * WA_L), MTOK, DM, DM}; pg8::StaticOrder S; S.init(MTOK, DM, G, bx);
              pg8::EpiMerge E{H, (const bf16*)(ws + WS_GATES)};
              pg8::gemm_phase<pg8::EpiMerge, pg8::StaticOrder, true, true>(L, g, S, E, wave_s); }
            GRID_BAR();
        }
        if (IN(pb + 5)) {
            PHASE_IDS(); const float* const modl = MOD + (size_t)l * NB * 6144; (void)modl;
            const void* xs = (l == 0) ? (const void*)KIN(KA_PTR(), 0) : (const void*)XB;
            pg8::Gemm g{H, (const bf16*)(ws + WS_WO + l * WO_L), MTOK, DM, DM}; pg8::StaticOrder S; S.init(MTOK, DM, G, bx);
            pg8::EpiResidB E{xs, XB, modl + 2048, l == 0 ? 1 : 0};
            pg8::gemm_phase<pg8::EpiResidB, pg8::StaticOrder, true, true>(L, g, S, E, wave_s);
            GRID_BAR();
        }
#endif
        if (IN(pb + 6)) {
            PHASE_IDS(); const float* const modl = MOD + (size_t)l * NB * 6144; (void)modl;
            const float* g = KIN(KA_PTR(), 6) + (size_t)l * DM;
            constexpr int RPW = MTOK / (256 * NWAVES);
            for (int r0 = gw * RPW; r0 < MTOK; r0 += NGW * RPW) {
                const int b = r0 / SEQ; const float* mb = modl + (size_t)b * 6144;
                f32x4 gv[4], scv[4], shv[4]; load_vec16b(g, lane, gv); load_vec16b(mb + 4096, lane, scv); load_vec16b(mb + 3072, lane, shv);
#pragma unroll
                for (int j = 0; j < 4; ++j) gv[j] = gv[j] * (scv[j] + 1.0f);
                for (int r = r0; r < r0 + RPW; ++r) {
                    f32x4 v[4]; load_row16b(XB + (size_t)r * DM, lane, v); float s = 0.f;
#pragma unroll
                    for (int j = 0; j < 4; ++j) s += (v[j].x * v[j].x + v[j].y * v[j].y) + (v[j].z * v[j].z + v[j].w * v[j].w);
                    const float rstd = rsqrtf(wave_sum(s, lane) * (1.f / DM) + EPS);
                    f32x4 y[4];
#pragma unroll
                    for (int j = 0; j < 4; ++j) y[j] = v[j] * rstd * gv[j] + shv[j];
                    store_row16b(H + (size_t)r * DM, lane, y);
                }
            }
            GRID_BAR();
        }
        if (IN(pb + 7)) {
            PHASE_IDS(); const float* const modl = MOD + (size_t)l * NB * 6144; (void)modl;
            pg8::Gemm g{H, (const bf16*)(ws + WS_WUP + l * WUP_L), MTOK, NUP, DM}; pg8::StaticOrder S; S.init(MTOK, NUP, G, bx);
            const char __attribute__((address_space(4)))* kp = KA_PTR();
            pg8::EpiUpConv E{(bf16*)(ws + WS_ACT), (float*)(ws + WS_UH), (float*)(ws + WS_UT), KIN(kp, 13) + (size_t)l * 3 * NUP, KIN(kp, 14) + (size_t)l * NUP};
            for (int rep = 0; rep < REP_UP; ++rep) pg8::gemm_phase<pg8::EpiUpConv, pg8::StaticOrder, true, true>(L, g, S, E, wave_s);
            GRID_BAR();
        }
        if (IN(pb + 8)) {
            PHASE_IDS(); const float* const modl = MOD + (size_t)l * NB * 6144; (void)modl;
            const float* UH = (const float*)(ws + WS_UH); const float* UT = (const float*)(ws + WS_UT);
            const char __attribute__((address_space(4)))* kp = KA_PTR(); const float* cw = KIN(kp, 13) + (size_t)l * 3 * NUP; const float* cb = KIN(kp, 14) + (size_t)l * NUP;
            bf16* ACT = (bf16*)(ws + WS_ACT);
            for (int it = vcu * NTHR + tid; it < 512 * 2 * (DFF / 4); it += G * NTHR) {
                const int c4 = it % (DFF / 4), rr = (it / (DFF / 4)) & 1, Gq = it / (2 * (DFF / 4));
                const int j = 4 * c4, pn = j >> 7, cl = j & 127, ua = 256 * pn + cl;
                const bool first = (Gq % (SEQ / 64)) == 0;
                const f32x4 z = {0.f, 0.f, 0.f, 0.f};
                f32x4 res;
                f32x4 cv[2];
#pragma unroll
                for (int hb = 0; hb < 2; ++hb) {
                    const int uc = ua + 128 * hb, ch = hb * DFF + j;
                    const f32x4 u0 = *(const GAS f32x4*)(UH + ((size_t)Gq * 2 + rr) * NUP + uc);
                    const f32x4 u1 = rr ? *(const GAS f32x4*)(UH + ((size_t)Gq * 2) * NUP + uc) : (first ? z : *(const GAS f32x4*)(UT + ((size_t)(Gq - 1) * 2 + 1) * NUP + uc));
                    const f32x4 u2 = first ? z : *(const GAS f32x4*)(UT + ((size_t)(Gq - 1) * 2 + (rr ? 1 : 0)) * NUP + uc);
                    cv[hb] = *(const GAS f32x4*)(cb + ch) + *(const GAS f32x4*)(cw + ch) * u2 + *(const GAS f32x4*)(cw + NUP + ch) * u1 + *(const GAS f32x4*)(cw + 2 * NUP + ch) * u0;
                }
#pragma unroll
                for (int i = 0; i < 4; ++i) res[i] = cv[0][i] * pg8::fast_sigmoid(cv[0][i]) * cv[1][i];
                *(GAS unsigned long long*)(ACT + (size_t)(Gq * 64 + rr) * DFF + j) = (unsigned long long)pk2(res[0], res[1]) | ((unsigned long long)pk2(res[2], res[3]) << 32);
            }
            GRID_BAR();
        }
        if (IN(pb + 9)) {
            PHASE_IDS(); const float* const modl = MOD + (size_t)l * NB * 6144; (void)modl;
            pg8::Gemm g{(const bf16*)(ws + WS_ACT), (const bf16*)(ws + WS_WD + l * WD_L), MTOK, DM, DFF}; pg8::StaticOrder S; S.init(MTOK, DM, G, bx);
            pg8::EpiResidB E{(const void*)XB, XB, modl + 5120, 0};
            pg8::gemm_phase<pg8::EpiResidB, pg8::StaticOrder, true, true>(L, g, S, E, wave_s);
            GRID_BAR();
        }
    }
    if (IN(PH_FINAL)) {
        const int l = 0; PHASE_IDS(); const float* const modl = MOD + (size_t)l * NB * 6144; (void)modl;
        f32x4 gv[4]; load_vec16b(KIN(KA_PTR(), 16), lane, gv);
        for (int r = gw; r < MTOK; r += NGW) {
            f32x4 v[4]; load_row16b(XB + (size_t)r * DM, lane, v); float s = 0.f;
#pragma unroll
            for (int j = 0; j < 4; ++j) s += (v[j].x * v[j].x + v[j].y * v[j].y) + (v[j].z * v[j].z + v[j].w * v[j].w);
            const float rstd = rsqrtf(wave_sum(s, lane) * (1.f / DM) + EPS);
#pragma unroll
            for (int j = 0; j < 2; ++j) { *(GAS f32x4*)(outp + (size_t)r * DM + 512 * j + 8 * lane) = v[2 * j] * rstd * gv[2 * j]; *(GAS f32x4*)(outp + (size_t)r * DM + 512 * j + 8 * lane + 4) = v[2 * j + 1] * rstd * gv[2 * j + 1]; }
        }
    }
#undef IN
#undef GRID_BAR
}

extern "C" void kernel_launch(void* const* d_in, const int* in_sizes, int n_in, void* d_out, int out_size, void* d_ws, size_t ws_size, hipStream_t stream) {
    static int grid = 0;
    if (grid == 0) {
        if (n_in != 17 || out_size != MTOK * DM || ws_size < WS_END) { fprintf(stderr, "kernel_launch: unexpected problem (n_in %d, out %d, ws %zu)\n", n_in, out_size, ws_size); grid = -1; return; }
        int dev = 0, cus = 0, per_cu = 0;
        if (hipGetDevice(&dev) != hipSuccess || hipDeviceGetAttribute(&cus, hipDeviceAttributeMultiprocessorCount, dev) != hipSuccess) { grid = -1; return; }
        if (hipFuncSetAttribute((const void*)mk_fwd, hipFuncAttributeMaxDynamicSharedMemorySize, LDS_BYTES) != hipSuccess) { fprintf(stderr, "kernel_launch: hipFuncSetAttribute failed\n"); grid = -1; return; }
        if (hipOccupancyMaxActiveBlocksPerMultiprocessor(&per_cu, (const void*)mk_fwd, NTHR, LDS_BYTES) != hipSuccess || per_cu < 1) { fprintf(stderr, "kernel_launch: occupancy query says %d\n", per_cu); (void)hipGetLastError(); grid = -1; return; }
        grid = cus;
    }
    if (grid < 0) return;
    (void)hipMemsetAsync((char*)d_ws + WS_CTL, 0, CTL_ZERO_BYTES, stream);
    Args a{};
    for (int i = 0; i < 17; ++i) a.in[i] = (const float*)d_in[i];
    a.out = (float*)d_out; a.ws = (unsigned char*)d_ws; a.pad = 0;
#if MK_ONE_LAUNCH
    a.ph_lo = 0; a.ph_hi = N_PHASES; a.use_bar = 1;
    hipLaunchKernelGGL(mk_fwd, dim3(grid), dim3(NTHR), LDS_BYTES, stream, a);
#else
    for (int p = 0; p < N_PHASES; ++p) { a.ph_lo = p; a.ph_hi = p + 1; a.use_bar = 0; hipLaunchKernelGGL(mk_fwd, dim3(grid), dim3(NTHR), LDS_BYTES, stream, a); }
#endif
}
```
